# Optimizing an MI355X kernel written in HIP

```python
import math
import jax, jax.numpy as jnp
from jax import lax
import numpy as np

D_MODEL = 1024
BATCH = 2
SEQ = 8192
DEPTH = 2

GRID_W = 64
CTX_LEN = 256
D_FF = 4 * D_MODEL
EPS = 1e-6
N_EVEN = (DEPTH + 1) // 2
N_ODD = DEPTH // 2
MLSTM_HEADS = 6
MLSTM_DH = 128
D_A = MLSTM_HEADS * MLSTM_DH
D_B = D_MODEL - D_A
FNET_GROUPS = 4
FNET_GC = D_B // FNET_GROUPS
MLSTM_CHUNK = 64
QK_CONV_W = 3
EVEN_IN = 4 * D_A + 4 * MLSTM_HEADS + D_B
DIFF_HEADS = 6
DIFF_DH = 64
DIFF_DV = 2 * DIFF_DH
D_C = DIFF_HEADS * DIFF_DV
D_D = D_MODEL - D_C
CONV_W = 31
ODD_IN = 3 * D_C + 2 * D_D
Q_BLOCK = 128
ROPE_BASE = 10000.0

kernel_name = "hybrid_mlstm_fnet_diffattn_conformer_dit"


def rmsnorm(x, g):
    xf = x.astype(jnp.float32)
    y = xf * lax.rsqrt(jnp.mean(xf * xf, axis=-1, keepdims=True) + EPS)
    return (y * g.astype(jnp.float32)).astype(x.dtype)


def layernorm(x, g, b):
    xf = x.astype(jnp.float32)
    mu = jnp.mean(xf, axis=-1, keepdims=True)
    var = jnp.mean(jnp.square(xf - mu), axis=-1, keepdims=True)
    y = (xf - mu) * lax.rsqrt(var + EPS)
    return (y * g.astype(jnp.float32) + b.astype(jnp.float32)).astype(x.dtype)


def modulate(h, shift, scale):
    return h * (1 + scale) + shift


def squared_relu_mlp(h, w1, w2):
    return jnp.square(jax.nn.relu(h @ w1)) @ w2


def depthwise_conv(x, w):
    pad = (w.shape[0] - 1) // 2
    return lax.conv_general_dilated(
        x, w.astype(x.dtype)[:, None, :], window_strides=(1,), padding=[(pad, pad)],
        dimension_numbers=('NWC', 'WIO', 'NWC'), feature_group_count=x.shape[-1])


def heads_first(a, n):
    b_, t_, _ = a.shape
    return a.reshape(b_, t_, n, -1).transpose(0, 2, 1, 3)


def head_rmsnorm(h, g, n):
    b_, t_, dm = h.shape
    hf = h.astype(jnp.float32).reshape(b_, t_, n, dm // n)
    hf = hf * lax.rsqrt(jnp.mean(hf * hf, axis=-1, keepdims=True) + EPS)
    return (hf.reshape(b_, t_, dm) * g.astype(jnp.float32)).astype(h.dtype)


def fourier_mix(f):
    b_, t_, _ = f.shape
    g = f.astype(jnp.float32).reshape(b_, t_, FNET_GROUPS, FNET_GC)
    y = jnp.fft.fft2(g, axes=(1, 3), norm='ortho').real
    return y.reshape(b_, t_, D_B).astype(f.dtype)


def axial_rope(t_len, dh):
    rows = t_len // GRID_W
    row = jnp.repeat(jnp.arange(rows, dtype=jnp.float32), GRID_W)
    col = jnp.tile(jnp.arange(GRID_W, dtype=jnp.float32), rows)
    n_freq = dh // 4
    inv = ROPE_BASE ** (-jnp.arange(n_freq, dtype=jnp.float32) / n_freq)
    ang = jnp.concatenate([row[:, None] * inv, col[:, None] * inv], axis=-1)
    return jnp.cos(ang), jnp.sin(ang)


def apply_rope(x, cos, sin):
    cos = cos[None, :, None, None, :]
    sin = sin[None, :, None, None, :]
    x1, x2 = jnp.split(x.astype(jnp.float32), 2, axis=-1)
    return jnp.concatenate([x1 * cos - x2 * sin, x2 * cos + x1 * sin], axis=-1).astype(x.dtype)


def mlstm_scan(q, k, v, logi, logf, state):
    b_, h_, t_, d_ = q.shape
    nc = t_ // MLSTM_CHUNK

    def to_chunks(a):
        a = a.reshape(a.shape[:2] + (nc, MLSTM_CHUNK) + a.shape[3:])
        return jnp.moveaxis(a, 2, 0)

    causal = jnp.tril(jnp.ones((MLSTM_CHUNK, MLSTM_CHUNK), dtype=bool))

    def step(carry, xs):
        c_mem, n_mem, m_prev = carry
        qc, kc, vc, ic, fc = xs
        bcum = jnp.cumsum(fc, axis=-1)
        dlog = bcum[..., :, None] - bcum[..., None, :] + ic[..., None, :]
        dlog = jnp.where(causal, dlog, -jnp.inf)
        m_t = jnp.maximum(bcum + m_prev[..., None], jnp.max(dlog, axis=-1))
        s = jnp.einsum('bhtd,bhsd->bhts', qc, kc) * jnp.exp(dlog - m_t[..., None])
        inter = jnp.exp(bcum + m_prev[..., None] - m_t)
        num = jnp.einsum('bhts,bhsd->bhtd', s, vc) + inter[..., None] * jnp.einsum('bhvk,bhtk->bhtv', c_mem, qc)
        den = jnp.sum(s, axis=-1) + inter * jnp.einsum('bhk,bhtk->bht', n_mem, qc)
        h = num / jnp.maximum(jnp.abs(den), jnp.exp(-m_t))[..., None]
        g = bcum[..., -1:] - bcum + ic
        m_new = jnp.maximum(bcum[..., -1] + m_prev, jnp.max(g, axis=-1))
        w = jnp.exp(g - m_new[..., None])
        decay = jnp.exp(bcum[..., -1] + m_prev - m_new)
        c_new = decay[..., None, None] * c_mem + jnp.einsum('bhs,bhsv,bhsk->bhvk', w, vc, kc)
        n_new = decay[..., None] * n_mem + jnp.einsum('bhs,bhsk->bhk', w, kc)
        return (c_new, n_new, m_new), h

    state, hs = lax.scan(step, state, (to_chunks(q), to_chunks(k), to_chunks(v), to_chunks(logi), to_chunks(logf)))
    h = jnp.moveaxis(hs, 0, 2).reshape(b_, h_, t_, d_)
    return h, state


def even_mixer(h_lat, h_ctx, w_in, b_gate, w_qk_conv, g_head, w_out, need_ctx_out):
    f32 = jnp.float32

    def project(h):
        u = h @ w_in
        qk, v, o, gates, f = jnp.split(u, [2 * D_A, 3 * D_A, 4 * D_A, 4 * D_A + 4 * MLSTM_HEADS], axis=-1)
        qk = jax.nn.silu(depthwise_conv(qk, w_qk_conv))
        q, k = jnp.split(qk, 2, axis=-1)
        q = heads_first(q, MLSTM_HEADS).astype(f32) * (MLSTM_DH ** -0.5)
        k = heads_first(k, MLSTM_HEADS).astype(f32)
        v = heads_first(v, MLSTM_HEADS).astype(f32)
        gates = (gates + b_gate).astype(f32).transpose(0, 2, 1)
        i_f, f_f, i_b, f_b = jnp.split(gates, 4, axis=1)
        return q, k, v, (i_f, jax.nn.log_sigmoid(f_f)), (i_b, jax.nn.log_sigmoid(f_b)), o, f

    qc, kc, vc, gcf, gcb, oc, fc = project(h_ctx)
    ql, kl, vl, glf, glb, ol, fl = project(h_lat)
    b_ = h_lat.shape[0]
    zero = (jnp.zeros((b_, MLSTM_HEADS, MLSTM_DH, MLSTM_DH), f32),
            jnp.zeros((b_, MLSTM_HEADS, MLSTM_DH), f32),
            jnp.zeros((b_, MLSTM_HEADS), f32))
    flip = lambda a: jnp.flip(a, axis=2)
    hcf, st_f = mlstm_scan(qc, kc, vc, gcf[0], gcf[1], zero)
    hlf, _ = mlstm_scan(ql, kl, vl, glf[0], glf[1], st_f)
    hcb, st_b = mlstm_scan(flip(qc), flip(kc), flip(vc), flip(gcb[0]), flip(gcb[1]), zero)
    hlb, _ = mlstm_scan(flip(ql), flip(kl), flip(vl), flip(glb[0]), flip(glb[1]), st_b)

    def finish(hf, hb_rev, o, f):
        h = hf + flip(hb_rev)
        b2, _, t2, _ = h.shape
        h = h.transpose(0, 2, 1, 3).reshape(b2, t2, D_A).astype(o.dtype)
        h = head_rmsnorm(h, g_head, MLSTM_HEADS) * jax.nn.sigmoid(o)
        return jnp.concatenate([h, fourier_mix(f)], axis=-1) @ w_out

    y_lat = finish(hlf, hlb, ol, fl)
    y_ctx = finish(hcf, hcb, oc, fc) if need_ctx_out else None
    return y_lat, y_ctx


def diff_attention(q, k, v, lam):
    s = jnp.einsum('bqhmd,bkhmd->bhmqk', q, k).astype(jnp.float32) * (DIFF_DH ** -0.5)
    p = jax.nn.softmax(s, axis=-1)
    a = p[:, :, 0] - lam * p[:, :, 1]
    return jnp.einsum('bhqk,bkhd->bqhd', a.astype(v.dtype), v)


def odd_mixer(h_lat, h_ctx, w_in, lam_p, g_sub, w_dw, g_ln, b_ln, w_out, lam_init, need_ctx_out):
    def project(h):
        u = h @ w_in
        q, k, v, glu = jnp.split(u, [D_C, 2 * D_C, 3 * D_C], axis=-1)
        b_, t_, _ = h.shape
        q = q.reshape(b_, t_, DIFF_HEADS, 2, DIFF_DH)
        k = k.reshape(b_, t_, DIFF_HEADS, 2, DIFF_DH)
        v = v.reshape(b_, t_, DIFF_HEADS, DIFF_DV)
        return q, k, v, glu

    qc, kc, vc, gluc = project(h_ctx)
    ql, kl, vl, glul = project(h_lat)
    b_, t_, _ = h_lat.shape
    cos, sin = axial_rope(t_, DIFF_DH)
    ql = apply_rope(ql, cos, sin)
    kl = apply_rope(kl, cos, sin)
    lp = lam_p.astype(jnp.float32)
    lam = jnp.exp(jnp.sum(lp[0] * lp[1])) - jnp.exp(jnp.sum(lp[2] * lp[3])) + lam_init
    k_all = jnp.concatenate([kc, kl], axis=1)
    v_all = jnp.concatenate([vc, vl], axis=1)
    nb = t_ // Q_BLOCK
    qb = jnp.moveaxis(ql.reshape(b_, nb, Q_BLOCK, DIFF_HEADS, 2, DIFF_DH), 1, 0)
    ob = lax.map(lambda q_blk: diff_attention(q_blk, k_all, v_all, lam), qb)
    o_lat = jnp.moveaxis(ob, 0, 1).reshape(b_, t_, DIFF_HEADS, DIFF_DV)

    def finish(o, glu):
        b2, t2 = o.shape[0], o.shape[1]
        o = (rmsnorm(o, g_sub) * (1.0 - lam_init)).reshape(b2, t2, D_C)
        a, gte = jnp.split(glu, 2, axis=-1)
        z = depthwise_conv(a * jax.nn.sigmoid(gte), w_dw)
        z = jax.nn.silu(layernorm(z, g_ln, b_ln))
        return jnp.concatenate([o.astype(z.dtype), z], axis=-1) @ w_out

    y_lat = finish(o_lat, glul)
    y_ctx = finish(diff_attention(qc, kc, vc, lam), gluc) if need_ctx_out else None
    return y_lat, y_ctx


def setup_inputs(seed: int = 0) -> dict:
    key = jax.random.key(seed)
    ks = jax.random.split(key, 24)
    f32 = jnp.float32

    def nrm(k, shape, scale):
        return jax.random.normal(k, shape, f32) * scale

    fbias = jnp.linspace(3.0, 6.0, MLSTM_HEADS, dtype=f32)
    gate_base = jnp.array([0.0, 1.0, 0.0, 1.0], f32)[:, None] * fbias[None, :]
    b_gate = (nrm(ks[8], (N_EVEN, 4, MLSTM_HEADS), 0.1) + gate_base[None]).reshape(N_EVEN, 4 * MLSTM_HEADS)
    return {
        'x': nrm(ks[0], (BATCH, SEQ, D_MODEL), 1.0),
        'c': nrm(ks[1], (BATCH, D_MODEL), 1.0),
        'ctx': nrm(ks[2], (BATCH, CTX_LEN, D_MODEL), 1.0),
        'c_ctx': nrm(ks[3], (D_MODEL,), 1.0),
        'w_mod': nrm(ks[4], (DEPTH, D_MODEL, 6 * D_MODEL), 0.5 * D_MODEL ** -0.5),
        'b_mod': nrm(ks[5], (DEPTH, 6 * D_MODEL), 0.02),
        'g_norm': 1.0 + nrm(ks[6], (DEPTH, 2, D_MODEL), 0.02),
        'w_in_even': nrm(ks[7], (N_EVEN, D_MODEL, EVEN_IN), D_MODEL ** -0.5),
        'b_gate': b_gate,
        'w_qk_conv': nrm(ks[9], (N_EVEN, QK_CONV_W, 2 * D_A), QK_CONV_W ** -0.5),
        'g_mlstm_head': 1.0 + nrm(ks[10], (N_EVEN, D_A), 0.02),
        'w_out_even': nrm(ks[11], (N_EVEN, D_MODEL, D_MODEL), D_MODEL ** -0.5),
        'w_in_odd': nrm(ks[12], (N_ODD, D_MODEL, ODD_IN), D_MODEL ** -0.5),
        'lam_p': nrm(ks[13], (N_ODD, 4, DIFF_DH), 0.1),
        'g_subln': 1.0 + nrm(ks[14], (N_ODD, DIFF_DV), 0.02),
        'w_dw': nrm(ks[15], (N_ODD, CONV_W, D_D), CONV_W ** -0.5),
        'g_conv_ln': 1.0 + nrm(ks[16], (N_ODD, D_D), 0.02),
        'b_conv_ln': nrm(ks[17], (N_ODD, D_D), 0.02),
        'w_out_odd': nrm(ks[18], (N_ODD, D_MODEL, D_MODEL), D_MODEL ** -0.5),
        'w_ff1': nrm(ks[19], (DEPTH, D_MODEL, D_FF), D_MODEL ** -0.5),
        'w_ff2': nrm(ks[20], (DEPTH, D_FF, D_MODEL), D_FF ** -0.5),
        'g_final': 1.0 + nrm(ks[21], (D_MODEL,), 0.02),
    }


def reference(x, c, ctx, c_ctx, w_mod, b_mod, g_norm, w_in_even, b_gate, w_qk_conv, g_mlstm_head,
              w_out_even, w_in_odd, lam_p, g_subln, w_dw, g_conv_ln, b_conv_ln, w_out_odd,
              w_ff1, w_ff2, g_final):
    xc = ctx
    s_lat = jax.nn.silu(c)
    s_ctx = jax.nn.silu(c_ctx)
    for l in range(DEPTH):
        last = l == DEPTH - 1
        j = l // 2
        mod_l = jnp.split((s_lat @ w_mod[l] + b_mod[l])[:, None, :], 6, axis=-1)
        mod_c = jnp.split(s_ctx @ w_mod[l] + b_mod[l], 6, axis=-1)
        h_l = modulate(rmsnorm(x, g_norm[l, 0]), mod_l[0], mod_l[1])
        h_c = modulate(rmsnorm(xc, g_norm[l, 0]), mod_c[0], mod_c[1])
        if l % 2 == 0:
            y_l, y_c = even_mixer(h_l, h_c, w_in_even[j], b_gate[j], w_qk_conv[j], g_mlstm_head[j],
                                  w_out_even[j], not last)
        else:
            lam_init = 0.8 - 0.6 * math.exp(-0.3 * l)
            y_l, y_c = odd_mixer(h_l, h_c, w_in_odd[j], lam_p[j], g_subln[j], w_dw[j], g_conv_ln[j],
                                 b_conv_ln[j], w_out_odd[j], lam_init, not last)
        x = x + mod_l[2] * y_l
        x = x + mod_l[5] * squared_relu_mlp(modulate(rmsnorm(x, g_norm[l, 1]), mod_l[3], mod_l[4]), w_ff1[l], w_ff2[l])
        if not last:
            xc = xc + mod_c[2] * y_c
            xc = xc + mod_c[5] * squared_relu_mlp(modulate(rmsnorm(xc, g_norm[l, 1]), mod_c[3], mod_c[4]), w_ff1[l], w_ff2[l])
    return rmsnorm(x, g_final)
```

```cpp
#include <hip/hip_runtime.h>
#include <hip/hip_cooperative_groups.h>
#include <cstdio>
#include <cstdint>
namespace cg = cooperative_groups;

#ifndef LB2
#define LB2 2
#endif
#ifndef NPH_RUN
#define NPH_RUN 20
#endif
#ifndef DUMP_OFF
#define DUMP_OFF (OFF_AR + A0_QK)
#endif
#ifndef MULTI_LAUNCH
#define MULTI_LAUNCH 0
#endif

typedef unsigned short bf16_t;
typedef short bf16x8 __attribute__((ext_vector_type(8)));
typedef float f32x4 __attribute__((ext_vector_type(4)));
typedef float f32x16 __attribute__((ext_vector_type(16)));
#define DEV __device__ __forceinline__

constexpr int D = 1024, NB = 2, SEQ = 8192, CTX = 256, S_ = SEQ + CTX, M = NB * S_, DFF = 4096;
constexpr int LDH = D + 64, LDHID = DFF + 64;
constexpr int NCH = S_ / 128;
constexpr int NPH = 20;
constexpr float EPS = 1e-6f;

constexpr size_t OFF_MOD = 0;
constexpr size_t MOD_BYTES = 2 * 3 * 6144 * 4;
constexpr size_t OFF_ROPE = 0x40000;
constexpr size_t OFF_XC = 0x240000;
constexpr size_t OFF_G = 0x440000;
constexpr size_t OFF_CS = 0x5D0000;
constexpr size_t OFF_MS = 0x5D8000;
constexpr size_t OFF_NV = 0x5DA000;
constexpr size_t OFF_WT = 0x700000;
constexpr size_t WT_IN = 0, WT_OUT = 0x770000, WT_FF1 = 0x990000, WT_FF2 = 0x1210000;
constexpr size_t OFF_H = 0x2200000;
constexpr size_t OFF_AR = 0x4510000;
constexpr size_t A0_QK = 0, A0_ST = 0, A0_VT = 0x3180000, A0_O = 0x4A40000, A0_QC = 0x6300000, A0_KC = 0x7BC0000;
constexpr size_t DO_KCT = 0, DO_ZT = 0x18C0000, DO_F = 0x2940000;
constexpr size_t A1_Q = 0, A1_K = 0x18C0000, A1_VT = 0x3180000, A1_GLU = 0x4A40000, A1_OA = 0x5AC0000;
constexpr size_t OFF_WT2 = OFF_AR + 0x9480000;
constexpr size_t WS_NEED = OFF_WT2 + 0x1A30000;

struct Params {
  const float *x, *c, *ctx, *c_ctx, *w_mod, *b_mod, *g_norm, *w_in_even, *b_gate, *w_qk_conv, *g_head, *w_out_even,
      *w_in_odd, *lam_p, *g_sub, *w_dw, *g_cln, *b_cln, *w_out_odd, *w_ff1, *w_ff2, *g_final;
  float* out;
  unsigned char* ws;
  int ph_lo, ph_hi;
};

typedef float f32x2 __attribute__((ext_vector_type(2)));
typedef __bf16 bf16x2_t __attribute__((ext_vector_type(2)));
DEV unsigned pk2(float lo, float hi) { f32x2 v = {lo, hi}; bf16x2_t b = __builtin_convertvector(v, bf16x2_t); return __builtin_bit_cast(unsigned, b); }
DEV bf16_t f2bf(float f) { return (bf16_t)(pk2(f, 0.f) & 0xffff); }
DEV float bf2f(unsigned h) { return __uint_as_float(h << 16); }
DEV float bflo(unsigned u) { return __uint_as_float(u << 16); }
DEV float bfhi(unsigned u) { return __uint_as_float(u & 0xffff0000u); }
DEV float wsum(float v) { for (int o = 32; o; o >>= 1) v += __shfl_xor(v, o); return v; }
DEV float xor32_max(float v) { auto r = __builtin_amdgcn_permlane32_swap(__float_as_uint(v), __float_as_uint(v), false, false); return fmaxf(__uint_as_float(r[0]), __uint_as_float(r[1])); }
DEV float xor32_sum(float v) { auto r = __builtin_amdgcn_permlane32_swap(__float_as_uint(v), __float_as_uint(v), false, false); return __uint_as_float(r[0]) + __uint_as_float(r[1]); }
DEV float sigmoidf_(float x) { return 1.f / (1.f + __expf(-x)); }
DEV float siluf_(float x) { return x / (1.f + __expf(-x)); }
DEV float logsigf_(float x) { return fminf(x, 0.f) - log1pf(__expf(-fabsf(x))); }

constexpr int LDT = 72;
constexpr int LDP = 136;
constexpr int LDS_A = 0, LDS_B = 18432, LDS_P = 36864, LDS_F = 71680, LDS_BYTES = 79872;

template <bool A_LDS, class LA, class LB>
DEV void block_gemm(f32x4 (&acc)[2][8], int nk, LA la, LB lb, unsigned char* smem, const bf16_t* pA, int ldp) {
  bf16_t* sA = (bf16_t*)(smem + LDS_A);
  bf16_t* sB = (bf16_t*)(smem + LDS_B);
  const int tid = threadIdx.x, lane = tid & 63, w = tid >> 6;
  const int srow = tid >> 3, scol = (tid & 7) * 8;
  const int fr = lane & 15, fq = lane >> 4;
  uint4 ra[4], rb[4];
#pragma unroll
  for (int i = 0; i < 4; ++i) { if (!A_LDS) ra[i] = la(srow + 32 * i, scol); rb[i] = lb(srow + 32 * i, scol); }
  for (int kt = 0; kt < nk; ++kt) {
    __syncthreads();
#pragma unroll
    for (int i = 0; i < 4; ++i) {
      if (!A_LDS) *(uint4*)&sA[(srow + 32 * i) * LDT + scol] = ra[i];
      *(uint4*)&sB[(srow + 32 * i) * LDT + scol] = rb[i];
    }
    __syncthreads();
    if (kt + 1 < nk) {
#pragma unroll
      for (int i = 0; i < 4; ++i) { if (!A_LDS) ra[i] = la(srow + 32 * i, (kt + 1) * 64 + scol); rb[i] = lb(srow + 32 * i, (kt + 1) * 64 + scol); }
    }
#pragma unroll
    for (int kk = 0; kk < 2; ++kk) {
      bf16x8 af[2], bfr[8];
#pragma unroll
      for (int mi = 0; mi < 2; ++mi) {
        if (A_LDS) af[mi] = *(const bf16x8*)&pA[(32 * w + 16 * mi + fr) * ldp + kt * 64 + kk * 32 + 8 * fq];
        else af[mi] = *(const bf16x8*)&sA[(32 * w + 16 * mi + fr) * LDT + kk * 32 + 8 * fq];
      }
#pragma unroll
      for (int ni = 0; ni < 8; ++ni) bfr[ni] = *(const bf16x8*)&sB[(16 * ni + fr) * LDT + kk * 32 + 8 * fq];
#pragma unroll
      for (int mi = 0; mi < 2; ++mi)
#pragma unroll
        for (int ni = 0; ni < 8; ++ni) acc[mi][ni] = __builtin_amdgcn_mfma_f32_16x16x32_bf16(bfr[ni], af[mi], acc[mi][ni], 0, 0, 0);
    }
  }
}

DEV void zero_acc(f32x4 (&acc)[2][8]) {
#pragma unroll
  for (int mi = 0; mi < 2; ++mi)
#pragma unroll
    for (int ni = 0; ni < 8; ++ni) acc[mi][ni] = (f32x4){0.f, 0.f, 0.f, 0.f};
}

#define LASG __attribute__((address_space(3)))
DEV void block_gemm_glds(f32x4 (&acc)[2][8], int nk, const bf16_t* Ag, size_t lda, const bf16_t* Bg, size_t ldb, unsigned char* smem) {
  const int tid = threadIdx.x, lane = tid & 63, w = tid >> 6;
  const int srow = tid >> 3, sc = ((tid & 7) ^ (srow & 7)) * 8;
  const int fr = lane & 15, fq = lane >> 4;
  const bf16_t* ag = Ag + (size_t)srow * lda + sc;
  const bf16_t* bg = Bg + (size_t)srow * ldb + sc;
  LASG unsigned char* lbase = (LASG unsigned char*)smem;
#define GLDS_ISSUE(st_, k0_) do { \
    _Pragma("unroll") for (int i = 0; i < 4; ++i) { \
      __builtin_amdgcn_global_load_lds((const unsigned*)(ag + (size_t)(32 * i) * lda + (k0_)), (LASG unsigned*)(lbase + (st_) * 32768 + (tid + 256 * i) * 16), 16, 0, 0); \
      __builtin_amdgcn_global_load_lds((const unsigned*)(bg + (size_t)(32 * i) * ldb + (k0_)), (LASG unsigned*)(lbase + (st_) * 32768 + 16384 + (tid + 256 * i) * 16), 16, 0, 0); } } while (0)
  __syncthreads();
  GLDS_ISSUE(0, 0);
  for (int kt = 0; kt < nk; ++kt) {
    __syncthreads();
    if (kt + 1 < nk) GLDS_ISSUE((kt + 1) & 1, (kt + 1) * 64);
    const unsigned char* sA = smem + (kt & 1) * 32768;
    const unsigned char* sB = sA + 16384;
#pragma unroll
    for (int kk = 0; kk < 2; ++kk) {
      const int swz = ((kk * 4 + fq) ^ (fr & 7)) * 16;
      bf16x8 af[2], bfr[8];
#pragma unroll
      for (int mi = 0; mi < 2; ++mi) af[mi] = *(const bf16x8*)(sA + (32 * w + 16 * mi + fr) * 128 + swz);
#pragma unroll
      for (int ni = 0; ni < 8; ++ni) bfr[ni] = *(const bf16x8*)(sB + (16 * ni + fr) * 128 + swz);
#pragma unroll
      for (int mi = 0; mi < 2; ++mi)
#pragma unroll
        for (int ni = 0; ni < 8; ++ni) acc[mi][ni] = __builtin_amdgcn_mfma_f32_16x16x32_bf16(bfr[ni], af[mi], acc[mi][ni], 0, 0, 0);
    }
  }
#undef GLDS_ISSUE
}

DEV void block_gemm_glds2(f32x4 (&acc0)[2][8], f32x4 (&acc1)[2][8], int nk, const bf16_t* Ag, size_t lda, const bf16_t* Bg, size_t ldb, unsigned char* smem) {
  const int tid = threadIdx.x, lane = tid & 63, w = tid >> 6;
  const int fr = lane & 15, fq = lane >> 4;
  const int lr = lane >> 2, lp = lane & 3;
  const int sc = (lp ^ ((0x78 >> (2 * ((lr >> 2) & 3))) & 3)) * 8;
  const bf16_t* ag = Ag + (size_t)(32 * w + lr) * lda + sc;
  const bf16_t* bg = Bg + (size_t)(64 * w + lr) * ldb + sc;
  LASG unsigned char* lbase = (LASG unsigned char*)smem;
#define G2_ISSUE(st_, k0_) do { \
    _Pragma("unroll") for (int i = 0; i < 2; ++i) \
      __builtin_amdgcn_global_load_lds((const unsigned*)(ag + (size_t)(16 * i) * lda + (k0_)), (LASG unsigned*)(lbase + (st_) * 24576 + (32 * w + 16 * i) * 64 + lane * 16), 16, 0, 0); \
    _Pragma("unroll") for (int i = 0; i < 4; ++i) \
      __builtin_amdgcn_global_load_lds((const unsigned*)(bg + (size_t)(16 * i) * ldb + (k0_)), (LASG unsigned*)(lbase + (st_) * 24576 + 8192 + (64 * w + 16 * i) * 64 + lane * 16), 16, 0, 0); } while (0)
  __syncthreads();
  G2_ISSUE(0, 0);
  if (nk > 1) G2_ISSUE(1, 32);
  const int roff = (fq ^ ((0x78 >> (2 * ((fr >> 2) & 3))) & 3)) * 16 + fr * 64;
  int st = 0;
  for (int kt = 0; kt < nk; ++kt) {
    if (kt + 1 < nk) asm volatile("s_waitcnt vmcnt(6)" ::: "memory"); else asm volatile("s_waitcnt vmcnt(0)" ::: "memory");
    __builtin_amdgcn_s_barrier();
    asm volatile("" ::: "memory");
    if (kt + 2 < nk) { const int st2 = st >= 1 ? st - 1 : 2; G2_ISSUE(st2, (kt + 2) * 32); }
    const unsigned char* sA = smem + st * 24576;
    const unsigned char* sB = sA + 8192;
    bf16x8 af[2];
#pragma unroll
    for (int mi = 0; mi < 2; ++mi) af[mi] = *(const bf16x8*)(sA + (32 * w + 16 * mi) * 64 + roff);
    {
      bf16x8 bfr[8];
#pragma unroll
      for (int ni = 0; ni < 8; ++ni) bfr[ni] = *(const bf16x8*)(sB + (16 * ni) * 64 + roff);
#pragma unroll
      for (int mi = 0; mi < 2; ++mi)
#pragma unroll
        for (int ni = 0; ni < 8; ++ni) acc0[mi][ni] = __builtin_amdgcn_mfma_f32_16x16x32_bf16(bfr[ni], af[mi], acc0[mi][ni], 0, 0, 0);
    }
    {
      bf16x8 bfr[8];
#pragma unroll
      for (int ni = 0; ni < 8; ++ni) bfr[ni] = *(const bf16x8*)(sB + (128 + 16 * ni) * 64 + roff);
#pragma unroll
      for (int mi = 0; mi < 2; ++mi)
#pragma unroll
        for (int ni = 0; ni < 8; ++ni) acc1[mi][ni] = __builtin_amdgcn_mfma_f32_16x16x32_bf16(bfr[ni], af[mi], acc1[mi][ni], 0, 0, 0);
    }
    st = st == 2 ? 0 : st + 1;
  }
#undef G2_ISSUE
}

constexpr size_t OFF_BAR = 0x28000;
#define XB_TMO      128
#define XB_XCNT(j)  (256  + 64 * (j))
#define XB_XSUB(j)  (1280 + 64 * (j))
#define XB_XGEN(j)  (2304 + 64 * (j))
#define XB_TOP      3328
#define XB_TOPGEN   3392
#define XCD_BAR_WORDS 3456
#define XB_SPIN_CAP (1u << 18)
#define LAS __attribute__((address_space(3)))

__device__ __forceinline__ unsigned xb_ld(unsigned* p)              { return __hip_atomic_load(p, __ATOMIC_RELAXED, __HIP_MEMORY_SCOPE_AGENT); }
__device__ __forceinline__ unsigned xb_add(unsigned* p, unsigned v) { return __hip_atomic_fetch_add(p, v, __ATOMIC_RELAXED, __HIP_MEMORY_SCOPE_AGENT); }
__device__ __forceinline__ unsigned xb_xcc_id() { return (unsigned)__builtin_amdgcn_s_getreg((3 << 11) | 20) & 0xFu; }
#define XB_SPIN(cond, bar) do { unsigned _sp = 0; while (cond) { __builtin_amdgcn_s_sleep(1); \
    if ((++_sp & 255u) == 0u) { if (xb_ld(&(bar)[XB_TMO])) break; if (_sp > XB_SPIN_CAP) { atomicAdd(&(bar)[XB_TMO], 1u); break; } } } } while (0)

struct XcdBarrier {
    unsigned* bar; unsigned x;
    volatile LAS unsigned* st;
};

__device__ __forceinline__ XcdBarrier xcd_barrier_post(unsigned* bar, volatile LAS unsigned* st) {
    XcdBarrier b; b.bar = bar; b.x = xb_xcc_id(); b.st = st;
    if (threadIdx.x == 0) (void)xb_add(&bar[XB_XCNT(b.x)], 1u);
    return b;
}
__device__ __forceinline__ void xcd_barrier_complete(unsigned* bar, unsigned x, unsigned& nloc, unsigned& nx) {
    const unsigned G = gridDim.x * gridDim.y * gridDim.z;
    unsigned sum, cnt, mine, sp = 0u;
    for (;;) {
        sum = 0u; cnt = 0u; mine = 0u;
#pragma unroll
        for (unsigned j = 0; j < 16; ++j) { const unsigned c = xb_ld(&bar[XB_XCNT(j)]); sum += c; cnt += (c > 0u) ? 1u : 0u; mine = (j == x) ? c : mine; }
        if (sum == G) break;
        __builtin_amdgcn_s_sleep(1);
        if ((++sp & 255u) == 0u) { if (xb_ld(&bar[XB_TMO])) break; if (sp > XB_SPIN_CAP) { atomicAdd(&bar[XB_TMO], 1u); break; } }
    }
    nloc = mine > 0u ? mine : 1u; nx = cnt > 0u ? cnt : 1u;
}

__device__ __forceinline__ void xcd_barrier(const XcdBarrier& b) {
    asm volatile("s_waitcnt vmcnt(0)" ::: "memory");
    __syncthreads();
    if (threadIdx.x == 0) {
        unsigned* bar = b.bar;
        __builtin_amdgcn_s_waitcnt(0);
        unsigned nloc = b.st[0], nx = b.st[1];
        if (nloc == 0u) { xcd_barrier_complete(bar, b.x, nloc, nx); b.st[0] = nloc; b.st[1] = nx; }
        const unsigned old = xb_add(&bar[XB_XSUB(b.x)], 1u);
        const unsigned gen = old / nloc;
        if (old + 1u == (gen + 1u) * nloc) {
            __builtin_amdgcn_fence(__ATOMIC_RELEASE, "agent");
            asm volatile("s_waitcnt vmcnt(0)" ::: "memory");
            const unsigned og = xb_add(&bar[XB_TOP], 1u);
            const unsigned tg = og / nx;
            if (og + 1u == (tg + 1u) * nx) xb_add(&bar[XB_TOPGEN], 1u);
            else XB_SPIN(xb_ld(&bar[XB_TOPGEN]) == tg, bar);
            __builtin_amdgcn_fence(__ATOMIC_ACQUIRE, "agent");
            xb_add(&bar[XB_XGEN(b.x)], 1u);
            asm volatile("s_waitcnt vmcnt(0)" ::: "memory");
        } else {
            XB_SPIN(xb_ld(&bar[XB_XGEN(b.x)]) == gen, bar);
            __builtin_amdgcn_fence(__ATOMIC_ACQUIRE, "agent");
            asm volatile("s_waitcnt vmcnt(0)" ::: "memory");
        }
    }
    __syncthreads();
}

DEV const float* xsrc_row(const Params& p, bool from_input, int r) {
  const int b = r / S_, s = r - b * S_;
  if (from_input) return s < CTX ? p.ctx + (size_t)(b * CTX + s) * D : p.x + (size_t)(b * SEQ + s - CTX) * D;
  return s < CTX ? (const float*)(p.ws + OFF_XC) + (size_t)(b * CTX + s) * D : p.out + (size_t)(b * SEQ + s - CTX) * D;
}
DEV float* xdst_row(const Params& p, int r) {
  const int b = r / S_, s = r - b * S_;
  return s < CTX ? (float*)(p.ws + OFF_XC) + (size_t)(b * CTX + s) * D : p.out + (size_t)(b * SEQ + s - CTX) * D;
}
DEV const float* mod_row(const Params& p, int layer, int r) {
  const int b = r / S_, s = r - b * S_;
  return (const float*)(p.ws + OFF_MOD) + (size_t)(layer * 3 + (s < CTX ? 2 : b)) * 6144;
}

DEV void transpose_tile(const float* W, int K, int N, bf16_t* WT, int remap, int kt, int nt, unsigned char* smem) {
  float* tile = (float*)smem;
  const int tid = threadIdx.x;
  __syncthreads();
#pragma unroll
  for (int i = 0; i < 4; ++i) {
    const int kk = (tid >> 4) + 16 * i, c4 = (tid & 15) * 4;
    const int n = nt * 64 + c4;
    int src = n;
    if (remap) src = n < 3072 ? n : (n < 3328 ? n + 24 : (n < 3352 ? n - 256 : -1));
    else if (n >= N) src = -1;
    f32x4 v = (f32x4){0.f, 0.f, 0.f, 0.f};
    if (src >= 0) v = *(const f32x4*)(W + (size_t)(kt * 64 + kk) * N + src);
    tile[kk * 65 + c4 + 0] = v[0]; tile[kk * 65 + c4 + 1] = v[1]; tile[kk * 65 + c4 + 2] = v[2]; tile[kk * 65 + c4 + 3] = v[3];
  }
  __syncthreads();
  const int n = tid >> 2, kc = (tid & 3) * 16;
  uint4 o0, o1;
  const float* t = tile + kc * 65 + n;
  o0.x = pk2(t[0 * 65], t[1 * 65]); o0.y = pk2(t[2 * 65], t[3 * 65]); o0.z = pk2(t[4 * 65], t[5 * 65]); o0.w = pk2(t[6 * 65], t[7 * 65]);
  o1.x = pk2(t[8 * 65], t[9 * 65]); o1.y = pk2(t[10 * 65], t[11 * 65]); o1.z = pk2(t[12 * 65], t[13 * 65]); o1.w = pk2(t[14 * 65], t[15 * 65]);
  bf16_t* dst = WT + (size_t)(nt * 64 + n) * (K + 64) + kt * 64 + kc;
  *(uint4*)dst = o0; *(uint4*)(dst + 8) = o1;
}
DEV void transpose_mat(const float* Wm, int K, int N, int Npad, bf16_t* dst, int remap, unsigned char* smem, int b0, int nb) {
  const int nkt = K / 64, nnt = Npad / 64;
  if ((int)blockIdx.x < b0) return;
  for (int t = blockIdx.x - b0; t < nkt * nnt; t += nb) transpose_tile(Wm, K, N, dst, remap, t / nnt, t % nnt, smem);
}
DEV void convert_weights(const Params& p, int part, unsigned char* smem, int b0, int nb) {
  unsigned char* wt = p.ws + OFF_WT; unsigned char* wt2 = p.ws + OFF_WT2;
  if (part == 0) { transpose_mat(p.w_in_even, 1024, 3352, 3584, (bf16_t*)(wt + WT_IN), 1, smem, b0, nb); return; }
  transpose_mat(p.w_out_even, 1024, 1024, 1024, (bf16_t*)(wt + WT_OUT), 0, smem, b0, nb);
  transpose_mat(p.w_ff1, 1024, 4096, 4096, (bf16_t*)(wt + WT_FF1), 0, smem, b0, nb);
  transpose_mat(p.w_ff2, 4096, 1024, 1024, (bf16_t*)(wt + WT_FF2), 0, smem, b0, nb);
  transpose_mat(p.w_in_odd, 1024, 2816, 2816, (bf16_t*)(wt2 + WT_IN), 0, smem, b0, nb);
  transpose_mat(p.w_out_odd, 1024, 1024, 1024, (bf16_t*)(wt2 + WT_OUT), 0, smem, b0, nb);
  transpose_mat(p.w_ff1 + (size_t)1024 * 4096, 1024, 4096, 4096, (bf16_t*)(wt2 + WT_FF1), 0, smem, b0, nb);
  transpose_mat(p.w_ff2 + (size_t)1024 * 4096, 4096, 1024, 1024, (bf16_t*)(wt2 + WT_FF2), 0, smem, b0, nb);
}

DEV void mod_phase(const Params& p, unsigned char* smem) {
  float* MOD = (float*)(p.ws + OFF_MOD);
  float* sS = (float*)smem;
  float* red = sS + 3072;
  const int tid = threadIdx.x, cl = tid & 31, kg = tid >> 5;
  if ((int)blockIdx.x >= 2 * 192) return;
  __syncthreads();
  for (int i = tid; i < 3072; i += 256) { const int v = i >> 10, k = i & 1023; sS[i] = siluf_(v == 0 ? p.c[k] : (v == 1 ? p.c[1024 + k] : p.c_ctx[k])); }
  __syncthreads();
  for (int it = blockIdx.x; it < 2 * 192; it += gridDim.x) {
    const int l = it / 192, n = (it % 192) * 32 + cl;
    const float* W = p.w_mod + (size_t)l * 1024 * 6144 + n;
    float a0 = 0.f, a1 = 0.f, a2 = 0.f;
#pragma unroll 16
    for (int k = kg * 128; k < kg * 128 + 128; ++k) {
      const float wv = W[(size_t)k * 6144];
      a0 += sS[k] * wv; a1 += sS[1024 + k] * wv; a2 += sS[2048 + k] * wv;
    }
    __syncthreads();
    red[(kg * 32 + cl) * 3 + 0] = a0; red[(kg * 32 + cl) * 3 + 1] = a1; red[(kg * 32 + cl) * 3 + 2] = a2;
    __syncthreads();
    if (kg == 0) {
      const float bv = p.b_mod[l * 6144 + n];
#pragma unroll
      for (int v = 0; v < 3; ++v) {
        float sacc = 0.f;
#pragma unroll
        for (int g2 = 0; g2 < 8; ++g2) sacc += red[(g2 * 32 + cl) * 3 + v];
        MOD[(l * 3 + v) * 6144 + n] = sacc + bv;
      }
    }
  }
}
DEV void rope_phase(const Params& p) {
  float* ct = (float*)(p.ws + OFF_ROPE);
  float* st = ct + 8192 * 32;
  for (int i = blockIdx.x * 256 + threadIdx.x; i < 8192 * 32; i += gridDim.x * 256) {
    const int t = i >> 5, d = i & 31;
    const float pos = (d < 16) ? (float)(t >> 6) : (float)(t & 63);
    const float inv = powf(10000.f, -(float)(d & 15) / 16.f);
    const float ang = pos * inv;
    ct[i] = cosf(ang); st[i] = sinf(ang);
  }
}

constexpr size_t A_PART = 0x8700000;
DEV void norm_phase(const Params& p, int layer, int which, bool from_input, bool skip_ctx, int ctx_fix = 0) {
  const int lane = threadIdx.x & 63;
  const int gw = blockIdx.x * 4 + (threadIdx.x >> 6), ngw = gridDim.x * 4;
  const float* g = p.g_norm + (layer * 2 + which) * D;
  bf16_t* H = (bf16_t*)(p.ws + OFF_H);
  for (int r = gw; r < M; r += ngw) {
    const int s = r % S_;
    if (skip_ctx && s < CTX) continue;
    const bool fix = ctx_fix && s < CTX;
    const f32x4* xr = (const f32x4*)xsrc_row(p, fix ? (ctx_fix == 1) : from_input, r) + lane;
    const float* mv = mod_row(p, layer, r) + which * 3 * 1024;
    f32x4 v[4]; float ss = 0.f;
#pragma unroll
    for (int j = 0; j < 4; ++j) v[j] = xr[64 * j];
    if (fix) {
      const int rc = (r / S_) * CTX + s;
      const f32x4* pp = (const f32x4*)(p.ws + OFF_AR + A_PART) + (size_t)rc * 256 + lane;
      f32x4* xw = (f32x4*)xdst_row(p, r) + lane;
#pragma unroll
      for (int j = 0; j < 4; ++j) {
        v[j] += (pp[64 * j] + pp[(size_t)512 * 256 + 64 * j]) + (pp[(size_t)2 * 512 * 256 + 64 * j] + pp[(size_t)3 * 512 * 256 + 64 * j]);
        xw[64 * j] = v[j];
      }
    }
#pragma unroll
    for (int j = 0; j < 4; ++j) ss += v[j][0] * v[j][0] + v[j][1] * v[j][1] + v[j][2] * v[j][2] + v[j][3] * v[j][3];
    const float rstd = rsqrtf(wsum(ss) * (1.f / D) + EPS);
    uint2* o = (uint2*)(H + (size_t)r * LDH) + lane;
#pragma unroll
    for (int j = 0; j < 4; ++j) {
      const int c = 4 * lane + 256 * j;
      const f32x4 gg = *(const f32x4*)(g + c), sh = *(const f32x4*)(mv + c), sc = *(const f32x4*)(mv + 1024 + c);
      float y[4];
#pragma unroll
      for (int e = 0; e < 4; ++e) y[e] = v[j][e] * rstd * gg[e] * (1.f + sc[e]) + sh[e];
      uint2 w2; w2.x = pk2(y[0], y[1]); w2.y = pk2(y[2], y[3]);
      o[64 * j] = w2;
    }
  }
}

template <class Epi>
DEV void gemm_phase(const bf16_t* A, int lda, const bf16_t* Bt, int K, int MT, int NT, bool skip_ctx, Epi epi, unsigned char* smem) {
  const int ldb = K + 64;
  const int MTv = skip_ctx ? MT - 2 * NB : MT;
  const int nwg = MTv * NT;
  for (int t = blockIdx.x; t < nwg; t += gridDim.x) {
    int wgid = t;
    { const int q = nwg / 8, r8 = nwg % 8, xcd = wgid % 8, off = wgid / 8; wgid = (xcd < r8 ? xcd * (q + 1) : r8 * (q + 1) + (xcd - r8) * q) + off; }
    const int nig = 8 * NT, gid = wgid / nig, fm = gid * 8, gsz = (MTv - fm) < 8 ? (MTv - fm) : 8;
    int mt = fm + (wgid % nig) % gsz; const int nt = (wgid % nig) / gsz;
    if (skip_ctx) mt = (mt / (NCH - 2)) * NCH + 2 + (mt % (NCH - 2));
    f32x4 acc[2][8]; zero_acc(acc);
    const bf16_t* Ab = A + (size_t)mt * 128 * lda;
    const bf16_t* Bb = Bt + (size_t)nt * 128 * ldb;
    block_gemm_glds(acc, K / 64, Ab, (size_t)lda, Bb, (size_t)ldb, smem);
    epi(acc, mt, nt);
  }
}

template <class Epi>
DEV void gemm_phase2(const bf16_t* A, int lda, const bf16_t* Bt, int K, int MT, int NP, bool skip_ctx, Epi epi, unsigned char* smem) {
  const int ldb = K + 64;
  const int MTv = skip_ctx ? MT - 2 * NB : MT;
  for (int t = blockIdx.x; t < MTv * NP; t += gridDim.x) {
    int mt = t / NP; const int np = t % NP;
    if (skip_ctx) mt = (mt / (NCH - 2)) * NCH + 2 + (mt % (NCH - 2));
    f32x4 acc0[2][8], acc1[2][8]; zero_acc(acc0); zero_acc(acc1);
    block_gemm_glds2(acc0, acc1, K / 32, A + (size_t)mt * 128 * lda, (size_t)lda, Bt + (size_t)np * 256 * ldb, (size_t)ldb, smem);
    epi(acc0, mt, 2 * np);
    epi(acc1, mt, 2 * np + 1);
  }
}

#define EPI_COORDS const int lane = threadIdx.x & 63, w = threadIdx.x >> 6, fr = lane & 15, fq = lane >> 4; (void)w; (void)fr; (void)fq;

DEV void store_bf16_row(bf16_t* base, size_t ld, int row, int col, const f32x4& v) {
  uint2 o; o.x = pk2(v[0], v[1]); o.y = pk2(v[2], v[3]);
  *(uint2*)(base + (size_t)row * ld + col) = o;
}
DEV void store_bf16_T(bf16_t* base, int col, int s, const f32x4& v) {
#pragma unroll
  for (int j = 0; j < 4; ++j) base[(size_t)(col + j) * S_ + s] = f2bf(v[j]);
}

struct GateScan { float a0, a1, b0, b1, pm0, pm1, F, amax; int pos0, pos1; };
DEV GateScan gate_scan(const float* G, const int r0, const int dir, const int h, const int lane) {
  GateScan g;
  const int j0 = 2 * lane, j1 = j0 + 1;
  g.pos0 = dir ? 127 - j0 : j0; g.pos1 = dir ? 127 - j1 : j1;
  const float i0 = G[(size_t)(r0 + g.pos0) * 24 + (dir * 2) * 6 + h], f0 = G[(size_t)(r0 + g.pos0) * 24 + (dir * 2 + 1) * 6 + h];
  const float i1 = G[(size_t)(r0 + g.pos1) * 24 + (dir * 2) * 6 + h], f1 = G[(size_t)(r0 + g.pos1) * 24 + (dir * 2 + 1) * 6 + h];
  const float lf0 = logsigf_(f0), lf1 = logsigf_(f1);
  const float s0 = lf0, s1 = lf0 + lf1;
  float tot = s1;
#pragma unroll
  for (int d = 1; d < 64; d <<= 1) { const float y = __shfl_up(tot, d); if (lane >= d) tot += y; }
  const float excl = tot - s1;
  g.b0 = s0 + excl; g.b1 = s1 + excl;
  g.F = __shfl(tot, 63);
  g.a0 = i0 - g.b0; g.a1 = i1 - g.b1;
  const float q0 = g.a0, q1 = fmaxf(g.a0, g.a1);
  float t = q1;
#pragma unroll
  for (int d = 1; d < 64; d <<= 1) { const float y = __shfl_up(t, d); if (lane >= d) t = fmaxf(t, y); }
  float ex = __shfl_up(t, 1); if (lane == 0) ex = -INFINITY;
  g.pm0 = fmaxf(q0, ex); g.pm1 = fmaxf(q1, ex);
  g.amax = __shfl(t, 63);
  return g;
}
DEV int chunk_ord(int dir, int i) { return dir == 0 ? i : (i < 2 ? 1 - i : 67 - i); }

template <int ph>
DEV void run_phase(const Params& p, unsigned char* smem) {
  const int tid = threadIdx.x, lane = tid & 63, w = tid >> 6, fr = lane & 15, fq = lane >> 4;
  unsigned char* ws = p.ws;
  bf16_t* const WT = (bf16_t*)(ws + (ph >= 11 ? OFF_WT2 : OFF_WT));
  bf16_t* const Hb = (bf16_t*)(ws + OFF_H);
  float* const Gt = (float*)(ws + OFF_G);
  float* const CS = (float*)(ws + OFF_CS);
  float* const MS = (float*)(ws + OFF_MS);
  float* const NV = (float*)(ws + OFF_NV);
  unsigned char* const AR = ws + OFF_AR;
  unsigned char* const DO = (unsigned char*)p.out;
  float* const sF = (float*)(smem + LDS_F);
  bf16_t* const sP = (bf16_t*)(smem + LDS_P);

    switch (ph) {
    case 0: {
      convert_weights(p, 0, smem, 0, gridDim.x);
      mod_phase(p, smem);
      rope_phase(p);
    } break;
    case 1: norm_phase(p, 0, 0, true, false); break;
    case 2: {
      bf16_t* QK = (bf16_t*)(AR + A0_QK); bf16_t* Vt = (bf16_t*)(AR + A0_VT); bf16_t* Ob = (bf16_t*)(AR + A0_O); bf16_t* Fb = (bf16_t*)(DO + DO_F);
      const float* bg = p.b_gate;
      auto epi = [&](f32x4 (&acc)[2][8], int mt, int nt) {
        const int b = mt / NCH;
        const int row0 = mt * 128 + 32 * w + fr, col0 = nt * 128 + 4 * fq;
        if (nt < 12 || (nt >= 18 && nt < 26)) {
          bf16_t* tb; int ld;
          if (nt < 12) { tb = QK + (size_t)row0 * 1536 + col0; ld = 1536; }
          else if (nt < 24) { tb = Ob + (size_t)row0 * 768 + (col0 - 2304); ld = 768; }
          else { tb = Fb + (size_t)row0 * 256 + (col0 - 3072); ld = 256; }
#pragma unroll
          for (int mi = 0; mi < 2; ++mi)
#pragma unroll
            for (int ni = 0; ni < 8; ++ni) {
              uint2 o; o.x = pk2(acc[mi][ni][0], acc[mi][ni][1]); o.y = pk2(acc[mi][ni][2], acc[mi][ni][3]);
              *(uint2*)(tb + (size_t)(16 * mi) * ld + 16 * ni) = o;
            }
        } else if (nt < 18) {
          bf16_t* tb = Vt + (size_t)b * 768 * S_ + (size_t)(col0 - 1536) * S_ + (row0 - b * S_);
#pragma unroll
          for (int mi = 0; mi < 2; ++mi)
#pragma unroll
            for (int ni = 0; ni < 8; ++ni)
#pragma unroll
              for (int j = 0; j < 4; ++j) tb[(size_t)(16 * ni + j) * S_ + 16 * mi] = f2bf(acc[mi][ni][j]);
        } else if (nt == 26) {
#pragma unroll
          for (int mi = 0; mi < 2; ++mi)
#pragma unroll
            for (int ni = 0; ni < 2; ++ni) {
              const int gc = 16 * ni + 4 * fq;
              if (gc < 24) { f32x4 o = acc[mi][ni]; o += *(const f32x4*)(bg + gc); *(f32x4*)(Gt + (size_t)(row0 + 16 * mi) * 24 + gc) = o; }
            }
        }
      };
      gemm_phase(Hb, LDH, (const bf16_t*)((unsigned char*)WT + WT_IN), D, M / 128, 27, false, epi, smem);
    } break;
    case 3: {
      const bf16_t* QK = (const bf16_t*)(AR + A0_QK);
      bf16_t* Qc = (bf16_t*)(AR + A0_QC); bf16_t* Kc = (bf16_t*)(AR + A0_KC); bf16_t* KcT = (bf16_t*)(DO + DO_KCT);
      bf16_t* ZT = (bf16_t*)(DO + DO_ZT); const bf16_t* Fb = (const bf16_t*)(DO + DO_F);
      for (int t = blockIdx.x; t < (M / 128) * 4; t += gridDim.x) {
        const int mt = t >> 2, g = t & 3;
        f32x4 acc[2][8]; zero_acc(acc);
        block_gemm<false>(acc, 1,
            [&](int row, int k) { return *(const uint4*)(Fb + (size_t)(mt * 128 + row) * 256 + g * 64 + k); },
            [&](int row, int k) {
              const int cp = row & 63, im = row >> 6; float vv[8];
#pragma unroll
              for (int j = 0; j < 8; ++j) { const int mm = (cp * (k + j)) & 63; const float xx = (float)mm * (1.f / 64.f); vv[j] = im ? -__builtin_amdgcn_sinf(xx) : __builtin_amdgcn_cosf(xx); }
              uint4 o; o.x = pk2(vv[0], vv[1]); o.y = pk2(vv[2], vv[3]); o.z = pk2(vv[4], vv[5]); o.w = pk2(vv[6], vv[7]); return o;
            }, smem, nullptr, 0);
        const int b = mt / NCH;
#pragma unroll
        for (int mi = 0; mi < 2; ++mi)
#pragma unroll
          for (int ni = 0; ni < 8; ++ni) {
            const int row = mt * 128 + 32 * w + 16 * mi + fr, s = row - b * S_;
#pragma unroll
            for (int j = 0; j < 4; ++j) {
              const int n = 16 * ni + 4 * fq + j, cp = n & 63, im = n >> 6;
              ZT[(size_t)((b * 256 + g * 64 + cp) * 2 + im) * S_ + s] = f2bf(acc[mi][ni][j]);
            }
          }
      }
      bf16_t* tl = (bf16_t*)smem;
      for (int t = blockIdx.x; t < (M / 64) * 12; t += gridDim.x) {
        const int rt = t / 12, ct = t % 12;
        const int r0 = rt * 64, b = r0 / S_, s0 = r0 - b * S_;
        const int lo = (s0 < CTX) ? 0 : CTX, hi = (s0 < CTX) ? CTX - 1 : S_ - 1;
        __syncthreads();
#pragma unroll
        for (int i = 0; i < 4; ++i) {
          const int id = tid + 256 * i, rr = id >> 4, cc = (id & 15) * 8;
          const int s = s0 + rr, c = ct * 128 + cc;
          const size_t base = (size_t)(r0 + rr) * 1536 + c;
          uint4 z = {0u, 0u, 0u, 0u};
          const uint4 u1 = *(const uint4*)(QK + base);
          const uint4 u0 = (s - 1 >= lo) ? *(const uint4*)(QK + base - 1536) : z;
          const uint4 u2 = (s + 1 <= hi) ? *(const uint4*)(QK + base + 1536) : z;
          const unsigned a0[4] = {u0.x, u0.y, u0.z, u0.w}, a1[4] = {u1.x, u1.y, u1.z, u1.w}, a2[4] = {u2.x, u2.y, u2.z, u2.w};
          float o[8];
#pragma unroll
          for (int e = 0; e < 4; ++e) {
            const int c0 = c + 2 * e;
            const float w00 = p.w_qk_conv[c0], w10 = p.w_qk_conv[1536 + c0], w20 = p.w_qk_conv[3072 + c0];
            const float w01 = p.w_qk_conv[c0 + 1], w11 = p.w_qk_conv[1536 + c0 + 1], w21 = p.w_qk_conv[3072 + c0 + 1];
            o[2 * e] = siluf_(w00 * bflo(a0[e]) + w10 * bflo(a1[e]) + w20 * bflo(a2[e]));
            o[2 * e + 1] = siluf_(w01 * bfhi(a0[e]) + w11 * bfhi(a1[e]) + w21 * bfhi(a2[e]));
          }
          if (ct < 6) {
            const float sc = 0.08838834764831845f;
            uint4 q; q.x = pk2(o[0] * sc, o[1] * sc); q.y = pk2(o[2] * sc, o[3] * sc); q.z = pk2(o[4] * sc, o[5] * sc); q.w = pk2(o[6] * sc, o[7] * sc);
            *(uint4*)(Qc + (size_t)(r0 + rr) * 768 + c) = q;
          } else {
            uint4 q; q.x = pk2(o[0], o[1]); q.y = pk2(o[2], o[3]); q.z = pk2(o[4], o[5]); q.w = pk2(o[6], o[7]);
            *(uint4*)(Kc + (size_t)(r0 + rr) * 768 + c - 768) = q;
#pragma unroll
            for (int e = 0; e < 8; ++e) tl[(cc + e) * LDT + rr] = f2bf(o[e]);
          }
        }
        __syncthreads();
        if (ct >= 6) {
#pragma unroll
          for (int i = 0; i < 4; ++i) {
            const int id = tid + 256 * i, cc = id >> 3, sc8 = (id & 7) * 8;
            const uint4 v = *(const uint4*)&tl[cc * LDT + sc8];
            *(uint4*)(KcT + (size_t)(b * 768 + (ct - 6) * 128 + cc) * S_ + s0 + sc8) = v;
          }
        }
      }
    } break;
    case 4: {
      const bf16_t* ZT = (const bf16_t*)(DO + DO_ZT);
      const int NF = 512 + 8;
      bf16_t* ApT = (bf16_t*)(DO + DO_F);
      const bf16_t* Vt = (const bf16_t*)(AR + A0_VT); const bf16_t* KcT = (const bf16_t*)(DO + DO_KCT); const bf16_t* Kc = (const bf16_t*)(AR + A0_KC);
      bf16_t* ST = (bf16_t*)(AR + A0_ST);
      for (int t = blockIdx.x; t < NF + 24 * NCH; t += gridDim.x) {
        if (t < 512) {
          const int mt = t & 1, ct = t >> 1;
          f32x4 acc[2][8]; zero_acc(acc);
          block_gemm<false>(acc, 4,
              [&](int row, int k) {
                const int p1 = mt * 64 + (row >> 1), op = row & 1, part = k >> 7, t1 = k & 127; float vv[8];
#pragma unroll
                for (int j = 0; j < 8; ++j) {
                  const float xx = (float)((p1 * (t1 + j)) & 127) * (1.f / 128.f);
                  const float cv = __builtin_amdgcn_cosf(xx), sv = __builtin_amdgcn_sinf(xx);
                  vv[j] = op == 0 ? (part == 0 ? cv : sv) : (part == 0 ? -sv : cv);
                }
                uint4 o; o.x = pk2(vv[0], vv[1]); o.y = pk2(vv[2], vv[3]); o.z = pk2(vv[4], vv[5]); o.w = pk2(vv[6], vv[7]); return o;
              },
              [&](int row, int k) {
                const int n = 2 * ct + (row >> 6), t2 = row & 63, part = k >> 7, t1 = k & 127;
                const bf16_t* src = ZT + (size_t)(n * 2 + part) * S_ + CTX + 64 * t1 + t2;
                unsigned e[8];
#pragma unroll
                for (int j = 0; j < 8; ++j) e[j] = src[64 * j];
                uint4 o; o.x = e[0] | (e[1] << 16); o.y = e[2] | (e[3] << 16); o.z = e[4] | (e[5] << 16); o.w = e[6] | (e[7] << 16); return o;
              }, smem, nullptr, 0);
#pragma unroll
          for (int mi = 0; mi < 2; ++mi) {
            const int row = 32 * w + 16 * mi + fr, p1 = mt * 64 + (row >> 1), op = row & 1;
#pragma unroll
            for (int ni = 0; ni < 8; ++ni) {
              const int col = 16 * ni + 4 * fq, n = 2 * ct + (col >> 6), t2 = col & 63;
              f32x4 v = acc[mi][ni], o;
#pragma unroll
              for (int j = 0; j < 4; ++j) {
                const float other = __shfl_xor(v[j], 1);
                const float xx = (float)((p1 * (t2 + j)) & 8191) * (1.f / 8192.f);
                const float cv = __builtin_amdgcn_cosf(xx), sv = __builtin_amdgcn_sinf(xx);
                o[j] = op == 0 ? (v[j] * cv + other * sv) : (v[j] * cv - other * sv);
              }
              store_bf16_row(ApT, 128, p1 * 512 + n, op * 64 + t2, o);
            }
          }
        } else if (t < NF) {
          const int tt = t - 512, mt = tt >> 2, nt = tt & 3;
          const int T = 256, tmask = T - 1;
          const float invT = 1.f / (float)T;
          f32x4 acc[2][8]; zero_acc(acc);
          block_gemm<false>(acc, 2 * T / 64,
              [&](int row, int k) {
                const int pp = mt * 128 + row, part = k >= T, t0 = k & tmask; float vv[8];
#pragma unroll
                for (int j = 0; j < 8; ++j) { const int mm = (pp * (t0 + j)) & tmask; const float xx = (float)mm * invT; vv[j] = part ? __builtin_amdgcn_sinf(xx) : __builtin_amdgcn_cosf(xx); }
                uint4 o; o.x = pk2(vv[0], vv[1]); o.y = pk2(vv[2], vv[3]); o.z = pk2(vv[4], vv[5]); o.w = pk2(vv[6], vv[7]); return o;
              },
              [&](int row, int k) { const int part = k >= T, t0 = k & tmask; return *(const uint4*)(ZT + (size_t)((nt * 128 + row) * 2 + part) * S_ + t0); },
              smem, nullptr, 0);
#pragma unroll
          for (int mi = 0; mi < 2; ++mi)
#pragma unroll
            for (int ni = 0; ni < 8; ++ni) {
              const int pp = mt * 128 + 32 * w + 16 * mi + fr, n = nt * 128 + 16 * ni + 4 * fq, b = n >> 8;
              f32x4 v = acc[mi][ni]; v *= (1.f / 128.f);
              store_bf16_row(Hb, LDH, b * S_ + pp, 768 + (n & 255), v);
            }
        } else {
          const int ta = t - NF, sd = ta / NCH, n = ta % NCH;
          const int dir = sd / 12, b = (sd / 6) & 1, h = sd % 6;
          const int r0 = b * S_ + n * 128;
          float* sW = sF;
          __syncthreads();
          if (w == 0) {
            const GateScan g = gate_scan(Gt, r0, dir, h, lane);
            sW[g.pos0] = __expf(g.a0 - g.amax); sW[g.pos1] = __expf(g.a1 - g.amax);
            if (lane == 0) { CS[(sd * NCH + n) * 4 + 0] = g.amax; CS[(sd * NCH + n) * 4 + 1] = g.F; }
          }
          __syncthreads();
          f32x4 acc[2][8]; zero_acc(acc);
          const bf16_t* Ab = Vt + (size_t)(b * 768 + h * 128) * S_ + n * 128;
          const bf16_t* Bb = KcT + (size_t)(b * 768 + h * 128) * S_ + n * 128;
          block_gemm<false>(acc, 2,
              [&](int row, int k) { return *(const uint4*)(Ab + (size_t)row * S_ + k); },
              [&](int row, int k) {
                const uint4 u = *(const uint4*)(Bb + (size_t)row * S_ + k);
                uint4 o;
                o.x = pk2(bflo(u.x) * sW[k], bfhi(u.x) * sW[k + 1]); o.y = pk2(bflo(u.y) * sW[k + 2], bfhi(u.y) * sW[k + 3]);
                o.z = pk2(bflo(u.z) * sW[k + 4], bfhi(u.z) * sW[k + 5]); o.w = pk2(bflo(u.w) * sW[k + 6], bfhi(u.w) * sW[k + 7]);
                return o;
              }, smem, nullptr, 0);
          bf16_t* Sd = ST + (size_t)(sd * NCH + n) * 16384;
#pragma unroll
          for (int mi = 0; mi < 2; ++mi)
#pragma unroll
            for (int ni = 0; ni < 8; ++ni) store_bf16_row(Sd, 128, 32 * w + 16 * mi + fr, 16 * ni + 4 * fq, acc[mi][ni]);
          if (tid < 128) {
            int tix = tid; asm volatile("" : "+v"(tix));
            const uint4* krow = (const uint4*)(KcT + (size_t)(b * 768 + h * 128 + tix) * S_ + n * 128);
            float a = 0.f;
#pragma unroll
            for (int c = 0; c < 16; ++c) {
              const uint4 u = krow[c]; const float* ww = sW + 8 * c;
              a += bflo(u.x) * ww[0] + bfhi(u.x) * ww[1] + bflo(u.y) * ww[2] + bfhi(u.y) * ww[3] + bflo(u.z) * ww[4] + bfhi(u.z) * ww[5] + bflo(u.w) * ww[6] + bfhi(u.w) * ww[7];
            }
            NV[(size_t)(sd * NCH + n) * 128 + tix] = a;
          }
        }
      }
    } break;
    case 5: {
      {
        const bf16_t* ApT = (const bf16_t*)(DO + DO_F);
        for (int t = blockIdx.x; t < 512; t += gridDim.x) {
          const int p1 = t >> 2, n0 = (t & 3) * 128;
          f32x4 acc[2][8]; zero_acc(acc);
          block_gemm<false>(acc, 2,
              [&](int row, int k) { return *(const uint4*)(ApT + (size_t)(t * 128 + row) * 128 + k); },
              [&](int row, int k) {
                uint4 o = {0u, 0u, 0u, 0u};
                if (row < 64) {
                  const int part = k >> 6, t2 = k & 63; float vv[8];
#pragma unroll
                  for (int j = 0; j < 8; ++j) { const float xx = (float)((row * (t2 + j)) & 63) * (1.f / 64.f); vv[j] = part ? __builtin_amdgcn_sinf(xx) : __builtin_amdgcn_cosf(xx); }
                  o.x = pk2(vv[0], vv[1]); o.y = pk2(vv[2], vv[3]); o.z = pk2(vv[4], vv[5]); o.w = pk2(vv[6], vv[7]);
                }
                return o;
              }, smem, nullptr, 0);
#pragma unroll
          for (int mi = 0; mi < 2; ++mi) {
            const int n = n0 + 32 * w + 16 * mi + fr, b = n >> 8;
#pragma unroll
            for (int ni = 0; ni < 4; ++ni)
#pragma unroll
              for (int j = 0; j < 4; ++j) {
                const int p2 = 16 * ni + 4 * fq + j;
                Hb[(size_t)(b * S_ + CTX + p1 + 128 * p2) * LDH + 768 + (n & 255)] = f2bf(acc[mi][ni][j] * 0.0013810679320049757f);
              }
          }
        }
      }
      if (gridDim.x >= 400) convert_weights(p, 1, smem, 200, gridDim.x - 200); else convert_weights(p, 1, smem, 0, gridDim.x);
      bf16_t* ST = (bf16_t*)(AR + A0_ST);
      for (int e = blockIdx.x * 256 + tid; e < 24 * 2064; e += gridDim.x * 256) {
        const int sd = e / 2064, idx = e % 2064, dir = sd / 12;
        float cst[8];
#pragma unroll
        for (int j = 0; j < 8; ++j) cst[j] = 0.f;
        float m = 0.f;
        uint4 ring0[4], ring1[4]; float ra[4], rf[4];
#define SC_FETCH(i_, u_) do { const int n_ = chunk_ord(dir, (i_)); ra[u_] = CS[(sd * NCH + n_) * 4 + 0]; rf[u_] = CS[(sd * NCH + n_) * 4 + 1]; \
          if (idx < 2048) ring0[u_] = *(const uint4*)(ST + (size_t)(sd * NCH + n_) * 16384 + idx * 8); \
          else { const uint4* q_ = (const uint4*)(NV + (size_t)(sd * NCH + n_) * 128 + (idx - 2048) * 8); ring0[u_] = q_[0]; ring1[u_] = q_[1]; } } while (0)
#pragma unroll
        for (int u = 0; u < 4; ++u) { ring1[u] = uint4{0u, 0u, 0u, 0u}; SC_FETCH(u, u); }
        for (int i0 = 0; i0 < NCH; i0 += 4) {
#pragma unroll
          for (int u = 0; u < 4; ++u) {
            const int i = i0 + u;
            if (i < NCH) {
              const int n = chunk_ord(dir, i);
              const float amax = ra[u], F = rf[u];
              const uint4 c0 = ring0[u], c1 = ring1[u];
              if (i + 4 < NCH) SC_FETCH(i + 4, u);
              const float Mx = fmaxf(m, amax), dcy = __expf(m - Mx), scl = __expf(amax - Mx);
              if (idx < 2048) {
                uint4* ptr = (uint4*)(ST + (size_t)(sd * NCH + n) * 16384 + idx * 8);
                uint4 o; o.x = pk2(cst[0], cst[1]); o.y = pk2(cst[2], cst[3]); o.z = pk2(cst[4], cst[5]); o.w = pk2(cst[6], cst[7]);
                *ptr = o;
                cst[0] = dcy * cst[0] + scl * bflo(c0.x); cst[1] = dcy * cst[1] + scl * bfhi(c0.x);
                cst[2] = dcy * cst[2] + scl * bflo(c0.y); cst[3] = dcy * cst[3] + scl * bfhi(c0.y);
                cst[4] = dcy * cst[4] + scl * bflo(c0.z); cst[5] = dcy * cst[5] + scl * bfhi(c0.z);
                cst[6] = dcy * cst[6] + scl * bflo(c0.w); cst[7] = dcy * cst[7] + scl * bfhi(c0.w);
              } else {
                uint4* ptr = (uint4*)(NV + (size_t)(sd * NCH + n) * 128 + (idx - 2048) * 8);
                uint4 o0, o1;
                o0.x = __float_as_uint(cst[0]); o0.y = __float_as_uint(cst[1]); o0.z = __float_as_uint(cst[2]); o0.w = __float_as_uint(cst[3]);
                o1.x = __float_as_uint(cst[4]); o1.y = __float_as_uint(cst[5]); o1.z = __float_as_uint(cst[6]); o1.w = __float_as_uint(cst[7]);
                ptr[0] = o0; ptr[1] = o1;
                cst[0] = dcy * cst[0] + scl * __uint_as_float(c0.x); cst[1] = dcy * cst[1] + scl * __uint_as_float(c0.y);
                cst[2] = dcy * cst[2] + scl * __uint_as_float(c0.z); cst[3] = dcy * cst[3] + scl * __uint_as_float(c0.w);
                cst[4] = dcy * cst[4] + scl * __uint_as_float(c1.x); cst[5] = dcy * cst[5] + scl * __uint_as_float(c1.y);
                cst[6] = dcy * cst[6] + scl * __uint_as_float(c1.z); cst[7] = dcy * cst[7] + scl * __uint_as_float(c1.w);
              }
              if (idx == 0) MS[sd * NCH + n] = m;
              m = F + Mx;
            }
          }
        }
#undef SC_FETCH
      }
    } break;
    case 6: {
      const bf16_t* Vt = (const bf16_t*)(AR + A0_VT); const bf16_t* Qc = (const bf16_t*)(AR + A0_QC); const bf16_t* Kc = (const bf16_t*)(AR + A0_KC);
      const bf16_t* ST = (const bf16_t*)(AR + A0_ST); const bf16_t* Ob = (const bf16_t*)(AR + A0_O);
      float* aA = sF; float* aM = sF + 256; float* aI = sF + 512; float* aE = sF + 768; float* sN = sF + 1024; float* sQN = sF + 1280; float* sSC = sF + 1536;
      for (int t = blockIdx.x; t < 12 * NCH; t += gridDim.x) {
        const int bh = t / NCH, n = t % NCH, b = bh / 6, h = bh % 6;
        const int r0 = b * S_ + n * 128;
        __syncthreads();
        if (w < 2) {
          const int dir = w, sd = (dir * 2 + b) * 6 + h;
          const GateScan g = gate_scan(Gt, r0, dir, h, lane);
          const float mp = MS[sd * NCH + n];
          const float M0 = fmaxf(mp, g.pm0), M1 = fmaxf(mp, g.pm1);
          aA[dir * 128 + g.pos0] = __expf(g.a0 - g.amax); aA[dir * 128 + g.pos1] = __expf(g.a1 - g.amax);
          aM[dir * 128 + g.pos0] = __expf(g.amax - M0); aM[dir * 128 + g.pos1] = __expf(g.amax - M1);
          aI[dir * 128 + g.pos0] = __expf(mp - M0); aI[dir * 128 + g.pos1] = __expf(mp - M1);
          aE[dir * 128 + g.pos0] = __expf(-(g.b0 + M0)); aE[dir * 128 + g.pos1] = __expf(-(g.b1 + M1));
        } else {
          const int dir = w - 2, sd = (dir * 2 + b) * 6 + h;
          sN[dir * 128 + lane] = NV[(size_t)(sd * NCH + n) * 128 + lane];
          sN[dir * 128 + 64 + lane] = NV[(size_t)(sd * NCH + n) * 128 + 64 + lane];
        }
        __syncthreads();
        const bf16_t* Qb = Qc + (size_t)r0 * 768 + h * 128;
        const bf16_t* Kb = Kc + (size_t)r0 * 768 + h * 128;
        {
          const int qr = tid >> 1, k0 = (tid & 1) * 64;
          float sf = 0.f, sb = 0.f;
#pragma unroll
          for (int c8 = 0; c8 < 8; ++c8) {
            const uint4 u = *(const uint4*)(Qb + (size_t)qr * 768 + k0 + c8 * 8);
            const float* nf = sN + k0 + c8 * 8; const float* nb = sN + 128 + k0 + c8 * 8;
            sf += bflo(u.x) * nf[0] + bfhi(u.x) * nf[1] + bflo(u.y) * nf[2] + bfhi(u.y) * nf[3] + bflo(u.z) * nf[4] + bfhi(u.z) * nf[5] + bflo(u.w) * nf[6] + bfhi(u.w) * nf[7];
            sb += bflo(u.x) * nb[0] + bfhi(u.x) * nb[1] + bflo(u.y) * nb[2] + bfhi(u.y) * nb[3] + bflo(u.z) * nb[4] + bfhi(u.z) * nb[5] + bflo(u.w) * nb[6] + bfhi(u.w) * nb[7];
          }
          sf += __shfl_xor(sf, 1); sb += __shfl_xor(sb, 1);
          if ((tid & 1) == 0) { sQN[qr] = sf; sQN[128 + qr] = sb; }
        }
        f32x4 acc[2][8]; zero_acc(acc);
        block_gemm<false>(acc, 2,
            [&](int row, int k) { return *(const uint4*)(Qb + (size_t)row * 768 + k); },
            [&](int row, int k) { return *(const uint4*)(Kb + (size_t)row * 768 + k); }, smem, nullptr, 0);
        __syncthreads();
        {
          float rsf[2] = {0.f, 0.f}, rsb[2] = {0.f, 0.f};
#pragma unroll
          for (int ni = 0; ni < 8; ++ni) {
            const int s0 = 16 * ni + 4 * fq;
            const f32x4 ef = *(const f32x4*)(aA + s0), eb = *(const f32x4*)(aA + 128 + s0);
#pragma unroll
            for (int mi = 0; mi < 2; ++mi) {
              const int tr = 32 * w + 16 * mi + fr;
#pragma unroll
              for (int j = 0; j < 4; ++j) {
                const float sv = acc[mi][ni][j];
                rsf[mi] += (s0 + j <= tr) ? sv * ef[j] : 0.f;
                rsb[mi] += (s0 + j >= tr) ? sv * eb[j] : 0.f;
              }
            }
          }
          float cf[2], cb[2];
#pragma unroll
          for (int mi = 0; mi < 2; ++mi) {
            const int tr = 32 * w + 16 * mi + fr;
            float a = rsf[mi], c2 = rsb[mi];
            a += __shfl_xor(a, 16); a += __shfl_xor(a, 32); c2 += __shfl_xor(c2, 16); c2 += __shfl_xor(c2, 32);
            const float denf = a * aM[tr] + aI[tr] * sQN[tr], denb = c2 * aM[128 + tr] + aI[128 + tr] * sQN[128 + tr];
            const float ddf = 1.f / fmaxf(fabsf(denf), aE[tr]), ddb = 1.f / fmaxf(fabsf(denb), aE[128 + tr]);
            if (fq == 0) { sSC[tr] = aI[tr] * ddf; sSC[128 + tr] = aI[128 + tr] * ddb; }
            cf[mi] = aM[tr] * ddf; cb[mi] = aM[128 + tr] * ddb;
          }
#pragma unroll
          for (int ni = 0; ni < 8; ++ni) {
            const int s0 = 16 * ni + 4 * fq;
            const f32x4 ef = *(const f32x4*)(aA + s0), eb = *(const f32x4*)(aA + 128 + s0);
#pragma unroll
            for (int mi = 0; mi < 2; ++mi) {
              const int tr = 32 * w + 16 * mi + fr;
              f32x4 pv;
#pragma unroll
              for (int j = 0; j < 4; ++j) {
                const float df = (s0 + j <= tr) ? ef[j] * cf[mi] : 0.f;
                const float db = (s0 + j >= tr) ? eb[j] * cb[mi] : 0.f;
                pv[j] = acc[mi][ni][j] * (df + db);
              }
              uint2 o; o.x = pk2(pv[0], pv[1]); o.y = pk2(pv[2], pv[3]);
              *(uint2*)&sP[tr * LDP + s0] = o;
            }
          }
        }
        __syncthreads();
        zero_acc(acc);
        {
          const bf16_t* Vb = Vt + (size_t)(b * 768 + h * 128) * S_ + n * 128;
          block_gemm<true>(acc, 2, [&](int, int) { return uint4{0u, 0u, 0u, 0u}; },
              [&](int row, int k) { return *(const uint4*)(Vb + (size_t)row * S_ + k); }, smem, sP, LDP);
        }
#pragma unroll
        for (int dir = 0; dir < 2; ++dir) {
          const int sd = (dir * 2 + b) * 6 + h;
          const bf16_t* Cb = ST + (size_t)(sd * NCH + n) * 16384;
          block_gemm<false>(acc, 2,
              [&](int row, int k) {
                const uint4 u = *(const uint4*)(Qb + (size_t)row * 768 + k);
                const float sc = sSC[dir * 128 + row];
                uint4 o; o.x = pk2(bflo(u.x) * sc, bfhi(u.x) * sc); o.y = pk2(bflo(u.y) * sc, bfhi(u.y) * sc);
                o.z = pk2(bflo(u.z) * sc, bfhi(u.z) * sc); o.w = pk2(bflo(u.w) * sc, bfhi(u.w) * sc); return o;
              },
              [&](int row, int k) { return *(const uint4*)(Cb + (size_t)row * 128 + k); }, smem, nullptr, 0);
        }
#pragma unroll
        for (int mi = 0; mi < 2; ++mi) {
          const int tr = 32 * w + 16 * mi + fr, row = r0 + tr;
          float ss = 0.f;
#pragma unroll
          for (int ni = 0; ni < 8; ++ni)
#pragma unroll
            for (int j = 0; j < 4; ++j) ss += acc[mi][ni][j] * acc[mi][ni][j];
          ss += __shfl_xor(ss, 16); ss += __shfl_xor(ss, 32);
          const float rstd = rsqrtf(ss * (1.f / 128.f) + EPS);
#pragma unroll
          for (int ni = 0; ni < 8; ++ni) {
            const int col = h * 128 + 16 * ni + 4 * fq;
            const f32x4 gg = *(const f32x4*)(p.g_head + col);
            const uint2 ou = *(const uint2*)(Ob + (size_t)row * 768 + col);
            f32x4 v;
            v[0] = acc[mi][ni][0] * rstd * gg[0] * sigmoidf_(bflo(ou.x)); v[1] = acc[mi][ni][1] * rstd * gg[1] * sigmoidf_(bfhi(ou.x));
            v[2] = acc[mi][ni][2] * rstd * gg[2] * sigmoidf_(bflo(ou.y)); v[3] = acc[mi][ni][3] * rstd * gg[3] * sigmoidf_(bfhi(ou.y));
            store_bf16_row(Hb, LDH, row, col, v);
          }
        }
      }
    } break;
    case 7: case 10: case 15: case 18: {
      const bool is_ff2 = (ph == 10 || ph == 18);
      const int layer = ph >= 15 ? 1 : 0;
      const bool from_input = (ph == 7);
      const bf16_t* A = is_ff2 ? (const bf16_t*)AR : Hb;
      const int K = is_ff2 ? DFF : D;
      const bf16_t* Bt = (const bf16_t*)((unsigned char*)WT + (is_ff2 ? WT_FF2 : WT_OUT));
      const int gidx = is_ff2 ? 5 : 2;
      auto epi = [&](f32x4 (&acc)[2][8], int mt, int nt) {
#pragma unroll
        for (int mi = 0; mi < 2; ++mi) {
          const int row = mt * 128 + 32 * w + 16 * mi + fr;
          const float* xs = xsrc_row(p, from_input, row);
          float* xd = xdst_row(p, row);
          const float* gate = mod_row(p, layer, row) + gidx * 1024;
#pragma unroll
          for (int ni = 0; ni < 8; ++ni) {
            const int col = nt * 128 + 16 * ni + 4 * fq;
            const f32x4 xv = *(const f32x4*)(xs + col), gv = *(const f32x4*)(gate + col);
            f32x4 o = xv + gv * acc[mi][ni];
            *(f32x4*)(xd + col) = o;
          }
        }
      };
      const int lda = is_ff2 ? LDHID : LDH;
      gemm_phase(A, lda, Bt, K, M / 128, 8, true, epi, smem);
      if (layer == 0) {
        const int ldb = K + 64, kper = K / 4;
        float* PART = (float*)(AR + A_PART);
        for (int u = blockIdx.x; u < 32 * 4; u += gridDim.x) {
          const int tile = u >> 2, ks = u & 3, mc = tile >> 3, nt = tile & 7, mt = (mc >> 1) * NCH + (mc & 1);
          f32x4 acc[2][8]; zero_acc(acc);
          block_gemm_glds(acc, kper / 64, A + (size_t)mt * 128 * lda + ks * kper, (size_t)lda, Bt + (size_t)nt * 128 * ldb + ks * kper, (size_t)ldb, smem);
#pragma unroll
          for (int mi = 0; mi < 2; ++mi) {
            const int row = mt * 128 + 32 * w + 16 * mi + fr, rc = (row / S_) * CTX + (row % S_);
            const float* gate = mod_row(p, layer, row) + gidx * 1024;
            float* pd = PART + ((size_t)ks * 512 + rc) * 1024;
#pragma unroll
            for (int ni = 0; ni < 8; ++ni) {
              const int col = nt * 128 + 16 * ni + 4 * fq;
              const f32x4 gv = *(const f32x4*)(gate + col);
              *(f32x4*)(pd + col) = gv * acc[mi][ni];
            }
          }
        }
      }
    } break;
    case 8: norm_phase(p, 0, 1, false, false, 1); break;
    case 9: case 17: {
      bf16_t* Hid = (bf16_t*)AR;
      auto epi = [&](f32x4 (&acc)[2][8], int mt, int nt) {
#pragma unroll
        for (int mi = 0; mi < 2; ++mi)
#pragma unroll
          for (int ni = 0; ni < 8; ++ni) {
            f32x4 v = acc[mi][ni];
#pragma unroll
            for (int j = 0; j < 4; ++j) { const float r = fmaxf(v[j], 0.f); v[j] = r * r; }
            store_bf16_row(Hid, LDHID, mt * 128 + 32 * w + 16 * mi + fr, nt * 128 + 16 * ni + 4 * fq, v);
          }
      };
      gemm_phase(Hb, LDH, (const bf16_t*)((unsigned char*)WT + WT_FF1), D, M / 128, 32, ph == 17, epi, smem);
    } break;
    case 11: {
      norm_phase(p, 1, 0, false, false, 2);
    } break;
    case 12: {
      bf16_t* Qb = (bf16_t*)(AR + A1_Q); bf16_t* Kb = (bf16_t*)(AR + A1_K); bf16_t* Vt = (bf16_t*)(AR + A1_VT); bf16_t* GL = (bf16_t*)(AR + A1_GLU);
      const float* cT = (const float*)(ws + OFF_ROPE); const float* sT = cT + 8192 * 32;
      auto epi = [&](f32x4 (&acc)[2][8], int mt, int nt) {
        const int b = mt / NCH;
        if (nt < 12) {
#pragma unroll
          for (int mi = 0; mi < 2; ++mi) {
            const int row = mt * 128 + 32 * w + 16 * mi + fr, s = row - b * S_;
            if (s >= CTX) {
              const int tpos = s - CTX;
#pragma unroll
              for (int g2 = 0; g2 < 2; ++g2)
#pragma unroll
                for (int nn = 0; nn < 2; ++nn) {
                  const int ni = g2 * 4 + nn, d0 = nn * 16 + 4 * fq;
                  const f32x4 cc = *(const f32x4*)(cT + tpos * 32 + d0), sn = *(const f32x4*)(sT + tpos * 32 + d0);
                  const f32x4 x1 = acc[mi][ni], x2 = acc[mi][ni + 2];
                  acc[mi][ni] = x1 * cc - x2 * sn; acc[mi][ni + 2] = x2 * cc + x1 * sn;
                }
            }
          }
        }
#pragma unroll
        for (int mi = 0; mi < 2; ++mi)
#pragma unroll
          for (int ni = 0; ni < 8; ++ni) {
            const int row = mt * 128 + 32 * w + 16 * mi + fr, col = nt * 128 + 16 * ni + 4 * fq;
            f32x4 v = acc[mi][ni];
            if (nt < 6) { v *= 0.18033688011112042f; store_bf16_row(Qb, 768, row, col, v); }
            else if (nt < 12) store_bf16_row(Kb, 768, row, col - 768, v);
            else if (nt < 18) store_bf16_T(Vt + (size_t)b * 768 * S_, col - 1536, row - b * S_, v);
            else store_bf16_row(GL, 512, row, col - 2304, v);
          }
      };
      gemm_phase(Hb, LDH, (const bf16_t*)((unsigned char*)WT + WT_IN), D, M / 128, 22, false, epi, smem);
    } break;
    case 13: {
      const bf16_t* Qb = (const bf16_t*)(AR + A1_Q); const bf16_t* Kb = (const bf16_t*)(AR + A1_K); const bf16_t* Vt = (const bf16_t*)(AR + A1_VT);
      bf16_t* OA = (bf16_t*)(AR + A1_OA);
      const int r = lane & 31, hh = lane >> 5;
      constexpr int STAGE = 24576, SV_OFF = 8192, NKT = S_ / 64;
      for (int t = blockIdx.x; t < NB * 6 * 2 * 64; t += gridDim.x) {
        const int qt = t & 63, mp = (t >> 6) & 1, bh = t >> 7, b = bh / 6, h = bh % 6;
        const int rq0 = b * S_ + CTX + qt * 128;
        const bf16_t* Qp = Qb + (size_t)rq0 * 768 + h * 128 + mp * 64;
        const bf16_t* Kp = Kb + (size_t)b * S_ * 768 + h * 128 + mp * 64;
        const bf16_t* Vp = Vt + (size_t)(b * 768 + h * 128) * S_;
        bf16x8 qf[4];
#pragma unroll
        for (int ks = 0; ks < 4; ++ks) qf[ks] = *(const bf16x8*)(Qp + (size_t)(32 * w + r) * 768 + 16 * ks + 8 * hh);
        f32x16 o[4];
#pragma unroll
        for (int db = 0; db < 4; ++db)
#pragma unroll
          for (int i = 0; i < 16; ++i) o[db][i] = 0.f;
        float mrun = -INFINITY, lrun = 0.f;
        LASG unsigned char* lb = (LASG unsigned char*)smem;
        const int g8 = lane >> 3, gp = lane & 7;
#define ATT_ISSUE(st_, kt_) do { \
          _Pragma("unroll") for (int i = 0; i < 2; ++i) { const int rho = 16 * w + 8 * i + g8, key_ = (rho & ~12) | ((rho & 4) << 1) | ((rho & 8) >> 1); \
            __builtin_amdgcn_global_load_lds((const unsigned*)(Kp + (size_t)((kt_) * 64 + key_) * 768 + ((gp ^ ((rho >> 1) & 7)) * 8)), (LASG unsigned*)(lb + (st_) * STAGE + (16 * w + 8 * i) * 128 + lane * 16), 16, 0, 0); } \
          _Pragma("unroll") for (int i = 0; i < 4; ++i) { const int rho = 32 * w + 8 * i + g8; \
            __builtin_amdgcn_global_load_lds((const unsigned*)(Vp + (size_t)rho * S_ + (kt_) * 64 + ((gp ^ ((rho >> 1) & 7)) * 8)), (LASG unsigned*)(lb + (st_) * STAGE + SV_OFF + (32 * w + 8 * i) * 128 + lane * 16), 16, 0, 0); } } while (0)
        const int rsw = (r >> 1) & 7;
        __syncthreads();
        ATT_ISSUE(0, 0);
        for (int kt = 0; kt < NKT; ++kt) {
          const int st = kt & 1;
          __syncthreads();
          if (kt + 1 < NKT) ATT_ISSUE(st ^ 1, kt + 1);
          const unsigned char* sK = smem + st * STAGE; const unsigned char* sV = sK + SV_OFF;
          f32x16 sx[2];
#pragma unroll
          for (int kb = 0; kb < 2; ++kb) {
#pragma unroll
            for (int i = 0; i < 16; ++i) sx[kb][i] = 0.f;
#pragma unroll
            for (int ks = 0; ks < 4; ++ks) {
              const bf16x8 kf = *(const bf16x8*)(sK + (32 * kb + r) * 128 + (((2 * ks + hh) ^ rsw) * 16));
              sx[kb] = __builtin_amdgcn_mfma_f32_32x32x16_bf16(kf, qf[ks], sx[kb], 0, 0, 0);
            }
          }
          float mx = sx[0][0];
#pragma unroll
          for (int i = 0; i < 16; ++i) { mx = fmaxf(mx, sx[0][i]); mx = fmaxf(mx, sx[1][i]); }
          mx = xor32_max(mx);
          const float mnew = fmaxf(mrun, mx), alpha = __builtin_amdgcn_exp2f(mrun - mnew);
          float rs = 0.f;
#pragma unroll
          for (int kb = 0; kb < 2; ++kb)
#pragma unroll
            for (int i = 0; i < 16; ++i) { const float pv = __builtin_amdgcn_exp2f(sx[kb][i] - mnew); sx[kb][i] = pv; rs += pv; }
          rs = xor32_sum(rs);
          lrun = lrun * alpha + rs; mrun = mnew;
          if (__any(alpha != 1.f)) {
#pragma unroll
            for (int db = 0; db < 4; ++db) o[db] *= alpha;
          }
#pragma unroll
          for (int kb = 0; kb < 2; ++kb)
#pragma unroll
            for (int s2 = 0; s2 < 2; ++s2) {
              uint4 xp;
              xp.x = pk2(sx[kb][8 * s2 + 0], sx[kb][8 * s2 + 1]); xp.y = pk2(sx[kb][8 * s2 + 2], sx[kb][8 * s2 + 3]);
              xp.z = pk2(sx[kb][8 * s2 + 4], sx[kb][8 * s2 + 5]); xp.w = pk2(sx[kb][8 * s2 + 6], sx[kb][8 * s2 + 7]);
              const bf16x8 xs = __builtin_bit_cast(bf16x8, xp);
#pragma unroll
              for (int db = 0; db < 4; ++db) {
                const bf16x8 pa = *(const bf16x8*)(sV + (32 * db + r) * 128 + (((4 * kb + 2 * s2 + hh) ^ rsw) * 16));
                o[db] = __builtin_amdgcn_mfma_f32_32x32x16_bf16(pa, xs, o[db], 0, 0, 0);
              }
            }
        }
#undef ATT_ISSUE
        bf16_t* Od = OA + (size_t)mp * M * 768 + (size_t)(rq0 + 32 * w + r) * 768 + h * 128;
        const float inv = 1.f / lrun;
#pragma unroll
        for (int db = 0; db < 4; ++db)
#pragma unroll
          for (int g = 0; g < 4; ++g) {
            uint2 ov; ov.x = pk2(o[db][4 * g] * inv, o[db][4 * g + 1] * inv); ov.y = pk2(o[db][4 * g + 2] * inv, o[db][4 * g + 3] * inv);
            *(uint2*)(Od + 32 * db + 8 * g + 4 * hh) = ov;
          }
      }
    } break;
    case 14: {
      const bf16_t* OA = (const bf16_t*)(AR + A1_OA); const bf16_t* GL = (const bf16_t*)(AR + A1_GLU);
      const float lam_init = 0.8f - 0.6f * 0.7408182206817179f;
      {
        float l1 = p.lam_p[lane] * p.lam_p[64 + lane], l2 = p.lam_p[128 + lane] * p.lam_p[192 + lane];
        l1 = wsum(l1); l2 = wsum(l2);
        const float lam = __expf(l1) - __expf(l2) + lam_init;
        const int gw = blockIdx.x * 4 + w, ngw = gridDim.x * 4;
        for (int rl = gw; rl < NB * SEQ; rl += ngw) {
          const int b = rl / SEQ, tpos = rl % SEQ, row = b * S_ + CTX + tpos;
#pragma unroll
          for (int h = 0; h < 6; ++h) {
            const unsigned u0 = *(const unsigned*)(OA + (size_t)row * 768 + h * 128 + 2 * lane);
            const unsigned u1 = *(const unsigned*)(OA + (size_t)M * 768 + (size_t)row * 768 + h * 128 + 2 * lane);
            const float o0 = bflo(u0) - lam * bflo(u1), o1 = bfhi(u0) - lam * bfhi(u1);
            const float ss = wsum(o0 * o0 + o1 * o1);
            const float rstd = rsqrtf(ss * (1.f / 128.f) + EPS) * (1.f - lam_init);
            *(unsigned*)(Hb + (size_t)row * LDH + h * 128 + 2 * lane) = pk2(o0 * rstd * p.g_sub[2 * lane], o1 * rstd * p.g_sub[2 * lane + 1]);
          }
        }
      }
      {
        float* su = (float*)smem;
        for (int t = blockIdx.x; t < NB * SEQ / 32; t += gridDim.x) {
          const int b = t / (SEQ / 32), t0 = (t % (SEQ / 32)) * 32;
          __syncthreads();
          for (int i = tid; i < 62 * 64; i += 256) {
            const int rr = i >> 6, c4 = (i & 63) * 4, tp = t0 + rr - 15;
            f32x4 u = {0.f, 0.f, 0.f, 0.f};
            if (tp >= 0 && tp < SEQ) {
              const size_t ro = (size_t)(b * S_ + CTX + tp) * 512;
              const uint2 av = *(const uint2*)(GL + ro + c4), gv = *(const uint2*)(GL + ro + 256 + c4);
              u[0] = bflo(av.x) * sigmoidf_(bflo(gv.x)); u[1] = bfhi(av.x) * sigmoidf_(bfhi(gv.x));
              u[2] = bflo(av.y) * sigmoidf_(bflo(gv.y)); u[3] = bfhi(av.y) * sigmoidf_(bfhi(gv.y));
            }
            *(f32x4*)(su + rr * 256 + c4) = u;
          }
          __syncthreads();
          float z[32];
#pragma unroll
          for (int tt = 0; tt < 32; ++tt) z[tt] = 0.f;
          for (int j = 0; j < 31; ++j) {
            const float wj = p.w_dw[j * 256 + tid];
#pragma unroll
            for (int tt = 0; tt < 32; ++tt) z[tt] += wj * su[(tt + j) * 256 + tid];
          }
          __syncthreads();
#pragma unroll
          for (int tt = 0; tt < 32; ++tt) su[tt * 256 + tid] = z[tt];
          __syncthreads();
          for (int tt = w; tt < 32; tt += 4) {
            f32x4 v = *(const f32x4*)(su + tt * 256 + 4 * lane);
            const float mu = wsum(v[0] + v[1] + v[2] + v[3]) * (1.f / 256.f);
            v -= mu;
            const float rstd = rsqrtf(wsum(v[0] * v[0] + v[1] * v[1] + v[2] * v[2] + v[3] * v[3]) * (1.f / 256.f) + EPS);
            const f32x4 gl = *(const f32x4*)(p.g_cln + 4 * lane), bl = *(const f32x4*)(p.b_cln + 4 * lane);
            float y[4];
#pragma unroll
            for (int e = 0; e < 4; ++e) y[e] = siluf_(v[e] * rstd * gl[e] + bl[e]);
            uint2 o; o.x = pk2(y[0], y[1]); o.y = pk2(y[2], y[3]);
            *(uint2*)(Hb + (size_t)(b * S_ + CTX + t0 + tt) * LDH + 768 + 4 * lane) = o;
          }
        }
      }
    } break;
    case 16: norm_phase(p, 1, 1, false, true); break;
    case 19: {
      const int gw = blockIdx.x * 4 + w, ngw = gridDim.x * 4;
      for (int r = gw; r < NB * SEQ; r += ngw) {
        f32x4* xr = (f32x4*)(p.out + (size_t)r * D) + lane;
        f32x4 v[4]; float ss = 0.f;
#pragma unroll
        for (int j = 0; j < 4; ++j) { v[j] = xr[64 * j]; ss += v[j][0] * v[j][0] + v[j][1] * v[j][1] + v[j][2] * v[j][2] + v[j][3] * v[j][3]; }
        const float rstd = rsqrtf(wsum(ss) * (1.f / D) + EPS);
#pragma unroll
        for (int j = 0; j < 4; ++j) { const f32x4 gg = *(const f32x4*)(p.g_final + 4 * lane + 256 * j); xr[64 * j] = v[j] * rstd * gg; }
      }
    } break;
    default: break;
    }
}

__global__ void __launch_bounds__(256, LB2) mega(Params p) {
  extern __shared__ __attribute__((aligned(16))) unsigned char smem[];
  {
    volatile LAS unsigned* st = (volatile LAS unsigned*)(smem + LDS_BYTES - 16);
    if (threadIdx.x == 0) { st[0] = 0u; st[1] = 0u; }
    __syncthreads();
  }
  if (p.ph_hi == 7777) cg::this_grid().sync();
  const XcdBarrier xb = xcd_barrier_post((unsigned*)(p.ws + OFF_BAR), (volatile LAS unsigned*)(smem + LDS_BYTES - 16));
#ifndef REP_PH
#define REP_PH -1
#endif
#define RUN(k) if (p.ph_lo <= k && k < p.ph_hi) { if (k > p.ph_lo) { xcd_barrier(xb); } run_phase<k>(p, smem); \
    if (k == REP_PH) { xcd_barrier(xb); run_phase<k>(p, smem); } }
  RUN(0) RUN(1) RUN(2) RUN(3) RUN(4) RUN(5) RUN(6) RUN(7) RUN(8) RUN(9) RUN(10) RUN(11) RUN(12) RUN(13) RUN(14) RUN(15) RUN(16) RUN(17) RUN(18) RUN(19)
#undef RUN
  if (p.ph_lo == 20) {
    const bf16_t* src = (const bf16_t*)(p.ws + DUMP_OFF);
    for (size_t i = (size_t)blockIdx.x * 256 + threadIdx.x; i < (size_t)NB * SEQ * D; i += (size_t)gridDim.x * 256) p.out[i] = bf2f(src[i]) + bf2f(((const bf16_t*)(p.ws + OFF_H))[i]);
  }
}

extern "C" void kernel_launch(void* const* d_in, const int* in_sizes, int n_in, void* d_out, int out_size, void* d_ws, size_t ws_size, hipStream_t stream) {
  static int grid_blocks = 0;
  if (!grid_blocks) {
    if (ws_size < WS_NEED) { fprintf(stderr, "kernel_launch: workspace too small: %zu < %zu\n", ws_size, (size_t)WS_NEED); grid_blocks = -1; return; }
    int dev = 0, cus = 0, per_cu = 0;
    hipGetDevice(&dev);
    hipDeviceGetAttribute(&cus, hipDeviceAttributeMultiprocessorCount, dev);
    hipFuncSetAttribute((const void*)mega, hipFuncAttributeMaxDynamicSharedMemorySize, LDS_BYTES);
    hipOccupancyMaxActiveBlocksPerMultiprocessor(&per_cu, (const void*)mega, 256, LDS_BYTES);
    if (per_cu < 1) per_cu = 1;
    if (per_cu > 2) per_cu = 2;
    grid_blocks = cus * per_cu;
    fprintf(stderr, "kernel_launch: cus %d per_cu %d grid %d ws %zu\n", cus, per_cu, grid_blocks, ws_size);
  }
  if (grid_blocks < 0) return;
  Params p{};
  const float** pp = (const float**)&p;
  for (int i = 0; i < 22; ++i) pp[i] = (const float*)d_in[i];
  p.out = (float*)d_out; p.ws = (unsigned char*)d_ws;
#if MULTI_LAUNCH
  for (int ph = 0; ph < NPH_RUN; ++ph) {
    p.ph_lo = ph; p.ph_hi = ph + 1;
    hipLaunchKernelGGL(mega, dim3(grid_blocks), dim3(256), LDS_BYTES, stream, p);
  }
#if NPH_RUN < 20
  p.ph_lo = 20; p.ph_hi = 21;
  hipLaunchKernelGGL(mega, dim3(grid_blocks), dim3(256), LDS_BYTES, stream, p);
#endif
#else
  hipMemsetAsync((unsigned char*)d_ws + OFF_BAR, 0, XCD_BAR_WORDS * 4, stream);
  p.ph_lo = 0; p.ph_hi = NPH;
  void* args[] = {&p};
  hipError_t e = hipLaunchCooperativeKernel((void*)mega, dim3(grid_blocks), dim3(256), args, LDS_BYTES, stream);
  if (e != hipSuccess) fprintf(stderr, "cooperative launch failed: %s (grid %d)\n", hipGetErrorString(e), grid_blocks);
#endif
}
```

```cpp
#include <hip/hip_runtime.h>
#include <hip/hip_cooperative_groups.h>
#include <cstdio>
#include <cstdint>
namespace cg = cooperative_groups;

#ifndef LB2
#define LB2 2
#endif
#ifndef NPH_RUN
#define NPH_RUN 20
#endif
#ifndef DUMP_OFF
#define DUMP_OFF (OFF_AR + A0_QK)
#endif
#ifndef MULTI_LAUNCH
#define MULTI_LAUNCH 0
#endif

typedef unsigned short bf16_t;
typedef short bf16x8 __attribute__((ext_vector_type(8)));
typedef float f32x4 __attribute__((ext_vector_type(4)));
typedef float f32x16 __attribute__((ext_vector_type(16)));
#define DEV __device__ __forceinline__

constexpr int D = 1024, NB = 2, SEQ = 8192, CTX = 256, S_ = SEQ + CTX, M = NB * S_, DFF = 4096;
constexpr int LDH = D + 64, LDHID = DFF + 64;
constexpr int NCH = S_ / 128;
constexpr int NPH = 20;
constexpr float EPS = 1e-6f;

constexpr size_t OFF_MOD = 0;
constexpr size_t MOD_BYTES = 2 * 3 * 6144 * 4;
constexpr size_t OFF_ROPE = 0x40000;
constexpr size_t OFF_XC = 0x240000;
constexpr size_t OFF_G = 0x440000;
constexpr size_t OFF_CS = 0x5D0000;
constexpr size_t OFF_MS = 0x5D8000;
constexpr size_t OFF_NV = 0x5DA000;
constexpr size_t OFF_WT = 0x700000;
constexpr size_t WT_IN = 0, WT_OUT = 0x770000, WT_FF1 = 0x990000, WT_FF2 = 0x1210000;
constexpr size_t OFF_H = 0x2200000;
constexpr size_t OFF_AR = 0x4510000;
constexpr size_t A0_QK = 0, A0_ST = 0, A0_VT = 0x3180000, A0_O = 0x4A40000, A0_QC = 0x6300000, A0_KC = 0x7BC0000;
constexpr size_t DO_KCT = 0, DO_ZT = 0x18C0000, DO_F = 0x2940000;
constexpr size_t A1_Q = 0, A1_K = 0x18C0000, A1_VT = 0x3180000, A1_GLU = 0x4A40000, A1_OA = 0x5AC0000;
constexpr size_t OFF_WT2 = OFF_AR + 0x9480000;
constexpr size_t WS_NEED = OFF_WT2 + 0x1A30000;

struct Params {
  const float *x, *c, *ctx, *c_ctx, *w_mod, *b_mod, *g_norm, *w_in_even, *b_gate, *w_qk_conv, *g_head, *w_out_even,
      *w_in_odd, *lam_p, *g_sub, *w_dw, *g_cln, *b_cln, *w_out_odd, *w_ff1, *w_ff2, *g_final;
  float* out;
  unsigned char* ws;
  int ph_lo, ph_hi;
};

typedef float f32x2 __attribute__((ext_vector_type(2)));
typedef __bf16 bf16x2_t __attribute__((ext_vector_type(2)));
DEV unsigned pk2(float lo, float hi) { f32x2 v = {lo, hi}; bf16x2_t b = __builtin_convertvector(v, bf16x2_t); return __builtin_bit_cast(unsigned, b); }
DEV bf16_t f2bf(float f) { return (bf16_t)(pk2(f, 0.f) & 0xffff); }
DEV float bf2f(unsigned h) { return __uint_as_float(h << 16); }
DEV float bflo(unsigned u) { return __uint_as_float(u << 16); }
DEV float bfhi(unsigned u) { return __uint_as_float(u & 0xffff0000u); }
DEV float wsum(float v) { for (int o = 32; o; o >>= 1) v += __shfl_xor(v, o); return v; }
DEV float xor32_max(float v) { auto r = __builtin_amdgcn_permlane32_swap(__float_as_uint(v), __float_as_uint(v), false, false); return fmaxf(__uint_as_float(r[0]), __uint_as_float(r[1])); }
DEV float xor32_sum(float v) { auto r = __builtin_amdgcn_permlane32_swap(__float_as_uint(v), __float_as_uint(v), false, false); return __uint_as_float(r[0]) + __uint_as_float(r[1]); }
DEV float sigmoidf_(float x) { return 1.f / (1.f + __expf(-x)); }
DEV float siluf_(float x) { return x / (1.f + __expf(-x)); }
DEV float logsigf_(float x) { return fminf(x, 0.f) - log1pf(__expf(-fabsf(x))); }

constexpr int LDT = 72;
constexpr int LDP = 136;
constexpr int LDS_A = 0, LDS_B = 18432, LDS_P = 36864, LDS_F = 71680, LDS_BYTES = 79872;

template <bool A_LDS, class LA, class LB>
DEV void block_gemm(f32x4 (&acc)[2][8], int nk, LA la, LB lb, unsigned char* smem, const bf16_t* pA, int ldp) {
  bf16_t* sA = (bf16_t*)(smem + LDS_A);
  bf16_t* sB = (bf16_t*)(smem + LDS_B);
  const int tid = threadIdx.x, lane = tid & 63, w = tid >> 6;
  const int srow = tid >> 3, scol = (tid & 7) * 8;
  const int fr = lane & 15, fq = lane >> 4;
  uint4 ra[4], rb[4];
#pragma unroll
  for (int i = 0; i < 4; ++i) { if (!A_LDS) ra[i] = la(srow + 32 * i, scol); rb[i] = lb(srow + 32 * i, scol); }
  for (int kt = 0; kt < nk; ++kt) {
    __syncthreads();
#pragma unroll
    for (int i = 0; i < 4; ++i) {
      if (!A_LDS) *(uint4*)&sA[(srow + 32 * i) * LDT + scol] = ra[i];
      *(uint4*)&sB[(srow + 32 * i) * LDT + scol] = rb[i];
    }
    __syncthreads();
    if (kt + 1 < nk) {
#pragma unroll
      for (int i = 0; i < 4; ++i) { if (!A_LDS) ra[i] = la(srow + 32 * i, (kt + 1) * 64 + scol); rb[i] = lb(srow + 32 * i, (kt + 1) * 64 + scol); }
    }
#pragma unroll
    for (int kk = 0; kk < 2; ++kk) {
      bf16x8 af[2], bfr[8];
#pragma unroll
      for (int mi = 0; mi < 2; ++mi) {
        if (A_LDS) af[mi] = *(const bf16x8*)&pA[(32 * w + 16 * mi + fr) * ldp + kt * 64 + kk * 32 + 8 * fq];
        else af[mi] = *(const bf16x8*)&sA[(32 * w + 16 * mi + fr) * LDT + kk * 32 + 8 * fq];
      }
#pragma unroll
      for (int ni = 0; ni < 8; ++ni) bfr[ni] = *(const bf16x8*)&sB[(16 * ni + fr) * LDT + kk * 32 + 8 * fq];
#pragma unroll
      for (int mi = 0; mi < 2; ++mi)
#pragma unroll
        for (int ni = 0; ni < 8; ++ni) acc[mi][ni] = __builtin_amdgcn_mfma_f32_16x16x32_bf16(bfr[ni], af[mi], acc[mi][ni], 0, 0, 0);
    }
  }
}

DEV void zero_acc(f32x4 (&acc)[2][8]) {
#pragma unroll
  for (int mi = 0; mi < 2; ++mi)
#pragma unroll
    for (int ni = 0; ni < 8; ++ni) acc[mi][ni] = (f32x4){0.f, 0.f, 0.f, 0.f};
}

#define LASG __attribute__((address_space(3)))
DEV void block_gemm_glds(f32x4 (&acc)[2][8], int nk, const bf16_t* Ag, size_t lda, const bf16_t* Bg, size_t ldb, unsigned char* smem) {
  const int tid = threadIdx.x, lane = tid & 63, w = tid >> 6;
  const int srow = tid >> 3, sc = ((tid & 7) ^ (srow & 7)) * 8;
  const int fr = lane & 15, fq = lane >> 4;
  const bf16_t* ag = Ag + (size_t)srow * lda + sc;
  const bf16_t* bg = Bg + (size_t)srow * ldb + sc;
  LASG unsigned char* lbase = (LASG unsigned char*)smem;
#define GLDS_ISSUE(st_, k0_) do { \
    _Pragma("unroll") for (int i = 0; i < 4; ++i) { \
      __builtin_amdgcn_global_load_lds((const unsigned*)(ag + (size_t)(32 * i) * lda + (k0_)), (LASG unsigned*)(lbase + (st_) * 32768 + (tid + 256 * i) * 16), 16, 0, 0); \
      __builtin_amdgcn_global_load_lds((const unsigned*)(bg + (size_t)(32 * i) * ldb + (k0_)), (LASG unsigned*)(lbase + (st_) * 32768 + 16384 + (tid + 256 * i) * 16), 16, 0, 0); } } while (0)
  __syncthreads();
  GLDS_ISSUE(0, 0);
  for (int kt = 0; kt < nk; ++kt) {
    __syncthreads();
    if (kt + 1 < nk) GLDS_ISSUE((kt + 1) & 1, (kt + 1) * 64);
    const unsigned char* sA = smem + (kt & 1) * 32768;
    const unsigned char* sB = sA + 16384;
#pragma unroll
    for (int kk = 0; kk < 2; ++kk) {
      const int swz = ((kk * 4 + fq) ^ (fr & 7)) * 16;
      bf16x8 af[2], bfr[8];
#pragma unroll
      for (int mi = 0; mi < 2; ++mi) af[mi] = *(const bf16x8*)(sA + (32 * w + 16 * mi + fr) * 128 + swz);
#pragma unroll
      for (int ni = 0; ni < 8; ++ni) bfr[ni] = *(const bf16x8*)(sB + (16 * ni + fr) * 128 + swz);
#pragma unroll
      for (int mi = 0; mi < 2; ++mi)
#pragma unroll
        for (int ni = 0; ni < 8; ++ni) acc[mi][ni] = __builtin_amdgcn_mfma_f32_16x16x32_bf16(bfr[ni], af[mi], acc[mi][ni], 0, 0, 0);
    }
  }
#undef GLDS_ISSUE
}

DEV void block_gemm_glds2(f32x4 (&acc0)[2][8], f32x4 (&acc1)[2][8], int nk, const bf16_t* Ag, size_t lda, const bf16_t* Bg, size_t ldb, unsigned char* smem) {
  const int tid = threadIdx.x, lane = tid & 63, w = tid >> 6;
  const int fr = lane & 15, fq = lane >> 4;
  const int lr = lane >> 2, lp = lane & 3;
  const int sc = (lp ^ ((0x78 >> (2 * ((lr >> 2) & 3))) & 3)) * 8;
  const bf16_t* ag = Ag + (size_t)(32 * w + lr) * lda + sc;
  const bf16_t* bg = Bg + (size_t)(64 * w + lr) * ldb + sc;
  LASG unsigned char* lbase = (LASG unsigned char*)smem;
#define G2_ISSUE(st_, k0_) do { \
    _Pragma("unroll") for (int i = 0; i < 2; ++i) \
      __builtin_amdgcn_global_load_lds((const unsigned*)(ag + (size_t)(16 * i) * lda + (k0_)), (LASG unsigned*)(lbase + (st_) * 24576 + (32 * w + 16 * i) * 64 + lane * 16), 16, 0, 0); \
    _Pragma("unroll") for (int i = 0; i < 4; ++i) \
      __builtin_amdgcn_global_load_lds((const unsigned*)(bg + (size_t)(16 * i) * ldb + (k0_)), (LASG unsigned*)(lbase + (st_) * 24576 + 8192 + (64 * w + 16 * i) * 64 + lane * 16), 16, 0, 0); } while (0)
  __syncthreads();
  G2_ISSUE(0, 0);
  if (nk > 1) G2_ISSUE(1, 32);
  const int roff = (fq ^ ((0x78 >> (2 * ((fr >> 2) & 3))) & 3)) * 16 + fr * 64;
  int st = 0;
  for (int kt = 0; kt < nk; ++kt) {
    if (kt + 1 < nk) asm volatile("s_waitcnt vmcnt(6)" ::: "memory"); else asm volatile("s_waitcnt vmcnt(0)" ::: "memory");
    __builtin_amdgcn_s_barrier();
    asm volatile("" ::: "memory");
    if (kt + 2 < nk) { const int st2 = st >= 1 ? st - 1 : 2; G2_ISSUE(st2, (kt + 2) * 32); }
    const unsigned char* sA = smem + st * 24576;
    const unsigned char* sB = sA + 8192;
    bf16x8 af[2];
#pragma unroll
    for (int mi = 0; mi < 2; ++mi) af[mi] = *(const bf16x8*)(sA + (32 * w + 16 * mi) * 64 + roff);
    {
      bf16x8 bfr[8];
#pragma unroll
      for (int ni = 0; ni < 8; ++ni) bfr[ni] = *(const bf16x8*)(sB + (16 * ni) * 64 + roff);
#pragma unroll
      for (int mi = 0; mi < 2; ++mi)
#pragma unroll
        for (int ni = 0; ni < 8; ++ni) acc0[mi][ni] = __builtin_amdgcn_mfma_f32_16x16x32_bf16(bfr[ni], af[mi], acc0[mi][ni], 0, 0, 0);
    }
    {
      bf16x8 bfr[8];
#pragma unroll
      for (int ni = 0; ni < 8; ++ni) bfr[ni] = *(const bf16x8*)(sB + (128 + 16 * ni) * 64 + roff);
#pragma unroll
      for (int mi = 0; mi < 2; ++mi)
#pragma unroll
        for (int ni = 0; ni < 8; ++ni) acc1[mi][ni] = __builtin_amdgcn_mfma_f32_16x16x32_bf16(bfr[ni], af[mi], acc1[mi][ni], 0, 0, 0);
    }
    st = st == 2 ? 0 : st + 1;
  }
#undef G2_ISSUE
}

constexpr size_t OFF_BAR = 0x28000;
#define XB_TMO      128
#define XB_XCNT(j)  (256  + 64 * (j))
#define XB_XSUB(j)  (1280 + 64 * (j))
#define XB_XGEN(j)  (2304 + 64 * (j))
#define XB_TOP      3328
#define XB_TOPGEN   3392
#define XCD_BAR_WORDS 3456
#define XB_SPIN_CAP (1u << 18)
#define LAS __attribute__((address_space(3)))

__device__ __forceinline__ unsigned xb_ld(unsigned* p)              { return __hip_atomic_load(p, __ATOMIC_RELAXED, __HIP_MEMORY_SCOPE_AGENT); }
__device__ __forceinline__ unsigned xb_add(unsigned* p, unsigned v) { return __hip_atomic_fetch_add(p, v, __ATOMIC_RELAXED, __HIP_MEMORY_SCOPE_AGENT); }
__device__ __forceinline__ unsigned xb_xcc_id() { return (unsigned)__builtin_amdgcn_s_getreg((3 << 11) | 20) & 0xFu; }
#define XB_SPIN(cond, bar) do { unsigned _sp = 0; while (cond) { __builtin_amdgcn_s_sleep(1); \
    if ((++_sp & 255u) == 0u) { if (xb_ld(&(bar)[XB_TMO])) break; if (_sp > XB_SPIN_CAP) { atomicAdd(&(bar)[XB_TMO], 1u); break; } } } } while (0)

struct XcdBarrier {
    unsigned* bar; unsigned x;
    volatile LAS unsigned* st;
};

__device__ __forceinline__ XcdBarrier xcd_barrier_post(unsigned* bar, volatile LAS unsigned* st) {
    XcdBarrier b; b.bar = bar; b.x = xb_xcc_id(); b.st = st;
    if (threadIdx.x == 0) (void)xb_add(&bar[XB_XCNT(b.x)], 1u);
    return b;
}
__device__ __forceinline__ void xcd_barrier_complete(unsigned* bar, unsigned x, unsigned& nloc, unsigned& nx) {
    const unsigned G = gridDim.x * gridDim.y * gridDim.z;
    unsigned sum, cnt, mine, sp = 0u;
    for (;;) {
        sum = 0u; cnt = 0u; mine = 0u;
#pragma unroll
        for (unsigned j = 0; j < 16; ++j) { const unsigned c = xb_ld(&bar[XB_XCNT(j)]); sum += c; cnt += (c > 0u) ? 1u : 0u; mine = (j == x) ? c : mine; }
        if (sum == G) break;
        __builtin_amdgcn_s_sleep(1);
        if ((++sp & 255u) == 0u) { if (xb_ld(&bar[XB_TMO])) break; if (sp > XB_SPIN_CAP) { atomicAdd(&bar[XB_TMO], 1u); break; } }
    }
    nloc = mine > 0u ? mine : 1u; nx = cnt > 0u ? cnt : 1u;
}

__device__ __forceinline__ void xcd_barrier(const XcdBarrier& b) {
    asm volatile("s_waitcnt vmcnt(0)" ::: "memory");
    __syncthreads();
    if (threadIdx.x == 0) {
        unsigned* bar = b.bar;
        __builtin_amdgcn_s_waitcnt(0);
        unsigned nloc = b.st[0], nx = b.st[1];
        if (nloc == 0u) { xcd_barrier_complete(bar, b.x, nloc, nx); b.st[0] = nloc; b.st[1] = nx; }
        const unsigned old = xb_add(&bar[XB_XSUB(b.x)], 1u);
        const unsigned gen = old / nloc;
        if (old + 1u == (gen + 1u) * nloc) {
            __builtin_amdgcn_fence(__ATOMIC_RELEASE, "agent");
            asm volatile("s_waitcnt vmcnt(0)" ::: "memory");
            const unsigned og = xb_add(&bar[XB_TOP], 1u);
            const unsigned tg = og / nx;
            if (og + 1u == (tg + 1u) * nx) xb_add(&bar[XB_TOPGEN], 1u);
            else XB_SPIN(xb_ld(&bar[XB_TOPGEN]) == tg, bar);
            __builtin_amdgcn_fence(__ATOMIC_ACQUIRE, "agent");
            xb_add(&bar[XB_XGEN(b.x)], 1u);
            asm volatile("s_waitcnt vmcnt(0)" ::: "memory");
        } else {
            XB_SPIN(xb_ld(&bar[XB_XGEN(b.x)]) == gen, bar);
            __builtin_amdgcn_fence(__ATOMIC_ACQUIRE, "agent");
            asm volatile("s_waitcnt vmcnt(0)" ::: "memory");
        }
    }
    __syncthreads();
}

DEV const float* xsrc_row(const Params& p, bool from_input, int r) {
  const int b = r / S_, s = r - b * S_;
  if (from_input) return s < CTX ? p.ctx + (size_t)(b * CTX + s) * D : p.x + (size_t)(b * SEQ + s - CTX) * D;
  return s < CTX ? (const float*)(p.ws + OFF_XC) + (size_t)(b * CTX + s) * D : p.out + (size_t)(b * SEQ + s - CTX) * D;
}
DEV float* xdst_row(const Params& p, int r) {
  const int b = r / S_, s = r - b * S_;
  return s < CTX ? (float*)(p.ws + OFF_XC) + (size_t)(b * CTX + s) * D : p.out + (size_t)(b * SEQ + s - CTX) * D;
}
DEV const float* mod_row(const Params& p, int layer, int r) {
  const int b = r / S_, s = r - b * S_;
  return (const float*)(p.ws + OFF_MOD) + (size_t)(layer * 3 + (s < CTX ? 2 : b)) * 6144;
}

DEV void transpose_tile(const float* W, int K, int N, bf16_t* WT, int remap, int kt, int nt, unsigned char* smem) {
  float* tile = (float*)smem;
  const int tid = threadIdx.x;
  __syncthreads();
#pragma unroll
  for (int i = 0; i < 4; ++i) {
    const int kk = (tid >> 4) + 16 * i, c4 = (tid & 15) * 4;
    const int n = nt * 64 + c4;
    int src = n;
    if (remap) src = n < 3072 ? n : (n < 3328 ? n + 24 : (n < 3352 ? n - 256 : -1));
    else if (n >= N) src = -1;
    f32x4 v = (f32x4){0.f, 0.f, 0.f, 0.f};
    if (src >= 0) v = *(const f32x4*)(W + (size_t)(kt * 64 + kk) * N + src);
    tile[kk * 65 + c4 + 0] = v[0]; tile[kk * 65 + c4 + 1] = v[1]; tile[kk * 65 + c4 + 2] = v[2]; tile[kk * 65 + c4 + 3] = v[3];
  }
  __syncthreads();
  const int n = tid >> 2, kc = (tid & 3) * 16;
  uint4 o0, o1;
  const float* t = tile + kc * 65 + n;
  o0.x = pk2(t[0 * 65], t[1 * 65]); o0.y = pk2(t[2 * 65], t[3 * 65]); o0.z = pk2(t[4 * 65], t[5 * 65]); o0.w = pk2(t[6 * 65], t[7 * 65]);
  o1.x = pk2(t[8 * 65], t[9 * 65]); o1.y = pk2(t[10 * 65], t[11 * 65]); o1.z = pk2(t[12 * 65], t[13 * 65]); o1.w = pk2(t[14 * 65], t[15 * 65]);
  bf16_t* dst = WT + (size_t)(nt * 64 + n) * (K + 64) + kt * 64 + kc;
  *(uint4*)dst = o0; *(uint4*)(dst + 8) = o1;
}
DEV void transpose_mat(const float* Wm, int K, int N, int Npad, bf16_t* dst, int remap, unsigned char* smem, int b0, int nb) {
  const int nkt = K / 64, nnt = Npad / 64;
  if ((int)blockIdx.x < b0) return;
  for (int t = blockIdx.x - b0; t < nkt * nnt; t += nb) transpose_tile(Wm, K, N, dst, remap, t / nnt, t % nnt, smem);
}
DEV void convert_weights(const Params& p, int part, unsigned char* smem, int b0, int nb) {
  unsigned char* wt = p.ws + OFF_WT; unsigned char* wt2 = p.ws + OFF_WT2;
  if (part == 0) { transpose_mat(p.w_in_even, 1024, 3352, 3584, (bf16_t*)(wt + WT_IN), 1, smem, b0, nb); return; }
  transpose_mat(p.w_out_even, 1024, 1024, 1024, (bf16_t*)(wt + WT_OUT), 0, smem, b0, nb);
  transpose_mat(p.w_ff1, 1024, 4096, 4096, (bf16_t*)(wt + WT_FF1), 0, smem, b0, nb);
  transpose_mat(p.w_ff2, 4096, 1024, 1024, (bf16_t*)(wt + WT_FF2), 0, smem, b0, nb);
  transpose_mat(p.w_in_odd, 1024, 2816, 2816, (bf16_t*)(wt2 + WT_IN), 0, smem, b0, nb);
  transpose_mat(p.w_out_odd, 1024, 1024, 1024, (bf16_t*)(wt2 + WT_OUT), 0, smem, b0, nb);
  transpose_mat(p.w_ff1 + (size_t)1024 * 4096, 1024, 4096, 4096, (bf16_t*)(wt2 + WT_FF1), 0, smem, b0, nb);
  transpose_mat(p.w_ff2 + (size_t)1024 * 4096, 4096, 1024, 1024, (bf16_t*)(wt2 + WT_FF2), 0, smem, b0, nb);
}

DEV void mod_phase(const Params& p, unsigned char* smem) {
  float* MOD = (float*)(p.ws + OFF_MOD);
  float* sS = (float*)smem;
  float* red = sS + 3072;
  const int tid = threadIdx.x, cl = tid & 31, kg = tid >> 5;
  if ((int)blockIdx.x >= 2 * 192) return;
  __syncthreads();
  for (int i = tid; i < 3072; i += 256) { const int v = i >> 10, k = i & 1023; sS[i] = siluf_(v == 0 ? p.c[k] : (v == 1 ? p.c[1024 + k] : p.c_ctx[k])); }
  __syncthreads();
  for (int it = blockIdx.x; it < 2 * 192; it += gridDim.x) {
    const int l = it / 192, n = (it % 192) * 32 + cl;
    const float* W = p.w_mod + (size_t)l * 1024 * 6144 + n;
    float a0 = 0.f, a1 = 0.f, a2 = 0.f;
#pragma unroll 16
    for (int k = kg * 128; k < kg * 128 + 128; ++k) {
      const float wv = W[(size_t)k * 6144];
      a0 += sS[k] * wv; a1 += sS[1024 + k] * wv; a2 += sS[2048 + k] * wv;
    }
    __syncthreads();
    red[(kg * 32 + cl) * 3 + 0] = a0; red[(kg * 32 + cl) * 3 + 1] = a1; red[(kg * 32 + cl) * 3 + 2] = a2;
    __syncthreads();
    if (kg == 0) {
      const float bv = p.b_mod[l * 6144 + n];
#pragma unroll
      for (int v = 0; v < 3; ++v) {
        float sacc = 0.f;
#pragma unroll
        for (int g2 = 0; g2 < 8; ++g2) sacc += red[(g2 * 32 + cl) * 3 + v];
        MOD[(l * 3 + v) * 6144 + n] = sacc + bv;
      }
    }
  }
}
DEV void rope_phase(const Params& p) {
  float* ct = (float*)(p.ws + OFF_ROPE);
  float* st = ct + 8192 * 32;
  for (int i = blockIdx.x * 256 + threadIdx.x; i < 8192 * 32; i += gridDim.x * 256) {
    const int t = i >> 5, d = i & 31;
    const float pos = (d < 16) ? (float)(t >> 6) : (float)(t & 63);
    const float inv = powf(10000.f, -(float)(d & 15) / 16.f);
    const float ang = pos * inv;
    ct[i] = cosf(ang); st[i] = sinf(ang);
  }
}

constexpr size_t A_PART = 0x8700000;
DEV void norm_phase(const Params& p, int layer, int which, bool from_input, bool skip_ctx, int ctx_fix = 0) {
  const int lane = threadIdx.x & 63;
  const int gw = blockIdx.x * 4 + (threadIdx.x >> 6), ngw = gridDim.x * 4;
  const float* g = p.g_norm + (layer * 2 + which) * D;
  bf16_t* H = (bf16_t*)(p.ws + OFF_H);
  for (int r = gw; r < M; r += ngw) {
    const int s = r % S_;
    if (skip_ctx && s < CTX) continue;
    const bool fix = ctx_fix && s < CTX;
    const f32x4* xr = (const f32x4*)xsrc_row(p, fix ? (ctx_fix == 1) : from_input, r) + lane;
    const float* mv = mod_row(p, layer, r) + which * 3 * 1024;
    f32x4 v[4]; float ss = 0.f;
#pragma unroll
    for (int j = 0; j < 4; ++j) v[j] = xr[64 * j];
    if (fix) {
      const int rc = (r / S_) * CTX + s;
      const f32x4* pp = (const f32x4*)(p.ws + OFF_AR + A_PART) + (size_t)rc * 256 + lane;
      f32x4* xw = (f32x4*)xdst_row(p, r) + lane;
#pragma unroll
      for (int j = 0; j < 4; ++j) {
        v[j] += (pp[64 * j] + pp[(size_t)512 * 256 + 64 * j]) + (pp[(size_t)2 * 512 * 256 + 64 * j] + pp[(size_t)3 * 512 * 256 + 64 * j]);
        xw[64 * j] = v[j];
      }
    }
#pragma unroll
    for (int j = 0; j < 4; ++j) ss += v[j][0] * v[j][0] + v[j][1] * v[j][1] + v[j][2] * v[j][2] + v[j][3] * v[j][3];
    const float rstd = rsqrtf(wsum(ss) * (1.f / D) + EPS);
    uint2* o = (uint2*)(H + (size_t)r * LDH) + lane;
#pragma unroll
    for (int j = 0; j < 4; ++j) {
      const int c = 4 * lane + 256 * j;
      const f32x4 gg = *(const f32x4*)(g + c), sh = *(const f32x4*)(mv + c), sc = *(const f32x4*)(mv + 1024 + c);
      float y[4];
#pragma unroll
      for (int e = 0; e < 4; ++e) y[e] = v[j][e] * rstd * gg[e] * (1.f + sc[e]) + sh[e];
      uint2 w2; w2.x = pk2(y[0], y[1]); w2.y = pk2(y[2], y[3]);
      o[64 * j] = w2;
    }
  }
}

template <class Epi>
DEV void gemm_phase(const bf16_t* A, int lda, const bf16_t* Bt, int K, int MT, int NT, bool skip_ctx, Epi epi, unsigned char* smem) {
  const int ldb = K + 64;
  const int MTv = skip_ctx ? MT - 2 * NB : MT;
  const int nwg = MTv * NT;
  for (int t = blockIdx.x; t < nwg; t += gridDim.x) {
    int wgid = t;
    { const int q = nwg / 8, r8 = nwg % 8, xcd = wgid % 8, off = wgid / 8; wgid = (xcd < r8 ? xcd * (q + 1) : r8 * (q + 1) + (xcd - r8) * q) + off; }
    const int nig = 8 * NT, gid = wgid / nig, fm = gid * 8, gsz = (MTv - fm) < 8 ? (MTv - fm) : 8;
    int mt = fm + (wgid % nig) % gsz; const int nt = (wgid % nig) / gsz;
    if (skip_ctx) mt = (mt / (NCH - 2)) * NCH + 2 + (mt % (NCH - 2));
    f32x4 acc[2][8]; zero_acc(acc);
    const bf16_t* Ab = A + (size_t)mt * 128 * lda;
    const bf16_t* Bb = Bt + (size_t)nt * 128 * ldb;
    block_gemm_glds(acc, K / 64, Ab, (size_t)lda, Bb, (size_t)ldb, smem);
    epi(acc, mt, nt);
  }
}

template <class Epi>
DEV void gemm_phase2(const bf16_t* A, int lda, const bf16_t* Bt, int K, int MT, int NP, bool skip_ctx, Epi epi, unsigned char* smem) {
  const int ldb = K + 64;
  const int MTv = skip_ctx ? MT - 2 * NB : MT;
  for (int t = blockIdx.x; t < MTv * NP; t += gridDim.x) {
    int mt = t / NP; const int np = t % NP;
    if (skip_ctx) mt = (mt / (NCH - 2)) * NCH + 2 + (mt % (NCH - 2));
    f32x4 acc0[2][8], acc1[2][8]; zero_acc(acc0); zero_acc(acc1);
    block_gemm_glds2(acc0, acc1, K / 32, A + (size_t)mt * 128 * lda, (size_t)lda, Bt + (size_t)np * 256 * ldb, (size_t)ldb, smem);
    epi(acc0, mt, 2 * np);
    epi(acc1, mt, 2 * np + 1);
  }
}

#define EPI_COORDS const int lane = threadIdx.x & 63, w = threadIdx.x >> 6, fr = lane & 15, fq = lane >> 4; (void)w; (void)fr; (void)fq;

DEV void store_bf16_row(bf16_t* base, size_t ld, int row, int col, const f32x4& v) {
  uint2 o; o.x = pk2(v[0], v[1]); o.y = pk2(v[2], v[3]);
  *(uint2*)(base + (size_t)row * ld + col) = o;
}
DEV void store_bf16_T(bf16_t* base, int col, int s, const f32x4& v) {
#pragma unroll
  for (int j = 0; j < 4; ++j) base[(size_t)(col + j) * S_ + s] = f2bf(v[j]);
}

struct GateScan { float a0, a1, b0, b1, pm0, pm1, F, amax; int pos0, pos1; };
DEV GateScan gate_scan(const float* G, const int r0, const int dir, const int h, const int lane) {
  GateScan g;
  const int j0 = 2 * lane, j1 = j0 + 1;
  g.pos0 = dir ? 127 - j0 : j0; g.pos1 = dir ? 127 - j1 : j1;
  const float i0 = G[(size_t)(r0 + g.pos0) * 24 + (dir * 2) * 6 + h], f0 = G[(size_t)(r0 + g.pos0) * 24 + (dir * 2 + 1) * 6 + h];
  const float i1 = G[(size_t)(r0 + g.pos1) * 24 + (dir * 2) * 6 + h], f1 = G[(size_t)(r0 + g.pos1) * 24 + (dir * 2 + 1) * 6 + h];
  const float lf0 = logsigf_(f0), lf1 = logsigf_(f1);
  const float s0 = lf0, s1 = lf0 + lf1;
  float tot = s1;
#pragma unroll
  for (int d = 1; d < 64; d <<= 1) { const float y = __shfl_up(tot, d); if (lane >= d) tot += y; }
  const float excl = tot - s1;
  g.b0 = s0 + excl; g.b1 = s1 + excl;
  g.F = __shfl(tot, 63);
  g.a0 = i0 - g.b0; g.a1 = i1 - g.b1;
  const float q0 = g.a0, q1 = fmaxf(g.a0, g.a1);
  float t = q1;
#pragma unroll
  for (int d = 1; d < 64; d <<= 1) { const float y = __shfl_up(t, d); if (lane >= d) t = fmaxf(t, y); }
  float ex = __shfl_up(t, 1); if (lane == 0) ex = -INFINITY;
  g.pm0 = fmaxf(q0, ex); g.pm1 = fmaxf(q1, ex);
  g.amax = __shfl(t, 63);
  return g;
}
DEV int chunk_ord(int dir, int i) { return dir == 0 ? i : (i < 2 ? 1 - i : 67 - i); }

template <int ph>
DEV void run_phase(const Params& p, unsigned char* smem) {
  const int tid = threadIdx.x, lane = tid & 63, w = tid >> 6, fr = lane & 15, fq = lane >> 4;
  unsigned char* ws = p.ws;
  bf16_t* const WT = (bf16_t*)(ws + (ph >= 11 ? OFF_WT2 : OFF_WT));
  bf16_t* const Hb = (bf16_t*)(ws + OFF_H);
  float* const Gt = (float*)(ws + OFF_G);
  float* const CS = (float*)(ws + OFF_CS);
  float* const MS = (float*)(ws + OFF_MS);
  float* const NV = (float*)(ws + OFF_NV);
  unsigned char* const AR = ws + OFF_AR;
  unsigned char* const DO = (unsigned char*)p.out;
  float* const sF = (float*)(smem + LDS_F);
  bf16_t* const sP = (bf16_t*)(smem + LDS_P);

    switch (ph) {
    case 0: {
      convert_weights(p, 0, smem, 0, gridDim.x);
      mod_phase(p, smem);
      rope_phase(p);
    } break;
    case 1: norm_phase(p, 0, 0, true, false); break;
    case 2: {
      bf16_t* QK = (bf16_t*)(AR + A0_QK); bf16_t* Vt = (bf16_t*)(AR + A0_VT); bf16_t* Ob = (bf16_t*)(AR + A0_O); bf16_t* Fb = (bf16_t*)(DO + DO_F);
      const float* bg = p.b_gate;
      auto epi = [&](f32x4 (&acc)[2][8], int mt, int nt) {
        const int b = mt / NCH;
        const int row0 = mt * 128 + 32 * w + fr, col0 = nt * 128 + 4 * fq;
        if (nt < 12 || (nt >= 18 && nt < 26)) {
          bf16_t* tb; int ld;
          if (nt < 12) { tb = QK + (size_t)row0 * 1536 + col0; ld = 1536; }
          else if (nt < 24) { tb = Ob + (size_t)row0 * 768 + (col0 - 2304); ld = 768; }
          else { tb = Fb + (size_t)row0 * 256 + (col0 - 3072); ld = 256; }
#pragma unroll
          for (int mi = 0; mi < 2; ++mi)
#pragma unroll
            for (int ni = 0; ni < 8; ++ni) {
              uint2 o; o.x = pk2(acc[mi][ni][0], acc[mi][ni][1]); o.y = pk2(acc[mi][ni][2], acc[mi][ni][3]);
              *(uint2*)(tb + (size_t)(16 * mi) * ld + 16 * ni) = o;
            }
        } else if (nt < 18) {
          bf16_t* tb = Vt + (size_t)b * 768 * S_ + (size_t)(col0 - 1536) * S_ + (row0 - b * S_);
#pragma unroll
          for (int mi = 0; mi < 2; ++mi)
#pragma unroll
            for (int ni = 0; ni < 8; ++ni)
#pragma unroll
              for (int j = 0; j < 4; ++j) tb[(size_t)(16 * ni + j) * S_ + 16 * mi] = f2bf(acc[mi][ni][j]);
        } else if (nt == 26) {
#pragma unroll
          for (int mi = 0; mi < 2; ++mi)
#pragma unroll
            for (int ni = 0; ni < 2; ++ni) {
              const int gc = 16 * ni + 4 * fq;
              if (gc < 24) { f32x4 o = acc[mi][ni]; o += *(const f32x4*)(bg + gc); *(f32x4*)(Gt + (size_t)(row0 + 16 * mi) * 24 + gc) = o; }
            }
        }
      };
      gemm_phase(Hb, LDH, (const bf16_t*)((unsigned char*)WT + WT_IN), D, M / 128, 27, false, epi, smem);
    } break;
    case 3: {
      const bf16_t* QK = (const bf16_t*)(AR + A0_QK);
      bf16_t* Qc = (bf16_t*)(AR + A0_QC); bf16_t* Kc = (bf16_t*)(AR + A0_KC); bf16_t* KcT = (bf16_t*)(DO + DO_KCT);
      bf16_t* ZT = (bf16_t*)(DO + DO_ZT); const bf16_t* Fb = (const bf16_t*)(DO + DO_F);
      for (int t = blockIdx.x; t < (M / 128) * 4; t += gridDim.x) {
        const int mt = t >> 2, g = t & 3;
        f32x4 acc[2][8]; zero_acc(acc);
        block_gemm<false>(acc, 1,
            [&](int row, int k) { return *(const uint4*)(Fb + (size_t)(mt * 128 + row) * 256 + g * 64 + k); },
            [&](int row, int k) {
              const int cp = row & 63, im = row >> 6; float vv[8];
#pragma unroll
              for (int j = 0; j < 8; ++j) { const int mm = (cp * (k + j)) & 63; const float xx = (float)mm * (1.f / 64.f); vv[j] = im ? -__builtin_amdgcn_sinf(xx) : __builtin_amdgcn_cosf(xx); }
              uint4 o; o.x = pk2(vv[0], vv[1]); o.y = pk2(vv[2], vv[3]); o.z = pk2(vv[4], vv[5]); o.w = pk2(vv[6], vv[7]); return o;
            }, smem, nullptr, 0);
        const int b = mt / NCH;
#pragma unroll
        for (int mi = 0; mi < 2; ++mi)
#pragma unroll
          for (int ni = 0; ni < 8; ++ni) {
            const int row = mt * 128 + 32 * w + 16 * mi + fr, s = row - b * S_;
#pragma unroll
            for (int j = 0; j < 4; ++j) {
              const int n = 16 * ni + 4 * fq + j, cp = n & 63, im = n >> 6;
              ZT[(size_t)((b * 256 + g * 64 + cp) * 2 + im) * S_ + s] = f2bf(acc[mi][ni][j]);
            }
          }
      }
      bf16_t* tl = (bf16_t*)smem;
      for (int t = blockIdx.x; t < (M / 64) * 12; t += gridDim.x) {
        const int rt = t / 12, ct = t % 12;
        const int r0 = rt * 64, b = r0 / S_, s0 = r0 - b * S_;
        const int lo = (s0 < CTX) ? 0 : CTX, hi = (s0 < CTX) ? CTX - 1 : S_ - 1;
        __syncthreads();
#pragma unroll
        for (int i = 0; i < 4; ++i) {
          const int id = tid + 256 * i, rr = id >> 4, cc = (id & 15) * 8;
          const int s = s0 + rr, c = ct * 128 + cc;
          const size_t base = (size_t)(r0 + rr) * 1536 + c;
          uint4 z = {0u, 0u, 0u, 0u};
          const uint4 u1 = *(const uint4*)(QK + base);
          const uint4 u0 = (s - 1 >= lo) ? *(const uint4*)(QK + base - 1536) : z;
          const uint4 u2 = (s + 1 <= hi) ? *(const uint4*)(QK + base + 1536) : z;
          const unsigned a0[4] = {u0.x, u0.y, u0.z, u0.w}, a1[4] = {u1.x, u1.y, u1.z, u1.w}, a2[4] = {u2.x, u2.y, u2.z, u2.w};
          float o[8];
          {
            const f32x4 wa0 = *(const f32x4*)(p.w_qk_conv + c), wa1 = *(const f32x4*)(p.w_qk_conv + c + 4);
            const f32x4 wb0 = *(const f32x4*)(p.w_qk_conv + 1536 + c), wb1 = *(const f32x4*)(p.w_qk_conv + 1536 + c + 4);
            const f32x4 wc0 = *(const f32x4*)(p.w_qk_conv + 3072 + c), wc1 = *(const f32x4*)(p.w_qk_conv + 3072 + c + 4);
            const float wA[8] = {wa0[0], wa0[1], wa0[2], wa0[3], wa1[0], wa1[1], wa1[2], wa1[3]};
            const float wB[8] = {wb0[0], wb0[1], wb0[2], wb0[3], wb1[0], wb1[1], wb1[2], wb1[3]};
            const float wC[8] = {wc0[0], wc0[1], wc0[2], wc0[3], wc1[0], wc1[1], wc1[2], wc1[3]};
#pragma unroll
            for (int e = 0; e < 4; ++e) {
              o[2 * e] = siluf_(wA[2 * e] * bflo(a0[e]) + wB[2 * e] * bflo(a1[e]) + wC[2 * e] * bflo(a2[e]));
              o[2 * e + 1] = siluf_(wA[2 * e + 1] * bfhi(a0[e]) + wB[2 * e + 1] * bfhi(a1[e]) + wC[2 * e + 1] * bfhi(a2[e]));
            }
          }
          if (ct < 6) {
            const float sc = 0.08838834764831845f;
            uint4 q; q.x = pk2(o[0] * sc, o[1] * sc); q.y = pk2(o[2] * sc, o[3] * sc); q.z = pk2(o[4] * sc, o[5] * sc); q.w = pk2(o[6] * sc, o[7] * sc);
            *(uint4*)(Qc + (size_t)(r0 + rr) * 768 + c) = q;
          } else {
            uint4 q; q.x = pk2(o[0], o[1]); q.y = pk2(o[2], o[3]); q.z = pk2(o[4], o[5]); q.w = pk2(o[6], o[7]);
            *(uint4*)(Kc + (size_t)(r0 + rr) * 768 + c - 768) = q;
#pragma unroll
            for (int e = 0; e < 8; ++e) tl[(cc + e) * LDT + rr] = f2bf(o[e]);
          }
        }
        __syncthreads();
        if (ct >= 6) {
#pragma unroll
          for (int i = 0; i < 4; ++i) {
            const int id = tid + 256 * i, cc = id >> 3, sc8 = (id & 7) * 8;
            const uint4 v = *(const uint4*)&tl[cc * LDT + sc8];
            *(uint4*)(KcT + (size_t)(b * 768 + (ct - 6) * 128 + cc) * S_ + s0 + sc8) = v;
          }
        }
      }
    } break;
    case 4: {
      const bf16_t* ZT = (const bf16_t*)(DO + DO_ZT);
      const int NF = 512 + 8;
      bf16_t* ApT = (bf16_t*)(DO + DO_F);
      const bf16_t* Vt = (const bf16_t*)(AR + A0_VT); const bf16_t* KcT = (const bf16_t*)(DO + DO_KCT); const bf16_t* Kc = (const bf16_t*)(AR + A0_KC);
      bf16_t* ST = (bf16_t*)(AR + A0_ST);
      for (int t = blockIdx.x; t < NF + 24 * NCH; t += gridDim.x) {
        if (t < 512) {
          const int mt = t & 1, ct = t >> 1;
          f32x4 acc[2][8]; zero_acc(acc);
          block_gemm<false>(acc, 4,
              [&](int row, int k) {
                const int p1 = mt * 64 + (row >> 1), op = row & 1, part = k >> 7, t1 = k & 127; float vv[8];
#pragma unroll
                for (int j = 0; j < 8; ++j) {
                  const float xx = (float)((p1 * (t1 + j)) & 127) * (1.f / 128.f);
                  const float cv = __builtin_amdgcn_cosf(xx), sv = __builtin_amdgcn_sinf(xx);
                  vv[j] = op == 0 ? (part == 0 ? cv : sv) : (part == 0 ? -sv : cv);
                }
                uint4 o; o.x = pk2(vv[0], vv[1]); o.y = pk2(vv[2], vv[3]); o.z = pk2(vv[4], vv[5]); o.w = pk2(vv[6], vv[7]); return o;
              },
              [&](int row, int k) {
                const int n = 2 * ct + (row >> 6), t2 = row & 63, part = k >> 7, t1 = k & 127;
                const bf16_t* src = ZT + (size_t)(n * 2 + part) * S_ + CTX + 64 * t1 + t2;
                unsigned e[8];
#pragma unroll
                for (int j = 0; j < 8; ++j) e[j] = src[64 * j];
                uint4 o; o.x = e[0] | (e[1] << 16); o.y = e[2] | (e[3] << 16); o.z = e[4] | (e[5] << 16); o.w = e[6] | (e[7] << 16); return o;
              }, smem, nullptr, 0);
#pragma unroll
          for (int mi = 0; mi < 2; ++mi) {
            const int row = 32 * w + 16 * mi + fr, p1 = mt * 64 + (row >> 1), op = row & 1;
#pragma unroll
            for (int ni = 0; ni < 8; ++ni) {
              const int col = 16 * ni + 4 * fq, n = 2 * ct + (col >> 6), t2 = col & 63;
              f32x4 v = acc[mi][ni], o;
#pragma unroll
              for (int j = 0; j < 4; ++j) {
                const float other = __shfl_xor(v[j], 1);
                const float xx = (float)((p1 * (t2 + j)) & 8191) * (1.f / 8192.f);
                const float cv = __builtin_amdgcn_cosf(xx), sv = __builtin_amdgcn_sinf(xx);
                o[j] = op == 0 ? (v[j] * cv + other * sv) : (v[j] * cv - other * sv);
              }
              store_bf16_row(ApT, 128, p1 * 512 + n, op * 64 + t2, o);
            }
          }
        } else if (t < NF) {
          const int tt = t - 512, mt = tt >> 2, nt = tt & 3;
          const int T = 256, tmask = T - 1;
          const float invT = 1.f / (float)T;
          f32x4 acc[2][8]; zero_acc(acc);
          block_gemm<false>(acc, 2 * T / 64,
              [&](int row, int k) {
                const int pp = mt * 128 + row, part = k >= T, t0 = k & tmask; float vv[8];
#pragma unroll
                for (int j = 0; j < 8; ++j) { const int mm = (pp * (t0 + j)) & tmask; const float xx = (float)mm * invT; vv[j] = part ? __builtin_amdgcn_sinf(xx) : __builtin_amdgcn_cosf(xx); }
                uint4 o; o.x = pk2(vv[0], vv[1]); o.y = pk2(vv[2], vv[3]); o.z = pk2(vv[4], vv[5]); o.w = pk2(vv[6], vv[7]); return o;
              },
              [&](int row, int k) { const int part = k >= T, t0 = k & tmask; return *(const uint4*)(ZT + (size_t)((nt * 128 + row) * 2 + part) * S_ + t0); },
              smem, nullptr, 0);
#pragma unroll
          for (int mi = 0; mi < 2; ++mi)
#pragma unroll
            for (int ni = 0; ni < 8; ++ni) {
              const int pp = mt * 128 + 32 * w + 16 * mi + fr, n = nt * 128 + 16 * ni + 4 * fq, b = n >> 8;
              f32x4 v = acc[mi][ni]; v *= (1.f / 128.f);
              store_bf16_row(Hb, LDH, b * S_ + pp, 768 + (n & 255), v);
            }
        } else {
          const int ta = t - NF, sd = ta / NCH, n = ta % NCH;
          const int dir = sd / 12, b = (sd / 6) & 1, h = sd % 6;
          const int r0 = b * S_ + n * 128;
          float* sW = sF;
          __syncthreads();
          if (w == 0) {
            const GateScan g = gate_scan(Gt, r0, dir, h, lane);
            sW[g.pos0] = __expf(g.a0 - g.amax); sW[g.pos1] = __expf(g.a1 - g.amax);
            if (lane == 0) { CS[(sd * NCH + n) * 4 + 0] = g.amax; CS[(sd * NCH + n) * 4 + 1] = g.F; }
          }
          __syncthreads();
          f32x4 acc[2][8]; zero_acc(acc);
          const bf16_t* Ab = Vt + (size_t)(b * 768 + h * 128) * S_ + n * 128;
          const bf16_t* Bb = KcT + (size_t)(b * 768 + h * 128) * S_ + n * 128;
          block_gemm<false>(acc, 2,
              [&](int row, int k) { return *(const uint4*)(Ab + (size_t)row * S_ + k); },
              [&](int row, int k) {
                const uint4 u = *(const uint4*)(Bb + (size_t)row * S_ + k);
                uint4 o;
                o.x = pk2(bflo(u.x) * sW[k], bfhi(u.x) * sW[k + 1]); o.y = pk2(bflo(u.y) * sW[k + 2], bfhi(u.y) * sW[k + 3]);
                o.z = pk2(bflo(u.z) * sW[k + 4], bfhi(u.z) * sW[k + 5]); o.w = pk2(bflo(u.w) * sW[k + 6], bfhi(u.w) * sW[k + 7]);
                return o;
              }, smem, nullptr, 0);
          bf16_t* Sd = ST + (size_t)(sd * NCH + n) * 16384;
#pragma unroll
          for (int mi = 0; mi < 2; ++mi)
#pragma unroll
            for (int ni = 0; ni < 8; ++ni) store_bf16_row(Sd, 128, 32 * w + 16 * mi + fr, 16 * ni + 4 * fq, acc[mi][ni]);
          if (tid < 128) {
            int tix = tid; asm volatile("" : "+v"(tix));
            const uint4* krow = (const uint4*)(KcT + (size_t)(b * 768 + h * 128 + tix) * S_ + n * 128);
            float a = 0.f;
#pragma unroll
            for (int c = 0; c < 16; ++c) {
              const uint4 u = krow[c]; const float* ww = sW + 8 * c;
              a += bflo(u.x) * ww[0] + bfhi(u.x) * ww[1] + bflo(u.y) * ww[2] + bfhi(u.y) * ww[3] + bflo(u.z) * ww[4] + bfhi(u.z) * ww[5] + bflo(u.w) * ww[6] + bfhi(u.w) * ww[7];
            }
            NV[(size_t)(sd * NCH + n) * 128 + tix] = a;
          }
        }
      }
    } break;
    case 5: {
      {
        const bf16_t* ApT = (const bf16_t*)(DO + DO_F);
        for (int t = blockIdx.x; t < 512; t += gridDim.x) {
          const int p1 = t >> 2, n0 = (t & 3) * 128;
          f32x4 acc[2][8]; zero_acc(acc);
          block_gemm<false>(acc, 2,
              [&](int row, int k) { return *(const uint4*)(ApT + (size_t)(t * 128 + row) * 128 + k); },
              [&](int row, int k) {
                uint4 o = {0u, 0u, 0u, 0u};
                if (row < 64) {
                  const int part = k >> 6, t2 = k & 63; float vv[8];
#pragma unroll
                  for (int j = 0; j < 8; ++j) { const float xx = (float)((row * (t2 + j)) & 63) * (1.f / 64.f); vv[j] = part ? __builtin_amdgcn_sinf(xx) : __builtin_amdgcn_cosf(xx); }
                  o.x = pk2(vv[0], vv[1]); o.y = pk2(vv[2], vv[3]); o.z = pk2(vv[4], vv[5]); o.w = pk2(vv[6], vv[7]);
                }
                return o;
              }, smem, nullptr, 0);
#pragma unroll
          for (int mi = 0; mi < 2; ++mi) {
            const int n = n0 + 32 * w + 16 * mi + fr, b = n >> 8;
#pragma unroll
            for (int ni = 0; ni < 4; ++ni)
#pragma unroll
              for (int j = 0; j < 4; ++j) {
                const int p2 = 16 * ni + 4 * fq + j;
                Hb[(size_t)(b * S_ + CTX + p1 + 128 * p2) * LDH + 768 + (n & 255)] = f2bf(acc[mi][ni][j] * 0.0013810679320049757f);
              }
          }
        }
      }
      if (gridDim.x >= 400) convert_weights(p, 1, smem, 200, gridDim.x - 200); else convert_weights(p, 1, smem, 0, gridDim.x);
      bf16_t* ST = (bf16_t*)(AR + A0_ST);
      for (int e = blockIdx.x * 256 + tid; e < 24 * 2064; e += gridDim.x * 256) {
        const int sd = e / 2064, idx = e % 2064, dir = sd / 12;
        float cst[8];
#pragma unroll
        for (int j = 0; j < 8; ++j) cst[j] = 0.f;
        float m = 0.f;
        uint4 ring0[4], ring1[4]; float ra[4], rf[4];
#define SC_FETCH(i_, u_) do { const int n_ = chunk_ord(dir, (i_)); ra[u_] = CS[(sd * NCH + n_) * 4 + 0]; rf[u_] = CS[(sd * NCH + n_) * 4 + 1]; \
          if (idx < 2048) ring0[u_] = *(const uint4*)(ST + (size_t)(sd * NCH + n_) * 16384 + idx * 8); \
          else { const uint4* q_ = (const uint4*)(NV + (size_t)(sd * NCH + n_) * 128 + (idx - 2048) * 8); ring0[u_] = q_[0]; ring1[u_] = q_[1]; } } while (0)
#pragma unroll
        for (int u = 0; u < 4; ++u) { ring1[u] = uint4{0u, 0u, 0u, 0u}; SC_FETCH(u, u); }
        for (int i0 = 0; i0 < NCH; i0 += 4) {
#pragma unroll
          for (int u = 0; u < 4; ++u) {
            const int i = i0 + u;
            if (i < NCH) {
              const int n = chunk_ord(dir, i);
              const float amax = ra[u], F = rf[u];
              const uint4 c0 = ring0[u], c1 = ring1[u];
              if (i + 4 < NCH) SC_FETCH(i + 4, u);
              const float Mx = fmaxf(m, amax), dcy = __expf(m - Mx), scl = __expf(amax - Mx);
              if (idx < 2048) {
                uint4* ptr = (uint4*)(ST + (size_t)(sd * NCH + n) * 16384 + idx * 8);
                uint4 o; o.x = pk2(cst[0], cst[1]); o.y = pk2(cst[2], cst[3]); o.z = pk2(cst[4], cst[5]); o.w = pk2(cst[6], cst[7]);
                *ptr = o;
                cst[0] = dcy * cst[0] + scl * bflo(c0.x); cst[1] = dcy * cst[1] + scl * bfhi(c0.x);
                cst[2] = dcy * cst[2] + scl * bflo(c0.y); cst[3] = dcy * cst[3] + scl * bfhi(c0.y);
                cst[4] = dcy * cst[4] + scl * bflo(c0.z); cst[5] = dcy * cst[5] + scl * bfhi(c0.z);
                cst[6] = dcy * cst[6] + scl * bflo(c0.w); cst[7] = dcy * cst[7] + scl * bfhi(c0.w);
              } else {
                uint4* ptr = (uint4*)(NV + (size_t)(sd * NCH + n) * 128 + (idx - 2048) * 8);
                uint4 o0, o1;
                o0.x = __float_as_uint(cst[0]); o0.y = __float_as_uint(cst[1]); o0.z = __float_as_uint(cst[2]); o0.w = __float_as_uint(cst[3]);
                o1.x = __float_as_uint(cst[4]); o1.y = __float_as_uint(cst[5]); o1.z = __float_as_uint(cst[6]); o1.w = __float_as_uint(cst[7]);
                ptr[0] = o0; ptr[1] = o1;
                cst[0] = dcy * cst[0] + scl * __uint_as_float(c0.x); cst[1] = dcy * cst[1] + scl * __uint_as_float(c0.y);
                cst[2] = dcy * cst[2] + scl * __uint_as_float(c0.z); cst[3] = dcy * cst[3] + scl * __uint_as_float(c0.w);
                cst[4] = dcy * cst[4] + scl * __uint_as_float(c1.x); cst[5] = dcy * cst[5] + scl * __uint_as_float(c1.y);
                cst[6] = dcy * cst[6] + scl * __uint_as_float(c1.z); cst[7] = dcy * cst[7] + scl * __uint_as_float(c1.w);
              }
              if (idx == 0) MS[sd * NCH + n] = m;
              m = F + Mx;
            }
          }
        }
#undef SC_FETCH
      }
    } break;
    case 6: {
      const bf16_t* Vt = (const bf16_t*)(AR + A0_VT); const bf16_t* Qc = (const bf16_t*)(AR + A0_QC); const bf16_t* Kc = (const bf16_t*)(AR + A0_KC);
      const bf16_t* ST = (const bf16_t*)(AR + A0_ST); const bf16_t* Ob = (const bf16_t*)(AR + A0_O);
      float* aA = sF; float* aM = sF + 256; float* aI = sF + 512; float* aE = sF + 768; float* sN = sF + 1024; float* sQN = sF + 1280; float* sSC = sF + 1536;
      for (int t = blockIdx.x; t < 12 * NCH; t += gridDim.x) {
        const int bh = t / NCH, n = t % NCH, b = bh / 6, h = bh % 6;
        const int r0 = b * S_ + n * 128;
        __syncthreads();
        if (w < 2) {
          const int dir = w, sd = (dir * 2 + b) * 6 + h;
          const GateScan g = gate_scan(Gt, r0, dir, h, lane);
          const float mp = MS[sd * NCH + n];
          const float M0 = fmaxf(mp, g.pm0), M1 = fmaxf(mp, g.pm1);
          aA[dir * 128 + g.pos0] = __expf(g.a0 - g.amax); aA[dir * 128 + g.pos1] = __expf(g.a1 - g.amax);
          aM[dir * 128 + g.pos0] = __expf(g.amax - M0); aM[dir * 128 + g.pos1] = __expf(g.amax - M1);
          aI[dir * 128 + g.pos0] = __expf(mp - M0); aI[dir * 128 + g.pos1] = __expf(mp - M1);
          aE[dir * 128 + g.pos0] = __expf(-(g.b0 + M0)); aE[dir * 128 + g.pos1] = __expf(-(g.b1 + M1));
        } else {
          const int dir = w - 2, sd = (dir * 2 + b) * 6 + h;
          sN[dir * 128 + lane] = NV[(size_t)(sd * NCH + n) * 128 + lane];
          sN[dir * 128 + 64 + lane] = NV[(size_t)(sd * NCH + n) * 128 + 64 + lane];
        }
        __syncthreads();
        const bf16_t* Qb = Qc + (size_t)r0 * 768 + h * 128;
        const bf16_t* Kb = Kc + (size_t)r0 * 768 + h * 128;
        {
          const int qr = tid >> 1, k0 = (tid & 1) * 64;
          float sf = 0.f, sb = 0.f;
#pragma unroll
          for (int c8 = 0; c8 < 8; ++c8) {
            const uint4 u = *(const uint4*)(Qb + (size_t)qr * 768 + k0 + c8 * 8);
            const float* nf = sN + k0 + c8 * 8; const float* nb = sN + 128 + k0 + c8 * 8;
            sf += bflo(u.x) * nf[0] + bfhi(u.x) * nf[1] + bflo(u.y) * nf[2] + bfhi(u.y) * nf[3] + bflo(u.z) * nf[4] + bfhi(u.z) * nf[5] + bflo(u.w) * nf[6] + bfhi(u.w) * nf[7];
            sb += bflo(u.x) * nb[0] + bfhi(u.x) * nb[1] + bflo(u.y) * nb[2] + bfhi(u.y) * nb[3] + bflo(u.z) * nb[4] + bfhi(u.z) * nb[5] + bflo(u.w) * nb[6] + bfhi(u.w) * nb[7];
          }
          sf += __shfl_xor(sf, 1); sb += __shfl_xor(sb, 1);
          if ((tid & 1) == 0) { sQN[qr] = sf; sQN[128 + qr] = sb; }
        }
        f32x4 acc[2][8]; zero_acc(acc);
        block_gemm<false>(acc, 2,
            [&](int row, int k) { return *(const uint4*)(Qb + (size_t)row * 768 + k); },
            [&](int row, int k) { return *(const uint4*)(Kb + (size_t)row * 768 + k); }, smem, nullptr, 0);
        __syncthreads();
        {
          float rsf[2] = {0.f, 0.f}, rsb[2] = {0.f, 0.f};
#pragma unroll
          for (int ni = 0; ni < 8; ++ni) {
            const int s0 = 16 * ni + 4 * fq;
            const f32x4 ef = *(const f32x4*)(aA + s0), eb = *(const f32x4*)(aA + 128 + s0);
#pragma unroll
            for (int mi = 0; mi < 2; ++mi) {
              const int tr = 32 * w + 16 * mi + fr;
#pragma unroll
              for (int j = 0; j < 4; ++j) {
                const float sv = acc[mi][ni][j];
                rsf[mi] += (s0 + j <= tr) ? sv * ef[j] : 0.f;
                rsb[mi] += (s0 + j >= tr) ? sv * eb[j] : 0.f;
              }
            }
          }
          float cf[2], cb[2];
#pragma unroll
          for (int mi = 0; mi < 2; ++mi) {
            const int tr = 32 * w + 16 * mi + fr;
            float a = rsf[mi], c2 = rsb[mi];
            a += __shfl_xor(a, 16); a += __shfl_xor(a, 32); c2 += __shfl_xor(c2, 16); c2 += __shfl_xor(c2, 32);
            const float denf = a * aM[tr] + aI[tr] * sQN[tr], denb = c2 * aM[128 + tr] + aI[128 + tr] * sQN[128 + tr];
            const float ddf = 1.f / fmaxf(fabsf(denf), aE[tr]), ddb = 1.f / fmaxf(fabsf(denb), aE[128 + tr]);
            if (fq == 0) { sSC[tr] = aI[tr] * ddf; sSC[128 + tr] = aI[128 + tr] * ddb; }
            cf[mi] = aM[tr] * ddf; cb[mi] = aM[128 + tr] * ddb;
          }
#pragma unroll
          for (int ni = 0; ni < 8; ++ni) {
            const int s0 = 16 * ni + 4 * fq;
            const f32x4 ef = *(const f32x4*)(aA + s0), eb = *(const f32x4*)(aA + 128 + s0);
#pragma unroll
            for (int mi = 0; mi < 2; ++mi) {
              const int tr = 32 * w + 16 * mi + fr;
              f32x4 pv;
#pragma unroll
              for (int j = 0; j < 4; ++j) {
                const float df = (s0 + j <= tr) ? ef[j] * cf[mi] : 0.f;
                const float db = (s0 + j >= tr) ? eb[j] * cb[mi] : 0.f;
                pv[j] = acc[mi][ni][j] * (df + db);
              }
              uint2 o; o.x = pk2(pv[0], pv[1]); o.y = pk2(pv[2], pv[3]);
              *(uint2*)&sP[tr * LDP + s0] = o;
            }
          }
        }
        __syncthreads();
        zero_acc(acc);
        {
          const bf16_t* Vb = Vt + (size_t)(b * 768 + h * 128) * S_ + n * 128;
          block_gemm<true>(acc, 2, [&](int, int) { return uint4{0u, 0u, 0u, 0u}; },
              [&](int row, int k) { return *(const uint4*)(Vb + (size_t)row * S_ + k); }, smem, sP, LDP);
        }
#pragma unroll
        for (int dir = 0; dir < 2; ++dir) {
          const int sd = (dir * 2 + b) * 6 + h;
          const bf16_t* Cb = ST + (size_t)(sd * NCH + n) * 16384;
          block_gemm<false>(acc, 2,
              [&](int row, int k) {
                const uint4 u = *(const uint4*)(Qb + (size_t)row * 768 + k);
                const float sc = sSC[dir * 128 + row];
                uint4 o; o.x = pk2(bflo(u.x) * sc, bfhi(u.x) * sc); o.y = pk2(bflo(u.y) * sc, bfhi(u.y) * sc);
                o.z = pk2(bflo(u.z) * sc, bfhi(u.z) * sc); o.w = pk2(bflo(u.w) * sc, bfhi(u.w) * sc); return o;
              },
              [&](int row, int k) { return *(const uint4*)(Cb + (size_t)row * 128 + k); }, smem, nullptr, 0);
        }
#pragma unroll
        for (int mi = 0; mi < 2; ++mi) {
          const int tr = 32 * w + 16 * mi + fr, row = r0 + tr;
          float ss = 0.f;
#pragma unroll
          for (int ni = 0; ni < 8; ++ni)
#pragma unroll
            for (int j = 0; j < 4; ++j) ss += acc[mi][ni][j] * acc[mi][ni][j];
          ss += __shfl_xor(ss, 16); ss += __shfl_xor(ss, 32);
          const float rstd = rsqrtf(ss * (1.f / 128.f) + EPS);
#pragma unroll
          for (int ni = 0; ni < 8; ++ni) {
            const int col = h * 128 + 16 * ni + 4 * fq;
            const f32x4 gg = *(const f32x4*)(p.g_head + col);
            const uint2 ou = *(const uint2*)(Ob + (size_t)row * 768 + col);
            f32x4 v;
            v[0] = acc[mi][ni][0] * rstd * gg[0] * sigmoidf_(bflo(ou.x)); v[1] = acc[mi][ni][1] * rstd * gg[1] * sigmoidf_(bfhi(ou.x));
            v[2] = acc[mi][ni][2] * rstd * gg[2] * sigmoidf_(bflo(ou.y)); v[3] = acc[mi][ni][3] * rstd * gg[3] * sigmoidf_(bfhi(ou.y));
            store_bf16_row(Hb, LDH, row, col, v);
          }
        }
      }
    } break;
    case 7: case 10: case 15: case 18: {
      const bool is_ff2 = (ph == 10 || ph == 18);
      const int layer = ph >= 15 ? 1 : 0;
      const bool from_input = (ph == 7);
      const bf16_t* A = is_ff2 ? (const bf16_t*)AR : Hb;
      const int K = is_ff2 ? DFF : D;
      const bf16_t* Bt = (const bf16_t*)((unsigned char*)WT + (is_ff2 ? WT_FF2 : WT_OUT));
      const int gidx = is_ff2 ? 5 : 2;
      auto epi = [&](f32x4 (&acc)[2][8], int mt, int nt) {
#pragma unroll
        for (int mi = 0; mi < 2; ++mi) {
          const int row = mt * 128 + 32 * w + 16 * mi + fr;
          const float* xs = xsrc_row(p, from_input, row);
          float* xd = xdst_row(p, row);
          const float* gate = mod_row(p, layer, row) + gidx * 1024;
#pragma unroll
          for (int ni = 0; ni < 8; ++ni) {
            const int col = nt * 128 + 16 * ni + 4 * fq;
            const f32x4 xv = *(const f32x4*)(xs + col), gv = *(const f32x4*)(gate + col);
            f32x4 o = xv + gv * acc[mi][ni];
            *(f32x4*)(xd + col) = o;
          }
        }
      };
      const int lda = is_ff2 ? LDHID : LDH;
      gemm_phase(A, lda, Bt, K, M / 128, 8, true, epi, smem);
      if (layer == 0) {
        const int ldb = K + 64, kper = K / 4;
        float* PART = (float*)(AR + A_PART);
        for (int u = blockIdx.x; u < 32 * 4; u += gridDim.x) {
          const int tile = u >> 2, ks = u & 3, mc = tile >> 3, nt = tile & 7, mt = (mc >> 1) * NCH + (mc & 1);
          f32x4 acc[2][8]; zero_acc(acc);
          block_gemm_glds(acc, kper / 64, A + (size_t)mt * 128 * lda + ks * kper, (size_t)lda, Bt + (size_t)nt * 128 * ldb + ks * kper, (size_t)ldb, smem);
#pragma unroll
          for (int mi = 0; mi < 2; ++mi) {
            const int row = mt * 128 + 32 * w + 16 * mi + fr, rc = (row / S_) * CTX + (row % S_);
            const float* gate = mod_row(p, layer, row) + gidx * 1024;
            float* pd = PART + ((size_t)ks * 512 + rc) * 1024;
#pragma unroll
            for (int ni = 0; ni < 8; ++ni) {
              const int col = nt * 128 + 16 * ni + 4 * fq;
              const f32x4 gv = *(const f32x4*)(gate + col);
              *(f32x4*)(pd + col) = gv * acc[mi][ni];
            }
          }
        }
      }
    } break;
    case 8: norm_phase(p, 0, 1, false, false, 1); break;
    case 9: case 17: {
      bf16_t* Hid = (bf16_t*)AR;
      auto epi = [&](f32x4 (&acc)[2][8], int mt, int nt) {
#pragma unroll
        for (int mi = 0; mi < 2; ++mi)
#pragma unroll
          for (int ni = 0; ni < 8; ++ni) {
            f32x4 v = acc[mi][ni];
#pragma unroll
            for (int j = 0; j < 4; ++j) { const float r = fmaxf(v[j], 0.f); v[j] = r * r; }
            store_bf16_row(Hid, LDHID, mt * 128 + 32 * w + 16 * mi + fr, nt * 128 + 16 * ni + 4 * fq, v);
          }
      };
      gemm_phase(Hb, LDH, (const bf16_t*)((unsigned char*)WT + WT_FF1), D, M / 128, 32, ph == 17, epi, smem);
    } break;
    case 11: {
      norm_phase(p, 1, 0, false, false, 2);
    } break;
    case 12: {
      bf16_t* Qb = (bf16_t*)(AR + A1_Q); bf16_t* Kb = (bf16_t*)(AR + A1_K); bf16_t* Vt = (bf16_t*)(AR + A1_VT); bf16_t* GL = (bf16_t*)(AR + A1_GLU);
      const float* cT = (const float*)(ws + OFF_ROPE); const float* sT = cT + 8192 * 32;
      auto epi = [&](f32x4 (&acc)[2][8], int mt, int nt) {
        const int b = mt / NCH;
        if (nt < 12) {
#pragma unroll
          for (int mi = 0; mi < 2; ++mi) {
            const int row = mt * 128 + 32 * w + 16 * mi + fr, s = row - b * S_;
            if (s >= CTX) {
              const int tpos = s - CTX;
#pragma unroll
              for (int g2 = 0; g2 < 2; ++g2)
#pragma unroll
                for (int nn = 0; nn < 2; ++nn) {
                  const int ni = g2 * 4 + nn, d0 = nn * 16 + 4 * fq;
                  const f32x4 cc = *(const f32x4*)(cT + tpos * 32 + d0), sn = *(const f32x4*)(sT + tpos * 32 + d0);
                  const f32x4 x1 = acc[mi][ni], x2 = acc[mi][ni + 2];
                  acc[mi][ni] = x1 * cc - x2 * sn; acc[mi][ni + 2] = x2 * cc + x1 * sn;
                }
            }
          }
        }
#pragma unroll
        for (int mi = 0; mi < 2; ++mi)
#pragma unroll
          for (int ni = 0; ni < 8; ++ni) {
            const int row = mt * 128 + 32 * w + 16 * mi + fr, col = nt * 128 + 16 * ni + 4 * fq;
            f32x4 v = acc[mi][ni];
            if (nt < 6) { v *= 0.18033688011112042f; store_bf16_row(Qb, 768, row, col, v); }
            else if (nt < 12) store_bf16_row(Kb, 768, row, col - 768, v);
            else if (nt < 18) store_bf16_T(Vt + (size_t)b * 768 * S_, col - 1536, row - b * S_, v);
            else store_bf16_row(GL, 512, row, col - 2304, v);
          }
      };
      gemm_phase(Hb, LDH, (const bf16_t*)((unsigned char*)WT + WT_IN), D, M / 128, 22, false, epi, smem);
    } break;
    case 13: {
      const bf16_t* Qb = (const bf16_t*)(AR + A1_Q); const bf16_t* Kb = (const bf16_t*)(AR + A1_K); const bf16_t* Vt = (const bf16_t*)(AR + A1_VT);
      bf16_t* OA = (bf16_t*)(AR + A1_OA);
      const int r = lane & 31, hh = lane >> 5;
      constexpr int STAGE = 24576, SV_OFF = 8192, NKT = S_ / 64;
      for (int t = blockIdx.x; t < NB * 6 * 2 * 64; t += gridDim.x) {
        const int qt = t & 63, mp = (t >> 6) & 1, bh = t >> 7, b = bh / 6, h = bh % 6;
        const int rq0 = b * S_ + CTX + qt * 128;
        const bf16_t* Qp = Qb + (size_t)rq0 * 768 + h * 128 + mp * 64;
        const bf16_t* Kp = Kb + (size_t)b * S_ * 768 + h * 128 + mp * 64;
        const bf16_t* Vp = Vt + (size_t)(b * 768 + h * 128) * S_;
        bf16x8 qf[4];
#pragma unroll
        for (int ks = 0; ks < 4; ++ks) qf[ks] = *(const bf16x8*)(Qp + (size_t)(32 * w + r) * 768 + 16 * ks + 8 * hh);
        f32x16 o[4];
#pragma unroll
        for (int db = 0; db < 4; ++db)
#pragma unroll
          for (int i = 0; i < 16; ++i) o[db][i] = 0.f;
        float mrun = -INFINITY, lrun = 0.f;
        LASG unsigned char* lb = (LASG unsigned char*)smem;
        const int g8 = lane >> 3, gp = lane & 7;
#define ATT_ISSUE(st_, kt_) do { \
          _Pragma("unroll") for (int i = 0; i < 2; ++i) { const int rho = 16 * w + 8 * i + g8, key_ = (rho & ~12) | ((rho & 4) << 1) | ((rho & 8) >> 1); \
            __builtin_amdgcn_global_load_lds((const unsigned*)(Kp + (size_t)((kt_) * 64 + key_) * 768 + ((gp ^ ((rho >> 1) & 7)) * 8)), (LASG unsigned*)(lb + (st_) * STAGE + (16 * w + 8 * i) * 128 + lane * 16), 16, 0, 0); } \
          _Pragma("unroll") for (int i = 0; i < 4; ++i) { const int rho = 32 * w + 8 * i + g8; \
            __builtin_amdgcn_global_load_lds((const unsigned*)(Vp + (size_t)rho * S_ + (kt_) * 64 + ((gp ^ ((rho >> 1) & 7)) * 8)), (LASG unsigned*)(lb + (st_) * STAGE + SV_OFF + (32 * w + 8 * i) * 128 + lane * 16), 16, 0, 0); } } while (0)
        const int rsw = (r >> 1) & 7;
        __syncthreads();
        ATT_ISSUE(0, 0);
        for (int kt = 0; kt < NKT; ++kt) {
          const int st = kt & 1;
          __syncthreads();
          if (kt + 1 < NKT) ATT_ISSUE(st ^ 1, kt + 1);
          const unsigned char* sK = smem + st * STAGE; const unsigned char* sV = sK + SV_OFF;
          f32x16 sx[2];
#pragma unroll
          for (int kb = 0; kb < 2; ++kb) {
#pragma unroll
            for (int i = 0; i < 16; ++i) sx[kb][i] = 0.f;
#pragma unroll
            for (int ks = 0; ks < 4; ++ks) {
              const bf16x8 kf = *(const bf16x8*)(sK + (32 * kb + r) * 128 + (((2 * ks + hh) ^ rsw) * 16));
              sx[kb] = __builtin_amdgcn_mfma_f32_32x32x16_bf16(kf, qf[ks], sx[kb], 0, 0, 0);
            }
          }
          float mx = sx[0][0];
#pragma unroll
          for (int i = 0; i < 16; ++i) { mx = fmaxf(mx, sx[0][i]); mx = fmaxf(mx, sx[1][i]); }
          mx = xor32_max(mx);
          const float mnew = fmaxf(mrun, mx), alpha = __builtin_amdgcn_exp2f(mrun - mnew);
          float rs = 0.f;
#pragma unroll
          for (int kb = 0; kb < 2; ++kb)
#pragma unroll
            for (int i = 0; i < 16; ++i) { const float pv = __builtin_amdgcn_exp2f(sx[kb][i] - mnew); sx[kb][i] = pv; rs += pv; }
          rs = xor32_sum(rs);
          lrun = lrun * alpha + rs; mrun = mnew;
          if (__any(alpha != 1.f)) {
#pragma unroll
            for (int db = 0; db < 4; ++db) o[db] *= alpha;
          }
#pragma unroll
          for (int kb = 0; kb < 2; ++kb)
#pragma unroll
            for (int s2 = 0; s2 < 2; ++s2) {
              uint4 xp;
              xp.x = pk2(sx[kb][8 * s2 + 0], sx[kb][8 * s2 + 1]); xp.y = pk2(sx[kb][8 * s2 + 2], sx[kb][8 * s2 + 3]);
              xp.z = pk2(sx[kb][8 * s2 + 4], sx[kb][8 * s2 + 5]); xp.w = pk2(sx[kb][8 * s2 + 6], sx[kb][8 * s2 + 7]);
              const bf16x8 xs = __builtin_bit_cast(bf16x8, xp);
#pragma unroll
              for (int db = 0; db < 4; ++db) {
                const bf16x8 pa = *(const bf16x8*)(sV + (32 * db + r) * 128 + (((4 * kb + 2 * s2 + hh) ^ rsw) * 16));
                o[db] = __builtin_amdgcn_mfma_f32_32x32x16_bf16(pa, xs, o[db], 0, 0, 0);
              }
            }
        }
#undef ATT_ISSUE
        bf16_t* Od = OA + (size_t)mp * M * 768 + (size_t)(rq0 + 32 * w + r) * 768 + h * 128;
        const float inv = 1.f / lrun;
#pragma unroll
        for (int db = 0; db < 4; ++db)
#pragma unroll
          for (int g = 0; g < 4; ++g) {
            uint2 ov; ov.x = pk2(o[db][4 * g] * inv, o[db][4 * g + 1] * inv); ov.y = pk2(o[db][4 * g + 2] * inv, o[db][4 * g + 3] * inv);
            *(uint2*)(Od + 32 * db + 8 * g + 4 * hh) = ov;
          }
      }
    } break;
    case 14: {
      const bf16_t* OA = (const bf16_t*)(AR + A1_OA); const bf16_t* GL = (const bf16_t*)(AR + A1_GLU);
      const float lam_init = 0.8f - 0.6f * 0.7408182206817179f;
      {
        float l1 = p.lam_p[lane] * p.lam_p[64 + lane], l2 = p.lam_p[128 + lane] * p.lam_p[192 + lane];
        l1 = wsum(l1); l2 = wsum(l2);
        const float lam = __expf(l1) - __expf(l2) + lam_init;
        const int gw = blockIdx.x * 4 + w, ngw = gridDim.x * 4;
        const int l16 = lane & 15, g4 = lane >> 4;
        const f32x4 gs0 = *(const f32x4*)(p.g_sub + 8 * l16), gs1 = *(const f32x4*)(p.g_sub + 8 * l16 + 4);
        for (int it = gw; it < NB * SEQ * 6 / 4; it += ngw) {
          const int item = it * 4 + g4, rl = item / 6, h = item - rl * 6;
          const int b = rl / SEQ, tpos = rl % SEQ, row = b * S_ + CTX + tpos;
          const uint4 u0 = *(const uint4*)(OA + (size_t)row * 768 + h * 128 + 8 * l16);
          const uint4 u1 = *(const uint4*)(OA + (size_t)M * 768 + (size_t)row * 768 + h * 128 + 8 * l16);
          float o[8];
          o[0] = bflo(u0.x) - lam * bflo(u1.x); o[1] = bfhi(u0.x) - lam * bfhi(u1.x); o[2] = bflo(u0.y) - lam * bflo(u1.y); o[3] = bfhi(u0.y) - lam * bfhi(u1.y);
          o[4] = bflo(u0.z) - lam * bflo(u1.z); o[5] = bfhi(u0.z) - lam * bfhi(u1.z); o[6] = bflo(u0.w) - lam * bflo(u1.w); o[7] = bfhi(u0.w) - lam * bfhi(u1.w);
          float ss = 0.f;
#pragma unroll
          for (int e = 0; e < 8; ++e) ss += o[e] * o[e];
          ss += __shfl_xor(ss, 1); ss += __shfl_xor(ss, 2); ss += __shfl_xor(ss, 4); ss += __shfl_xor(ss, 8);
          const float rstd = rsqrtf(ss * (1.f / 128.f) + EPS) * (1.f - lam_init);
          uint4 ov;
          ov.x = pk2(o[0] * rstd * gs0[0], o[1] * rstd * gs0[1]); ov.y = pk2(o[2] * rstd * gs0[2], o[3] * rstd * gs0[3]);
          ov.z = pk2(o[4] * rstd * gs1[0], o[5] * rstd * gs1[1]); ov.w = pk2(o[6] * rstd * gs1[2], o[7] * rstd * gs1[3]);
          *(uint4*)(Hb + (size_t)row * LDH + h * 128 + 8 * l16) = ov;
        }
      }
      {
        float* su = (float*)smem;
        for (int t = blockIdx.x; t < NB * SEQ / 32; t += gridDim.x) {
          const int b = t / (SEQ / 32), t0 = (t % (SEQ / 32)) * 32;
          __syncthreads();
          for (int i = tid; i < 62 * 64; i += 256) {
            const int rr = i >> 6, c4 = (i & 63) * 4, tp = t0 + rr - 15;
            f32x4 u = {0.f, 0.f, 0.f, 0.f};
            if (tp >= 0 && tp < SEQ) {
              const size_t ro = (size_t)(b * S_ + CTX + tp) * 512;
              const uint2 av = *(const uint2*)(GL + ro + c4), gv = *(const uint2*)(GL + ro + 256 + c4);
              u[0] = bflo(av.x) * sigmoidf_(bflo(gv.x)); u[1] = bfhi(av.x) * sigmoidf_(bfhi(gv.x));
              u[2] = bflo(av.y) * sigmoidf_(bflo(gv.y)); u[3] = bfhi(av.y) * sigmoidf_(bfhi(gv.y));
            }
            *(f32x4*)(su + rr * 256 + c4) = u;
          }
          __syncthreads();
          float z[32];
#pragma unroll
          for (int tt = 0; tt < 32; ++tt) z[tt] = 0.f;
          for (int j = 0; j < 31; ++j) {
            const float wj = p.w_dw[j * 256 + tid];
#pragma unroll
            for (int tt = 0; tt < 32; ++tt) z[tt] += wj * su[(tt + j) * 256 + tid];
          }
          __syncthreads();
#pragma unroll
          for (int tt = 0; tt < 32; ++tt) su[tt * 256 + tid] = z[tt];
          __syncthreads();
          for (int tt = w; tt < 32; tt += 4) {
            f32x4 v = *(const f32x4*)(su + tt * 256 + 4 * lane);
            const float mu = wsum(v[0] + v[1] + v[2] + v[3]) * (1.f / 256.f);
            v -= mu;
            const float rstd = rsqrtf(wsum(v[0] * v[0] + v[1] * v[1] + v[2] * v[2] + v[3] * v[3]) * (1.f / 256.f) + EPS);
            const f32x4 gl = *(const f32x4*)(p.g_cln + 4 * lane), bl = *(const f32x4*)(p.b_cln + 4 * lane);
            float y[4];
#pragma unroll
            for (int e = 0; e < 4; ++e) y[e] = siluf_(v[e] * rstd * gl[e] + bl[e]);
            uint2 o; o.x = pk2(y[0], y[1]); o.y = pk2(y[2], y[3]);
            *(uint2*)(Hb + (size_t)(b * S_ + CTX + t0 + tt) * LDH + 768 + 4 * lane) = o;
          }
        }
      }
    } break;
    case 16: norm_phase(p, 1, 1, false, true); break;
    case 19: {
      const int gw = blockIdx.x * 4 + w, ngw = gridDim.x * 4;
      for (int r = gw; r < NB * SEQ; r += ngw) {
        f32x4* xr = (f32x4*)(p.out + (size_t)r * D) + lane;
        f32x4 v[4]; float ss = 0.f;
#pragma unroll
        for (int j = 0; j < 4; ++j) { v[j] = xr[64 * j]; ss += v[j][0] * v[j][0] + v[j][1] * v[j][1] + v[j][2] * v[j][2] + v[j][3] * v[j][3]; }
        const float rstd = rsqrtf(wsum(ss) * (1.f / D) + EPS);
#pragma unroll
        for (int j = 0; j < 4; ++j) { const f32x4 gg = *(const f32x4*)(p.g_final + 4 * lane + 256 * j); xr[64 * j] = v[j] * rstd * gg; }
      }
    } break;
    default: break;
    }
}

__global__ void __launch_bounds__(256, LB2) mega(Params p) {
  extern __shared__ __attribute__((aligned(16))) unsigned char smem[];
  {
    volatile LAS unsigned* st = (volatile LAS unsigned*)(smem + LDS_BYTES - 16);
    if (threadIdx.x == 0) { st[0] = 0u; st[1] = 0u; }
    __syncthreads();
  }
  if (p.ph_hi == 7777) cg::this_grid().sync();
  const XcdBarrier xb = xcd_barrier_post((unsigned*)(p.ws + OFF_BAR), (volatile LAS unsigned*)(smem + LDS_BYTES - 16));
#ifndef REP_PH
#define REP_PH -1
#endif
#define RUN(k) if (p.ph_lo <= k && k < p.ph_hi) { if (k > p.ph_lo) { xcd_barrier(xb); } run_phase<k>(p, smem); \
    if (k == REP_PH) { xcd_barrier(xb); run_phase<k>(p, smem); } }
  RUN(0) RUN(1) RUN(2) RUN(3) RUN(4) RUN(5) RUN(6) RUN(7) RUN(8) RUN(9) RUN(10) RUN(11) RUN(12) RUN(13) RUN(14) RUN(15) RUN(16) RUN(17) RUN(18) RUN(19)
#undef RUN
  if (p.ph_lo == 20) {
    const bf16_t* src = (const bf16_t*)(p.ws + DUMP_OFF);
    for (size_t i = (size_t)blockIdx.x * 256 + threadIdx.x; i < (size_t)NB * SEQ * D; i += (size_t)gridDim.x * 256) p.out[i] = bf2f(src[i]) + bf2f(((const bf16_t*)(p.ws + OFF_H))[i]);
  }
}

extern "C" void kernel_launch(void* const* d_in, const int* in_sizes, int n_in, void* d_out, int out_size, void* d_ws, size_t ws_size, hipStream_t stream) {
  static int grid_blocks = 0;
  if (!grid_blocks) {
    if (ws_size < WS_NEED) { fprintf(stderr, "kernel_launch: workspace too small: %zu < %zu\n", ws_size, (size_t)WS_NEED); grid_blocks = -1; return; }
    int dev = 0, cus = 0, per_cu = 0;
    hipGetDevice(&dev);
    hipDeviceGetAttribute(&cus, hipDeviceAttributeMultiprocessorCount, dev);
    hipFuncSetAttribute((const void*)mega, hipFuncAttributeMaxDynamicSharedMemorySize, LDS_BYTES);
    hipOccupancyMaxActiveBlocksPerMultiprocessor(&per_cu, (const void*)mega, 256, LDS_BYTES);
    if (per_cu < 1) per_cu = 1;
    if (per_cu > 2) per_cu = 2;
    grid_blocks = cus * per_cu;
    fprintf(stderr, "kernel_launch: cus %d per_cu %d grid %d ws %zu\n", cus, per_cu, grid_blocks, ws_size);
  }
  if (grid_blocks < 0) return;
  Params p{};
  const float** pp = (const float**)&p;
  for (int i = 0; i < 22; ++i) pp[i] = (const float*)d_in[i];
  p.out = (float*)d_out; p.ws = (unsigned char*)d_ws;
#if MULTI_LAUNCH
  for (int ph = 0; ph < NPH_RUN; ++ph) {
    p.ph_lo = ph; p.ph_hi = ph + 1;
    hipLaunchKernelGGL(mega, dim3(grid_blocks), dim3(256), LDS_BYTES, stream, p);
  }
#if NPH_RUN < 20
  p.ph_lo = 20; p.ph_hi = 21;
  hipLaunchKernelGGL(mega, dim3(grid_blocks), dim3(256), LDS_BYTES, stream, p);
#endif
#else
  hipMemsetAsync((unsigned char*)d_ws + OFF_BAR, 0, XCD_BAR_WORDS * 4, stream);
  p.ph_lo = 0; p.ph_hi = NPH;
  void* args[] = {&p};
  hipError_t e = hipLaunchCooperativeKernel((void*)mega, dim3(grid_blocks), dim3(256), args, LDS_BYTES, stream);
  if (e != hipSuccess) fprintf(stderr, "cooperative launch failed: %s (grid %d)\n", hipGetErrorString(e), grid_blocks);
#endif
}
```

```cpp
#include <hip/hip_runtime.h>
#include <hip/hip_cooperative_groups.h>
#include <cstdio>
#include <cstdint>
namespace cg = cooperative_groups;

#ifndef LB2
#define LB2 2
#endif
#ifndef NPH_RUN
#define NPH_RUN 20
#endif
#ifndef DUMP_OFF
#define DUMP_OFF (OFF_AR + A0_QK)
#endif
#ifndef MULTI_LAUNCH
#define MULTI_LAUNCH 0
#endif

typedef unsigned short bf16_t;
typedef short bf16x8 __attribute__((ext_vector_type(8)));
typedef float f32x4 __attribute__((ext_vector_type(4)));
typedef float f32x16 __attribute__((ext_vector_type(16)));
#define DEV __device__ __forceinline__

constexpr int D = 1024, NB = 2, SEQ = 8192, CTX = 256, S_ = SEQ + CTX, M = NB * S_, DFF = 4096;
constexpr int LDH = D + 64, LDHID = DFF + 64;
constexpr int NCH = S_ / 128;
constexpr int NPH = 20;
constexpr float EPS = 1e-6f;

constexpr size_t OFF_MOD = 0;
constexpr size_t MOD_BYTES = 2 * 3 * 6144 * 4;
constexpr size_t OFF_ROPE = 0x40000;
constexpr size_t OFF_XC = 0x240000;
constexpr size_t OFF_G = 0x440000;
constexpr size_t OFF_CS = 0x5D0000;
constexpr size_t OFF_MS = 0x5D8000;
constexpr size_t OFF_NV = 0x5DA000;
constexpr size_t OFF_WT = 0x700000;
constexpr size_t WT_IN = 0, WT_OUT = 0x770000, WT_FF1 = 0x990000, WT_FF2 = 0x1210000;
constexpr size_t OFF_H = 0x2200000;
constexpr size_t OFF_AR = 0x4510000;
constexpr size_t A0_QK = 0, A0_ST = 0, A0_VT = 0x3180000, A0_O = 0x4A40000, A0_QC = 0x6300000, A0_KC = 0x7BC0000;
constexpr size_t DO_KCT = 0, DO_ZT = 0x18C0000, DO_F = 0x2940000;
constexpr size_t A1_Q = 0, A1_K = 0x18C0000, A1_VT = 0x3180000, A1_GLU = 0x4A40000, A1_OA = 0x5AC0000;
constexpr size_t OFF_WT2 = OFF_AR + 0x9480000;
constexpr size_t WS_NEED = OFF_WT2 + 0x1A30000;

struct Params {
  const float *x, *c, *ctx, *c_ctx, *w_mod, *b_mod, *g_norm, *w_in_even, *b_gate, *w_qk_conv, *g_head, *w_out_even,
      *w_in_odd, *lam_p, *g_sub, *w_dw, *g_cln, *b_cln, *w_out_odd, *w_ff1, *w_ff2, *g_final;
  float* out;
  unsigned char* ws;
  int ph_lo, ph_hi;
};

typedef float f32x2 __attribute__((ext_vector_type(2)));
typedef __bf16 bf16x2_t __attribute__((ext_vector_type(2)));
DEV unsigned pk2(float lo, float hi) { f32x2 v = {lo, hi}; bf16x2_t b = __builtin_convertvector(v, bf16x2_t); return __builtin_bit_cast(unsigned, b); }
DEV bf16_t f2bf(float f) { return (bf16_t)(pk2(f, 0.f) & 0xffff); }
DEV float bf2f(unsigned h) { return __uint_as_float(h << 16); }
DEV float bflo(unsigned u) { return __uint_as_float(u << 16); }
DEV float bfhi(unsigned u) { return __uint_as_float(u & 0xffff0000u); }
DEV float wsum(float v) { for (int o = 32; o; o >>= 1) v += __shfl_xor(v, o); return v; }
DEV float xor32_max(float v) { auto r = __builtin_amdgcn_permlane32_swap(__float_as_uint(v), __float_as_uint(v), false, false); return fmaxf(__uint_as_float(r[0]), __uint_as_float(r[1])); }
DEV float xor32_sum(float v) { auto r = __builtin_amdgcn_permlane32_swap(__float_as_uint(v), __float_as_uint(v), false, false); return __uint_as_float(r[0]) + __uint_as_float(r[1]); }
DEV float sigmoidf_(float x) { return 1.f / (1.f + __expf(-x)); }
DEV float siluf_(float x) { return x / (1.f + __expf(-x)); }
DEV float logsigf_(float x) { return fminf(x, 0.f) - log1pf(__expf(-fabsf(x))); }

constexpr int LDT = 72;
constexpr int LDP = 136;
constexpr int LDS_A = 0, LDS_B = 18432, LDS_P = 36864, LDS_F = 71680, LDS_BYTES = 79872;

template <bool A_LDS, class LA, class LB>
DEV void block_gemm(f32x4 (&acc)[2][8], int nk, LA la, LB lb, unsigned char* smem, const bf16_t* pA, int ldp) {
  bf16_t* sA = (bf16_t*)(smem + LDS_A);
  bf16_t* sB = (bf16_t*)(smem + LDS_B);
  const int tid = threadIdx.x, lane = tid & 63, w = tid >> 6;
  const int srow = tid >> 3, scol = (tid & 7) * 8;
  const int fr = lane & 15, fq = lane >> 4;
  uint4 ra[4], rb[4];
#pragma unroll
  for (int i = 0; i < 4; ++i) { if (!A_LDS) ra[i] = la(srow + 32 * i, scol); rb[i] = lb(srow + 32 * i, scol); }
  for (int kt = 0; kt < nk; ++kt) {
    __syncthreads();
#pragma unroll
    for (int i = 0; i < 4; ++i) {
      if (!A_LDS) *(uint4*)&sA[(srow + 32 * i) * LDT + scol] = ra[i];
      *(uint4*)&sB[(srow + 32 * i) * LDT + scol] = rb[i];
    }
    __syncthreads();
    if (kt + 1 < nk) {
#pragma unroll
      for (int i = 0; i < 4; ++i) { if (!A_LDS) ra[i] = la(srow + 32 * i, (kt + 1) * 64 + scol); rb[i] = lb(srow + 32 * i, (kt + 1) * 64 + scol); }
    }
#pragma unroll
    for (int kk = 0; kk < 2; ++kk) {
      bf16x8 af[2], bfr[8];
#pragma unroll
      for (int mi = 0; mi < 2; ++mi) {
        if (A_LDS) af[mi] = *(const bf16x8*)&pA[(32 * w + 16 * mi + fr) * ldp + kt * 64 + kk * 32 + 8 * fq];
        else af[mi] = *(const bf16x8*)&sA[(32 * w + 16 * mi + fr) * LDT + kk * 32 + 8 * fq];
      }
#pragma unroll
      for (int ni = 0; ni < 8; ++ni) bfr[ni] = *(const bf16x8*)&sB[(16 * ni + fr) * LDT + kk * 32 + 8 * fq];
#pragma unroll
      for (int mi = 0; mi < 2; ++mi)
#pragma unroll
        for (int ni = 0; ni < 8; ++ni) acc[mi][ni] = __builtin_amdgcn_mfma_f32_16x16x32_bf16(bfr[ni], af[mi], acc[mi][ni], 0, 0, 0);
    }
  }
}

DEV void zero_acc(f32x4 (&acc)[2][8]) {
#pragma unroll
  for (int mi = 0; mi < 2; ++mi)
#pragma unroll
    for (int ni = 0; ni < 8; ++ni) acc[mi][ni] = (f32x4){0.f, 0.f, 0.f, 0.f};
}

#define LASG __attribute__((address_space(3)))
DEV void block_gemm_glds(f32x4 (&acc)[2][8], int nk, const bf16_t* Ag, size_t lda, const bf16_t* Bg, size_t ldb, unsigned char* smem) {
  const int tid = threadIdx.x, lane = tid & 63, w = tid >> 6;
  const int srow = tid >> 3, sc = ((tid & 7) ^ (srow & 7)) * 8;
  const int fr = lane & 15, fq = lane >> 4;
  const bf16_t* ag = Ag + (size_t)srow * lda + sc;
  const bf16_t* bg = Bg + (size_t)srow * ldb + sc;
  LASG unsigned char* lbase = (LASG unsigned char*)smem;
#define GLDS_ISSUE(st_, k0_) do { \
    _Pragma("unroll") for (int i = 0; i < 4; ++i) { \
      __builtin_amdgcn_global_load_lds((const unsigned*)(ag + (size_t)(32 * i) * lda + (k0_)), (LASG unsigned*)(lbase + (st_) * 32768 + (tid + 256 * i) * 16), 16, 0, 0); \
      __builtin_amdgcn_global_load_lds((const unsigned*)(bg + (size_t)(32 * i) * ldb + (k0_)), (LASG unsigned*)(lbase + (st_) * 32768 + 16384 + (tid + 256 * i) * 16), 16, 0, 0); } } while (0)
  __syncthreads();
  GLDS_ISSUE(0, 0);
  for (int kt = 0; kt < nk; ++kt) {
    __syncthreads();
    if (kt + 1 < nk) GLDS_ISSUE((kt + 1) & 1, (kt + 1) * 64);
    const unsigned char* sA = smem + (kt & 1) * 32768;
    const unsigned char* sB = sA + 16384;
#pragma unroll
    for (int kk = 0; kk < 2; ++kk) {
      const int swz = ((kk * 4 + fq) ^ (fr & 7)) * 16;
      bf16x8 af[2], bfr[8];
#pragma unroll
      for (int mi = 0; mi < 2; ++mi) af[mi] = *(const bf16x8*)(sA + (32 * w + 16 * mi + fr) * 128 + swz);
#pragma unroll
      for (int ni = 0; ni < 8; ++ni) bfr[ni] = *(const bf16x8*)(sB + (16 * ni + fr) * 128 + swz);
#pragma unroll
      for (int mi = 0; mi < 2; ++mi)
#pragma unroll
        for (int ni = 0; ni < 8; ++ni) acc[mi][ni] = __builtin_amdgcn_mfma_f32_16x16x32_bf16(bfr[ni], af[mi], acc[mi][ni], 0, 0, 0);
    }
  }
#undef GLDS_ISSUE
}

DEV void block_gemm_glds2(f32x4 (&acc0)[2][8], f32x4 (&acc1)[2][8], int nk, const bf16_t* Ag, size_t lda, const bf16_t* Bg, size_t ldb, unsigned char* smem) {
  const int tid = threadIdx.x, lane = tid & 63, w = tid >> 6;
  const int fr = lane & 15, fq = lane >> 4;
  const int lr = lane >> 2, lp = lane & 3;
  const int sc = (lp ^ ((0x78 >> (2 * ((lr >> 2) & 3))) & 3)) * 8;
  const bf16_t* ag = Ag + (size_t)(32 * w + lr) * lda + sc;
  const bf16_t* bg = Bg + (size_t)(64 * w + lr) * ldb + sc;
  LASG unsigned char* lbase = (LASG unsigned char*)smem;
#define G2_ISSUE(st_, k0_) do { \
    _Pragma("unroll") for (int i = 0; i < 2; ++i) \
      __builtin_amdgcn_global_load_lds((const unsigned*)(ag + (size_t)(16 * i) * lda + (k0_)), (LASG unsigned*)(lbase + (st_) * 24576 + (32 * w + 16 * i) * 64 + lane * 16), 16, 0, 0); \
    _Pragma("unroll") for (int i = 0; i < 4; ++i) \
      __builtin_amdgcn_global_load_lds((const unsigned*)(bg + (size_t)(16 * i) * ldb + (k0_)), (LASG unsigned*)(lbase + (st_) * 24576 + 8192 + (64 * w + 16 * i) * 64 + lane * 16), 16, 0, 0); } while (0)
  __syncthreads();
  G2_ISSUE(0, 0);
  if (nk > 1) G2_ISSUE(1, 32);
  const int roff = (fq ^ ((0x78 >> (2 * ((fr >> 2) & 3))) & 3)) * 16 + fr * 64;
  int st = 0;
  for (int kt = 0; kt < nk; ++kt) {
    if (kt + 1 < nk) asm volatile("s_waitcnt vmcnt(6)" ::: "memory"); else asm volatile("s_waitcnt vmcnt(0)" ::: "memory");
    __builtin_amdgcn_s_barrier();
    asm volatile("" ::: "memory");
    if (kt + 2 < nk) { const int st2 = st >= 1 ? st - 1 : 2; G2_ISSUE(st2, (kt + 2) * 32); }
    const unsigned char* sA = smem + st * 24576;
    const unsigned char* sB = sA + 8192;
    bf16x8 af[2];
#pragma unroll
    for (int mi = 0; mi < 2; ++mi) af[mi] = *(const bf16x8*)(sA + (32 * w + 16 * mi) * 64 + roff);
    {
      bf16x8 bfr[8];
#pragma unroll
      for (int ni = 0; ni < 8; ++ni) bfr[ni] = *(const bf16x8*)(sB + (16 * ni) * 64 + roff);
#pragma unroll
      for (int mi = 0; mi < 2; ++mi)
#pragma unroll
        for (int ni = 0; ni < 8; ++ni) acc0[mi][ni] = __builtin_amdgcn_mfma_f32_16x16x32_bf16(bfr[ni], af[mi], acc0[mi][ni], 0, 0, 0);
    }
    {
      bf16x8 bfr[8];
#pragma unroll
      for (int ni = 0; ni < 8; ++ni) bfr[ni] = *(const bf16x8*)(sB + (128 + 16 * ni) * 64 + roff);
#pragma unroll
      for (int mi = 0; mi < 2; ++mi)
#pragma unroll
        for (int ni = 0; ni < 8; ++ni) acc1[mi][ni] = __builtin_amdgcn_mfma_f32_16x16x32_bf16(bfr[ni], af[mi], acc1[mi][ni], 0, 0, 0);
    }
    st = st == 2 ? 0 : st + 1;
  }
#undef G2_ISSUE
}

constexpr size_t OFF_BAR = 0x28000;
#define XB_TMO      128
#define XB_XCNT(j)  (256  + 64 * (j))
#define XB_XSUB(j)  (1280 + 64 * (j))
#define XB_XGEN(j)  (2304 + 64 * (j))
#define XB_TOP      3328
#define XB_TOPGEN   3392
#define XCD_BAR_WORDS 3456
#define XB_SPIN_CAP (1u << 18)
#define LAS __attribute__((address_space(3)))

__device__ __forceinline__ unsigned xb_ld(unsigned* p)              { return __hip_atomic_load(p, __ATOMIC_RELAXED, __HIP_MEMORY_SCOPE_AGENT); }
__device__ __forceinline__ unsigned xb_add(unsigned* p, unsigned v) { return __hip_atomic_fetch_add(p, v, __ATOMIC_RELAXED, __HIP_MEMORY_SCOPE_AGENT); }
__device__ __forceinline__ unsigned xb_xcc_id() { return (unsigned)__builtin_amdgcn_s_getreg((3 << 11) | 20) & 0xFu; }
#define XB_SPIN(cond, bar) do { unsigned _sp = 0; while (cond) { __builtin_amdgcn_s_sleep(1); \
    if ((++_sp & 255u) == 0u) { if (xb_ld(&(bar)[XB_TMO])) break; if (_sp > XB_SPIN_CAP) { atomicAdd(&(bar)[XB_TMO], 1u); break; } } } } while (0)

struct XcdBarrier {
    unsigned* bar; unsigned x;
    volatile LAS unsigned* st;
};

__device__ __forceinline__ XcdBarrier xcd_barrier_post(unsigned* bar, volatile LAS unsigned* st) {
    XcdBarrier b; b.bar = bar; b.x = xb_xcc_id(); b.st = st;
    if (threadIdx.x == 0) (void)xb_add(&bar[XB_XCNT(b.x)], 1u);
    return b;
}
__device__ __forceinline__ void xcd_barrier_complete(unsigned* bar, unsigned x, unsigned& nloc, unsigned& nx) {
    const unsigned G = gridDim.x * gridDim.y * gridDim.z;
    unsigned sum, cnt, mine, sp = 0u;
    for (;;) {
        sum = 0u; cnt = 0u; mine = 0u;
#pragma unroll
        for (unsigned j = 0; j < 16; ++j) { const unsigned c = xb_ld(&bar[XB_XCNT(j)]); sum += c; cnt += (c > 0u) ? 1u : 0u; mine = (j == x) ? c : mine; }
        if (sum == G) break;
        __builtin_amdgcn_s_sleep(1);
        if ((++sp & 255u) == 0u) { if (xb_ld(&bar[XB_TMO])) break; if (sp > XB_SPIN_CAP) { atomicAdd(&bar[XB_TMO], 1u); break; } }
    }
    nloc = mine > 0u ? mine : 1u; nx = cnt > 0u ? cnt : 1u;
}

__device__ __forceinline__ void xcd_barrier(const XcdBarrier& b) {
    asm volatile("s_waitcnt vmcnt(0)" ::: "memory");
    __syncthreads();
    if (threadIdx.x == 0) {
        unsigned* bar = b.bar;
        __builtin_amdgcn_s_waitcnt(0);
        unsigned nloc = b.st[0], nx = b.st[1];
        if (nloc == 0u) { xcd_barrier_complete(bar, b.x, nloc, nx); b.st[0] = nloc; b.st[1] = nx; }
        const unsigned old = xb_add(&bar[XB_XSUB(b.x)], 1u);
        const unsigned gen = old / nloc;
        if (old + 1u == (gen + 1u) * nloc) {
            __builtin_amdgcn_fence(__ATOMIC_RELEASE, "agent");
            asm volatile("s_waitcnt vmcnt(0)" ::: "memory");
            const unsigned og = xb_add(&bar[XB_TOP], 1u);
            const unsigned tg = og / nx;
            if (og + 1u == (tg + 1u) * nx) xb_add(&bar[XB_TOPGEN], 1u);
            else XB_SPIN(xb_ld(&bar[XB_TOPGEN]) == tg, bar);
            __builtin_amdgcn_fence(__ATOMIC_ACQUIRE, "agent");
            xb_add(&bar[XB_XGEN(b.x)], 1u);
            asm volatile("s_waitcnt vmcnt(0)" ::: "memory");
        } else {
            XB_SPIN(xb_ld(&bar[XB_XGEN(b.x)]) == gen, bar);
            __builtin_amdgcn_fence(__ATOMIC_ACQUIRE, "agent");
            asm volatile("s_waitcnt vmcnt(0)" ::: "memory");
        }
    }
    __syncthreads();
}

DEV const float* xsrc_row(const Params& p, bool from_input, int r) {
  const int b = r / S_, s = r - b * S_;
  if (from_input) return s < CTX ? p.ctx + (size_t)(b * CTX + s) * D : p.x + (size_t)(b * SEQ + s - CTX) * D;
  return s < CTX ? (const float*)(p.ws + OFF_XC) + (size_t)(b * CTX + s) * D : p.out + (size_t)(b * SEQ + s - CTX) * D;
}
DEV float* xdst_row(const Params& p, int r) {
  const int b = r / S_, s = r - b * S_;
  return s < CTX ? (float*)(p.ws + OFF_XC) + (size_t)(b * CTX + s) * D : p.out + (size_t)(b * SEQ + s - CTX) * D;
}
DEV const float* mod_row(const Params& p, int layer, int r) {
  const int b = r / S_, s = r - b * S_;
  return (const float*)(p.ws + OFF_MOD) + (size_t)(layer * 3 + (s < CTX ? 2 : b)) * 6144;
}

DEV void transpose_tile(const float* W, int K, int N, bf16_t* WT, int remap, int kt, int nt, unsigned char* smem) {
  float* tile = (float*)smem;
  const int tid = threadIdx.x;
  __syncthreads();
#pragma unroll
  for (int i = 0; i < 4; ++i) {
    const int kk = (tid >> 4) + 16 * i, c4 = (tid & 15) * 4;
    const int n = nt * 64 + c4;
    int src = n;
    if (remap) src = n < 3072 ? n : (n < 3328 ? n + 24 : (n < 3352 ? n - 256 : -1));
    else if (n >= N) src = -1;
    f32x4 v = (f32x4){0.f, 0.f, 0.f, 0.f};
    if (src >= 0) v = *(const f32x4*)(W + (size_t)(kt * 64 + kk) * N + src);
    tile[kk * 65 + c4 + 0] = v[0]; tile[kk * 65 + c4 + 1] = v[1]; tile[kk * 65 + c4 + 2] = v[2]; tile[kk * 65 + c4 + 3] = v[3];
  }
  __syncthreads();
  const int n = tid >> 2, kc = (tid & 3) * 16;
  uint4 o0, o1;
  const float* t = tile + kc * 65 + n;
  o0.x = pk2(t[0 * 65], t[1 * 65]); o0.y = pk2(t[2 * 65], t[3 * 65]); o0.z = pk2(t[4 * 65], t[5 * 65]); o0.w = pk2(t[6 * 65], t[7 * 65]);
  o1.x = pk2(t[8 * 65], t[9 * 65]); o1.y = pk2(t[10 * 65], t[11 * 65]); o1.z = pk2(t[12 * 65], t[13 * 65]); o1.w = pk2(t[14 * 65], t[15 * 65]);
  bf16_t* dst = WT + (size_t)(nt * 64 + n) * (K + 64) + kt * 64 + kc;
  *(uint4*)dst = o0; *(uint4*)(dst + 8) = o1;
}
DEV void transpose_mat(const float* Wm, int K, int N, int Npad, bf16_t* dst, int remap, unsigned char* smem, int b0, int nb) {
  const int nkt = K / 64, nnt = Npad / 64;
  if ((int)blockIdx.x < b0) return;
  for (int t = blockIdx.x - b0; t < nkt * nnt; t += nb) transpose_tile(Wm, K, N, dst, remap, t / nnt, t % nnt, smem);
}
DEV void convert_weights(const Params& p, int part, unsigned char* smem, int b0, int nb) {
  unsigned char* wt = p.ws + OFF_WT; unsigned char* wt2 = p.ws + OFF_WT2;
  if (part == 0) { transpose_mat(p.w_in_even, 1024, 3352, 3584, (bf16_t*)(wt + WT_IN), 1, smem, b0, nb); return; }
  transpose_mat(p.w_out_even, 1024, 1024, 1024, (bf16_t*)(wt + WT_OUT), 0, smem, b0, nb);
  transpose_mat(p.w_ff1, 1024, 4096, 4096, (bf16_t*)(wt + WT_FF1), 0, smem, b0, nb);
  transpose_mat(p.w_ff2, 4096, 1024, 1024, (bf16_t*)(wt + WT_FF2), 0, smem, b0, nb);
  transpose_mat(p.w_in_odd, 1024, 2816, 2816, (bf16_t*)(wt2 + WT_IN), 0, smem, b0, nb);
  transpose_mat(p.w_out_odd, 1024, 1024, 1024, (bf16_t*)(wt2 + WT_OUT), 0, smem, b0, nb);
  transpose_mat(p.w_ff1 + (size_t)1024 * 4096, 1024, 4096, 4096, (bf16_t*)(wt2 + WT_FF1), 0, smem, b0, nb);
  transpose_mat(p.w_ff2 + (size_t)1024 * 4096, 4096, 1024, 1024, (bf16_t*)(wt2 + WT_FF2), 0, smem, b0, nb);
}

DEV void mod_phase(const Params& p, unsigned char* smem) {
  float* MOD = (float*)(p.ws + OFF_MOD);
  float* sS = (float*)smem;
  float* red = sS + 3072;
  const int tid = threadIdx.x, cl = tid & 31, kg = tid >> 5;
  if ((int)blockIdx.x >= 2 * 192) return;
  __syncthreads();
  for (int i = tid; i < 3072; i += 256) { const int v = i >> 10, k = i & 1023; sS[i] = siluf_(v == 0 ? p.c[k] : (v == 1 ? p.c[1024 + k] : p.c_ctx[k])); }
  __syncthreads();
  for (int it = blockIdx.x; it < 2 * 192; it += gridDim.x) {
    const int l = it / 192, n = (it % 192) * 32 + cl;
    const float* W = p.w_mod + (size_t)l * 1024 * 6144 + n;
    float a0 = 0.f, a1 = 0.f, a2 = 0.f;
#pragma unroll 16
    for (int k = kg * 128; k < kg * 128 + 128; ++k) {
      const float wv = W[(size_t)k * 6144];
      a0 += sS[k] * wv; a1 += sS[1024 + k] * wv; a2 += sS[2048 + k] * wv;
    }
    __syncthreads();
    red[(kg * 32 + cl) * 3 + 0] = a0; red[(kg * 32 + cl) * 3 + 1] = a1; red[(kg * 32 + cl) * 3 + 2] = a2;
    __syncthreads();
    if (kg == 0) {
      const float bv = p.b_mod[l * 6144 + n];
#pragma unroll
      for (int v = 0; v < 3; ++v) {
        float sacc = 0.f;
#pragma unroll
        for (int g2 = 0; g2 < 8; ++g2) sacc += red[(g2 * 32 + cl) * 3 + v];
        MOD[(l * 3 + v) * 6144 + n] = sacc + bv;
      }
    }
  }
}
DEV void rope_phase(const Params& p) {
  float* ct = (float*)(p.ws + OFF_ROPE);
  float* st = ct + 8192 * 32;
  for (int i = blockIdx.x * 256 + threadIdx.x; i < 8192 * 32; i += gridDim.x * 256) {
    const int t = i >> 5, d = i & 31;
    const float pos = (d < 16) ? (float)(t >> 6) : (float)(t & 63);
    const float inv = powf(10000.f, -(float)(d & 15) / 16.f);
    const float ang = pos * inv;
    ct[i] = cosf(ang); st[i] = sinf(ang);
  }
}

constexpr size_t A_PART = 0x8700000;
DEV void norm_phase(const Params& p, int layer, int which, bool from_input, bool skip_ctx, int ctx_fix = 0) {
  const int lane = threadIdx.x & 63;
  const int gw = blockIdx.x * 4 + (threadIdx.x >> 6), ngw = gridDim.x * 4;
  const float* g = p.g_norm + (layer * 2 + which) * D;
  bf16_t* H = (bf16_t*)(p.ws + OFF_H);
  for (int r = gw; r < M; r += ngw) {
    const int s = r % S_;
    if (skip_ctx && s < CTX) continue;
    const bool fix = ctx_fix && s < CTX;
    const f32x4* xr = (const f32x4*)xsrc_row(p, fix ? (ctx_fix == 1) : from_input, r) + lane;
    const float* mv = mod_row(p, layer, r) + which * 3 * 1024;
    f32x4 v[4]; float ss = 0.f;
#pragma unroll
    for (int j = 0; j < 4; ++j) v[j] = xr[64 * j];
    if (fix) {
      const int rc = (r / S_) * CTX + s;
      const f32x4* pp = (const f32x4*)(p.ws + OFF_AR + A_PART) + (size_t)rc * 256 + lane;
      f32x4* xw = (f32x4*)xdst_row(p, r) + lane;
#pragma unroll
      for (int j = 0; j < 4; ++j) {
        v[j] += (pp[64 * j] + pp[(size_t)512 * 256 + 64 * j]) + (pp[(size_t)2 * 512 * 256 + 64 * j] + pp[(size_t)3 * 512 * 256 + 64 * j]);
        xw[64 * j] = v[j];
      }
    }
#pragma unroll
    for (int j = 0; j < 4; ++j) ss += v[j][0] * v[j][0] + v[j][1] * v[j][1] + v[j][2] * v[j][2] + v[j][3] * v[j][3];
    const float rstd = rsqrtf(wsum(ss) * (1.f / D) + EPS);
    uint2* o = (uint2*)(H + (size_t)r * LDH) + lane;
#pragma unroll
    for (int j = 0; j < 4; ++j) {
      const int c = 4 * lane + 256 * j;
      const f32x4 gg = *(const f32x4*)(g + c), sh = *(const f32x4*)(mv + c), sc = *(const f32x4*)(mv + 1024 + c);
      float y[4];
#pragma unroll
      for (int e = 0; e < 4; ++e) y[e] = v[j][e] * rstd * gg[e] * (1.f + sc[e]) + sh[e];
      uint2 w2; w2.x = pk2(y[0], y[1]); w2.y = pk2(y[2], y[3]);
      o[64 * j] = w2;
    }
  }
}

template <class Epi>
DEV void gemm_phase(const bf16_t* A, int lda, const bf16_t* Bt, int K, int MT, int NT, bool skip_ctx, Epi epi, unsigned char* smem) {
  const int ldb = K + 64;
  const int MTv = skip_ctx ? MT - 2 * NB : MT;
  const int nwg = MTv * NT;
  for (int t = blockIdx.x; t < nwg; t += gridDim.x) {
    int wgid = t;
    { const int q = nwg / 8, r8 = nwg % 8, xcd = wgid % 8, off = wgid / 8; wgid = (xcd < r8 ? xcd * (q + 1) : r8 * (q + 1) + (xcd - r8) * q) + off; }
    const int nig = 8 * NT, gid = wgid / nig, fm = gid * 8, gsz = (MTv - fm) < 8 ? (MTv - fm) : 8;
    int mt = fm + (wgid % nig) % gsz; const int nt = (wgid % nig) / gsz;
    if (skip_ctx) mt = (mt / (NCH - 2)) * NCH + 2 + (mt % (NCH - 2));
    f32x4 acc[2][8]; zero_acc(acc);
    const bf16_t* Ab = A + (size_t)mt * 128 * lda;
    const bf16_t* Bb = Bt + (size_t)nt * 128 * ldb;
    block_gemm_glds(acc, K / 64, Ab, (size_t)lda, Bb, (size_t)ldb, smem);
    epi(acc, mt, nt);
  }
}

template <class Epi>
DEV void gemm_phase2(const bf16_t* A, int lda, const bf16_t* Bt, int K, int MT, int NP, bool skip_ctx, Epi epi, unsigned char* smem) {
  const int ldb = K + 64;
  const int MTv = skip_ctx ? MT - 2 * NB : MT;
  for (int t = blockIdx.x; t < MTv * NP; t += gridDim.x) {
    int mt = t / NP; const int np = t % NP;
    if (skip_ctx) mt = (mt / (NCH - 2)) * NCH + 2 + (mt % (NCH - 2));
    f32x4 acc0[2][8], acc1[2][8]; zero_acc(acc0); zero_acc(acc1);
    block_gemm_glds2(acc0, acc1, K / 32, A + (size_t)mt * 128 * lda, (size_t)lda, Bt + (size_t)np * 256 * ldb, (size_t)ldb, smem);
    epi(acc0, mt, 2 * np);
    epi(acc1, mt, 2 * np + 1);
  }
}

#define EPI_COORDS const int lane = threadIdx.x & 63, w = threadIdx.x >> 6, fr = lane & 15, fq = lane >> 4; (void)w; (void)fr; (void)fq;

DEV void store_bf16_row(bf16_t* base, size_t ld, int row, int col, const f32x4& v) {
  uint2 o; o.x = pk2(v[0], v[1]); o.y = pk2(v[2], v[3]);
  *(uint2*)(base + (size_t)row * ld + col) = o;
}
DEV void store_bf16_T(bf16_t* base, int col, int s, const f32x4& v) {
#pragma unroll
  for (int j = 0; j < 4; ++j) base[(size_t)(col + j) * S_ + s] = f2bf(v[j]);
}

struct GateScan { float a0, a1, b0, b1, pm0, pm1, F, amax; int pos0, pos1; };
DEV GateScan gate_scan(const float* G, const int r0, const int dir, const int h, const int lane) {
  GateScan g;
  const int j0 = 2 * lane, j1 = j0 + 1;
  g.pos0 = dir ? 127 - j0 : j0; g.pos1 = dir ? 127 - j1 : j1;
  const float i0 = G[(size_t)(r0 + g.pos0) * 24 + (dir * 2) * 6 + h], f0 = G[(size_t)(r0 + g.pos0) * 24 + (dir * 2 + 1) * 6 + h];
  const float i1 = G[(size_t)(r0 + g.pos1) * 24 + (dir * 2) * 6 + h], f1 = G[(size_t)(r0 + g.pos1) * 24 + (dir * 2 + 1) * 6 + h];
  const float lf0 = logsigf_(f0), lf1 = logsigf_(f1);
  const float s0 = lf0, s1 = lf0 + lf1;
  float tot = s1;
#pragma unroll
  for (int d = 1; d < 64; d <<= 1) { const float y = __shfl_up(tot, d); if (lane >= d) tot += y; }
  const float excl = tot - s1;
  g.b0 = s0 + excl; g.b1 = s1 + excl;
  g.F = __shfl(tot, 63);
  g.a0 = i0 - g.b0; g.a1 = i1 - g.b1;
  const float q0 = g.a0, q1 = fmaxf(g.a0, g.a1);
  float t = q1;
#pragma unroll
  for (int d = 1; d < 64; d <<= 1) { const float y = __shfl_up(t, d); if (lane >= d) t = fmaxf(t, y); }
  float ex = __shfl_up(t, 1); if (lane == 0) ex = -INFINITY;
  g.pm0 = fmaxf(q0, ex); g.pm1 = fmaxf(q1, ex);
  g.amax = __shfl(t, 63);
  return g;
}
DEV int chunk_ord(int dir, int i) { return dir == 0 ? i : (i < 2 ? 1 - i : 67 - i); }

template <int ph>
DEV void run_phase(const Params& p, unsigned char* smem) {
  const int tid = threadIdx.x, lane = tid & 63, w = tid >> 6, fr = lane & 15, fq = lane >> 4;
  unsigned char* ws = p.ws;
  bf16_t* const WT = (bf16_t*)(ws + (ph >= 11 ? OFF_WT2 : OFF_WT));
  bf16_t* const Hb = (bf16_t*)(ws + OFF_H);
  float* const Gt = (float*)(ws + OFF_G);
  float* const CS = (float*)(ws + OFF_CS);
  float* const MS = (float*)(ws + OFF_MS);
  float* const NV = (float*)(ws + OFF_NV);
  unsigned char* const AR = ws + OFF_AR;
  unsigned char* const DO = (unsigned char*)p.out;
  float* const sF = (float*)(smem + LDS_F);
  bf16_t* const sP = (bf16_t*)(smem + LDS_P);

    switch (ph) {
    case 0: {
      convert_weights(p, 0, smem, 0, gridDim.x);
      mod_phase(p, smem);
      rope_phase(p);
    } break;
    case 1: norm_phase(p, 0, 0, true, false); break;
    case 2: {
      bf16_t* QK = (bf16_t*)(AR + A0_QK); bf16_t* Vt = (bf16_t*)(AR + A0_VT); bf16_t* Ob = (bf16_t*)(AR + A0_O); bf16_t* Fb = (bf16_t*)(DO + DO_F);
      const float* bg = p.b_gate;
      auto epi = [&](f32x4 (&acc)[2][8], int mt, int nt) {
        const int b = mt / NCH;
        const int row0 = mt * 128 + 32 * w + fr, col0 = nt * 128 + 4 * fq;
        if (nt < 12 || (nt >= 18 && nt < 26)) {
          bf16_t* tb; int ld;
          if (nt < 12) { tb = QK + (size_t)row0 * 1536 + col0; ld = 1536; }
          else if (nt < 24) { tb = Ob + (size_t)row0 * 768 + (col0 - 2304); ld = 768; }
          else { tb = Fb + (size_t)row0 * 256 + (col0 - 3072); ld = 256; }
#pragma unroll
          for (int mi = 0; mi < 2; ++mi)
#pragma unroll
            for (int ni = 0; ni < 8; ++ni) {
              uint2 o; o.x = pk2(acc[mi][ni][0], acc[mi][ni][1]); o.y = pk2(acc[mi][ni][2], acc[mi][ni][3]);
              *(uint2*)(tb + (size_t)(16 * mi) * ld + 16 * ni) = o;
            }
        } else if (nt < 18) {
          bf16_t* tb = Vt + (size_t)b * 768 * S_ + (size_t)(col0 - 1536) * S_ + (row0 - b * S_);
#pragma unroll
          for (int mi = 0; mi < 2; ++mi)
#pragma unroll
            for (int ni = 0; ni < 8; ++ni)
#pragma unroll
              for (int j = 0; j < 4; ++j) tb[(size_t)(16 * ni + j) * S_ + 16 * mi] = f2bf(acc[mi][ni][j]);
        } else if (nt == 26) {
#pragma unroll
          for (int mi = 0; mi < 2; ++mi)
#pragma unroll
            for (int ni = 0; ni < 2; ++ni) {
              const int gc = 16 * ni + 4 * fq;
              if (gc < 24) { f32x4 o = acc[mi][ni]; o += *(const f32x4*)(bg + gc); *(f32x4*)(Gt + (size_t)(row0 + 16 * mi) * 24 + gc) = o; }
            }
        }
      };
      gemm_phase(Hb, LDH, (const bf16_t*)((unsigned char*)WT + WT_IN), D, M / 128, 27, false, epi, smem);
    } break;
    case 3: {
      const bf16_t* QK = (const bf16_t*)(AR + A0_QK);
      bf16_t* Qc = (bf16_t*)(AR + A0_QC); bf16_t* Kc = (bf16_t*)(AR + A0_KC); bf16_t* KcT = (bf16_t*)(DO + DO_KCT);
      bf16_t* ZT = (bf16_t*)(DO + DO_ZT); const bf16_t* Fb = (const bf16_t*)(DO + DO_F);
      for (int t = blockIdx.x; t < (M / 128) * 4; t += gridDim.x) {
        const int mt = t >> 2, g = t & 3;
        f32x4 acc[2][8]; zero_acc(acc);
        block_gemm<false>(acc, 1,
            [&](int row, int k) { return *(const uint4*)(Fb + (size_t)(mt * 128 + row) * 256 + g * 64 + k); },
            [&](int row, int k) {
              const int cp = row & 63, im = row >> 6; float vv[8];
#pragma unroll
              for (int j = 0; j < 8; ++j) { const int mm = (cp * (k + j)) & 63; const float xx = (float)mm * (1.f / 64.f); vv[j] = im ? -__builtin_amdgcn_sinf(xx) : __builtin_amdgcn_cosf(xx); }
              uint4 o; o.x = pk2(vv[0], vv[1]); o.y = pk2(vv[2], vv[3]); o.z = pk2(vv[4], vv[5]); o.w = pk2(vv[6], vv[7]); return o;
            }, smem, nullptr, 0);
        const int b = mt / NCH;
#pragma unroll
        for (int mi = 0; mi < 2; ++mi)
#pragma unroll
          for (int ni = 0; ni < 8; ++ni) {
            const int row = mt * 128 + 32 * w + 16 * mi + fr, s = row - b * S_;
#pragma unroll
            for (int j = 0; j < 4; ++j) {
              const int n = 16 * ni + 4 * fq + j, cp = n & 63, im = n >> 6;
              ZT[(size_t)((b * 256 + g * 64 + cp) * 2 + im) * S_ + s] = f2bf(acc[mi][ni][j]);
            }
          }
      }
      bf16_t* tl = (bf16_t*)smem;
      for (int t = blockIdx.x; t < (M / 64) * 12; t += gridDim.x) {
        const int rt = t / 12, ct = t % 12;
        const int r0 = rt * 64, b = r0 / S_, s0 = r0 - b * S_;
        const int lo = (s0 < CTX) ? 0 : CTX, hi = (s0 < CTX) ? CTX - 1 : S_ - 1;
        __syncthreads();
#pragma unroll
        for (int i = 0; i < 4; ++i) {
          const int id = tid + 256 * i, rr = id >> 4, cc = (id & 15) * 8;
          const int s = s0 + rr, c = ct * 128 + cc;
          const size_t base = (size_t)(r0 + rr) * 1536 + c;
          uint4 z = {0u, 0u, 0u, 0u};
          const uint4 u1 = *(const uint4*)(QK + base);
          const uint4 u0 = (s - 1 >= lo) ? *(const uint4*)(QK + base - 1536) : z;
          const uint4 u2 = (s + 1 <= hi) ? *(const uint4*)(QK + base + 1536) : z;
          const unsigned a0[4] = {u0.x, u0.y, u0.z, u0.w}, a1[4] = {u1.x, u1.y, u1.z, u1.w}, a2[4] = {u2.x, u2.y, u2.z, u2.w};
          float o[8];
          {
            const f32x4 wa0 = *(const f32x4*)(p.w_qk_conv + c), wa1 = *(const f32x4*)(p.w_qk_conv + c + 4);
            const f32x4 wb0 = *(const f32x4*)(p.w_qk_conv + 1536 + c), wb1 = *(const f32x4*)(p.w_qk_conv + 1536 + c + 4);
            const f32x4 wc0 = *(const f32x4*)(p.w_qk_conv + 3072 + c), wc1 = *(const f32x4*)(p.w_qk_conv + 3072 + c + 4);
            const float wA[8] = {wa0[0], wa0[1], wa0[2], wa0[3], wa1[0], wa1[1], wa1[2], wa1[3]};
            const float wB[8] = {wb0[0], wb0[1], wb0[2], wb0[3], wb1[0], wb1[1], wb1[2], wb1[3]};
            const float wC[8] = {wc0[0], wc0[1], wc0[2], wc0[3], wc1[0], wc1[1], wc1[2], wc1[3]};
#pragma unroll
            for (int e = 0; e < 4; ++e) {
              o[2 * e] = siluf_(wA[2 * e] * bflo(a0[e]) + wB[2 * e] * bflo(a1[e]) + wC[2 * e] * bflo(a2[e]));
              o[2 * e + 1] = siluf_(wA[2 * e + 1] * bfhi(a0[e]) + wB[2 * e + 1] * bfhi(a1[e]) + wC[2 * e + 1] * bfhi(a2[e]));
            }
          }
          if (ct < 6) {
            const float sc = 0.08838834764831845f;
            uint4 q; q.x = pk2(o[0] * sc, o[1] * sc); q.y = pk2(o[2] * sc, o[3] * sc); q.z = pk2(o[4] * sc, o[5] * sc); q.w = pk2(o[6] * sc, o[7] * sc);
            *(uint4*)(Qc + (size_t)(r0 + rr) * 768 + c) = q;
          } else {
            uint4 q; q.x = pk2(o[0], o[1]); q.y = pk2(o[2], o[3]); q.z = pk2(o[4], o[5]); q.w = pk2(o[6], o[7]);
            *(uint4*)(Kc + (size_t)(r0 + rr) * 768 + c - 768) = q;
#pragma unroll
            for (int e = 0; e < 8; ++e) tl[(cc + e) * LDT + rr] = f2bf(o[e]);
          }
        }
        __syncthreads();
        if (ct >= 6) {
#pragma unroll
          for (int i = 0; i < 4; ++i) {
            const int id = tid + 256 * i, cc = id >> 3, sc8 = (id & 7) * 8;
            const uint4 v = *(const uint4*)&tl[cc * LDT + sc8];
            *(uint4*)(KcT + (size_t)(b * 768 + (ct - 6) * 128 + cc) * S_ + s0 + sc8) = v;
          }
        }
      }
    } break;
    case 4: {
      const bf16_t* ZT = (const bf16_t*)(DO + DO_ZT);
      const int NF = 512 + 8;
      bf16_t* ApT = (bf16_t*)(DO + DO_F);
      const bf16_t* Vt = (const bf16_t*)(AR + A0_VT); const bf16_t* KcT = (const bf16_t*)(DO + DO_KCT); const bf16_t* Kc = (const bf16_t*)(AR + A0_KC);
      bf16_t* ST = (bf16_t*)(AR + A0_ST);
      for (int t = blockIdx.x; t < NF + 24 * NCH; t += gridDim.x) {
        if (t < 512) {
          const int mt = t & 1, ct = t >> 1;
          f32x4 acc[2][8]; zero_acc(acc);
          block_gemm<false>(acc, 4,
              [&](int row, int k) {
                const int p1 = mt * 64 + (row >> 1), op = row & 1, part = k >> 7, t1 = k & 127; float vv[8];
#pragma unroll
                for (int j = 0; j < 8; ++j) {
                  const float xx = (float)((p1 * (t1 + j)) & 127) * (1.f / 128.f);
                  const float cv = __builtin_amdgcn_cosf(xx), sv = __builtin_amdgcn_sinf(xx);
                  vv[j] = op == 0 ? (part == 0 ? cv : sv) : (part == 0 ? -sv : cv);
                }
                uint4 o; o.x = pk2(vv[0], vv[1]); o.y = pk2(vv[2], vv[3]); o.z = pk2(vv[4], vv[5]); o.w = pk2(vv[6], vv[7]); return o;
              },
              [&](int row, int k) {
                const int n = 2 * ct + (row >> 6), t2 = row & 63, part = k >> 7, t1 = k & 127;
                const bf16_t* src = ZT + (size_t)(n * 2 + part) * S_ + CTX + 64 * t1 + t2;
                unsigned e[8];
#pragma unroll
                for (int j = 0; j < 8; ++j) e[j] = src[64 * j];
                uint4 o; o.x = e[0] | (e[1] << 16); o.y = e[2] | (e[3] << 16); o.z = e[4] | (e[5] << 16); o.w = e[6] | (e[7] << 16); return o;
              }, smem, nullptr, 0);
#pragma unroll
          for (int mi = 0; mi < 2; ++mi) {
            const int row = 32 * w + 16 * mi + fr, p1 = mt * 64 + (row >> 1), op = row & 1;
#pragma unroll
            for (int ni = 0; ni < 8; ++ni) {
              const int col = 16 * ni + 4 * fq, n = 2 * ct + (col >> 6), t2 = col & 63;
              f32x4 v = acc[mi][ni], o;
#pragma unroll
              for (int j = 0; j < 4; ++j) {
                const float other = __shfl_xor(v[j], 1);
                const float xx = (float)((p1 * (t2 + j)) & 8191) * (1.f / 8192.f);
                const float cv = __builtin_amdgcn_cosf(xx), sv = __builtin_amdgcn_sinf(xx);
                o[j] = op == 0 ? (v[j] * cv + other * sv) : (v[j] * cv - other * sv);
              }
              store_bf16_row(ApT, 128, p1 * 512 + n, op * 64 + t2, o);
            }
          }
        } else if (t < NF) {
          const int tt = t - 512, mt = tt >> 2, nt = tt & 3;
          const int T = 256, tmask = T - 1;
          const float invT = 1.f / (float)T;
          f32x4 acc[2][8]; zero_acc(acc);
          block_gemm<false>(acc, 2 * T / 64,
              [&](int row, int k) {
                const int pp = mt * 128 + row, part = k >= T, t0 = k & tmask; float vv[8];
#pragma unroll
                for (int j = 0; j < 8; ++j) { const int mm = (pp * (t0 + j)) & tmask; const float xx = (float)mm * invT; vv[j] = part ? __builtin_amdgcn_sinf(xx) : __builtin_amdgcn_cosf(xx); }
                uint4 o; o.x = pk2(vv[0], vv[1]); o.y = pk2(vv[2], vv[3]); o.z = pk2(vv[4], vv[5]); o.w = pk2(vv[6], vv[7]); return o;
              },
              [&](int row, int k) { const int part = k >= T, t0 = k & tmask; return *(const uint4*)(ZT + (size_t)((nt * 128 + row) * 2 + part) * S_ + t0); },
              smem, nullptr, 0);
#pragma unroll
          for (int mi = 0; mi < 2; ++mi)
#pragma unroll
            for (int ni = 0; ni < 8; ++ni) {
              const int pp = mt * 128 + 32 * w + 16 * mi + fr, n = nt * 128 + 16 * ni + 4 * fq, b = n >> 8;
              f32x4 v = acc[mi][ni]; v *= (1.f / 128.f);
              store_bf16_row(Hb, LDH, b * S_ + pp, 768 + (n & 255), v);
            }
        } else {
          const int ta = t - NF, sd = ta / NCH, n = ta % NCH;
          const int dir = sd / 12, b = (sd / 6) & 1, h = sd % 6;
          const int r0 = b * S_ + n * 128;
          float* sW = sF;
          __syncthreads();
          if (w == 0) {
            const GateScan g = gate_scan(Gt, r0, dir, h, lane);
            sW[g.pos0] = __expf(g.a0 - g.amax); sW[g.pos1] = __expf(g.a1 - g.amax);
            if (lane == 0) { CS[(sd * NCH + n) * 4 + 0] = g.amax; CS[(sd * NCH + n) * 4 + 1] = g.F; }
          }
          __syncthreads();
          f32x4 acc[2][8]; zero_acc(acc);
          const bf16_t* Ab = Vt + (size_t)(b * 768 + h * 128) * S_ + n * 128;
          const bf16_t* Bb = KcT + (size_t)(b * 768 + h * 128) * S_ + n * 128;
          block_gemm<false>(acc, 2,
              [&](int row, int k) { return *(const uint4*)(Ab + (size_t)row * S_ + k); },
              [&](int row, int k) {
                const uint4 u = *(const uint4*)(Bb + (size_t)row * S_ + k);
                uint4 o;
                o.x = pk2(bflo(u.x) * sW[k], bfhi(u.x) * sW[k + 1]); o.y = pk2(bflo(u.y) * sW[k + 2], bfhi(u.y) * sW[k + 3]);
                o.z = pk2(bflo(u.z) * sW[k + 4], bfhi(u.z) * sW[k + 5]); o.w = pk2(bflo(u.w) * sW[k + 6], bfhi(u.w) * sW[k + 7]);
                return o;
              }, smem, nullptr, 0);
          bf16_t* Sd = ST + (size_t)(sd * NCH + n) * 16384;
#pragma unroll
          for (int mi = 0; mi < 2; ++mi)
#pragma unroll
            for (int ni = 0; ni < 8; ++ni) store_bf16_row(Sd, 128, 32 * w + 16 * mi + fr, 16 * ni + 4 * fq, acc[mi][ni]);
          if (tid < 128) {
            int tix = tid; asm volatile("" : "+v"(tix));
            const uint4* krow = (const uint4*)(KcT + (size_t)(b * 768 + h * 128 + tix) * S_ + n * 128);
            float a = 0.f;
#pragma unroll
            for (int c = 0; c < 16; ++c) {
              const uint4 u = krow[c]; const float* ww = sW + 8 * c;
              a += bflo(u.x) * ww[0] + bfhi(u.x) * ww[1] + bflo(u.y) * ww[2] + bfhi(u.y) * ww[3] + bflo(u.z) * ww[4] + bfhi(u.z) * ww[5] + bflo(u.w) * ww[6] + bfhi(u.w) * ww[7];
            }
            NV[(size_t)(sd * NCH + n) * 128 + tix] = a;
          }
        }
      }
    } break;
    case 5: {
      {
        const bf16_t* ApT = (const bf16_t*)(DO + DO_F);
        for (int t = blockIdx.x; t < 512; t += gridDim.x) {
          const int p1 = t >> 2, n0 = (t & 3) * 128;
          f32x4 acc[2][8]; zero_acc(acc);
          block_gemm<false>(acc, 2,
              [&](int row, int k) { return *(const uint4*)(ApT + (size_t)(t * 128 + row) * 128 + k); },
              [&](int row, int k) {
                uint4 o = {0u, 0u, 0u, 0u};
                if (row < 64) {
                  const int part = k >> 6, t2 = k & 63; float vv[8];
#pragma unroll
                  for (int j = 0; j < 8; ++j) { const float xx = (float)((row * (t2 + j)) & 63) * (1.f / 64.f); vv[j] = part ? __builtin_amdgcn_sinf(xx) : __builtin_amdgcn_cosf(xx); }
                  o.x = pk2(vv[0], vv[1]); o.y = pk2(vv[2], vv[3]); o.z = pk2(vv[4], vv[5]); o.w = pk2(vv[6], vv[7]);
                }
                return o;
              }, smem, nullptr, 0);
#pragma unroll
          for (int mi = 0; mi < 2; ++mi) {
            const int n = n0 + 32 * w + 16 * mi + fr, b = n >> 8;
#pragma unroll
            for (int ni = 0; ni < 4; ++ni)
#pragma unroll
              for (int j = 0; j < 4; ++j) {
                const int p2 = 16 * ni + 4 * fq + j;
                Hb[(size_t)(b * S_ + CTX + p1 + 128 * p2) * LDH + 768 + (n & 255)] = f2bf(acc[mi][ni][j] * 0.0013810679320049757f);
              }
          }
        }
      }
      if (gridDim.x >= 400) convert_weights(p, 1, smem, 200, gridDim.x - 200); else convert_weights(p, 1, smem, 0, gridDim.x);
      bf16_t* ST = (bf16_t*)(AR + A0_ST);
      for (int e = blockIdx.x * 256 + tid; e < 24 * 2064; e += gridDim.x * 256) {
        const int sd = e / 2064, idx = e % 2064, dir = sd / 12;
        float cst[8];
#pragma unroll
        for (int j = 0; j < 8; ++j) cst[j] = 0.f;
        float m = 0.f;
        uint4 ring0[4], ring1[4]; float ra[4], rf[4];
#define SC_FETCH(i_, u_) do { const int n_ = chunk_ord(dir, (i_)); ra[u_] = CS[(sd * NCH + n_) * 4 + 0]; rf[u_] = CS[(sd * NCH + n_) * 4 + 1]; \
          if (idx < 2048) ring0[u_] = *(const uint4*)(ST + (size_t)(sd * NCH + n_) * 16384 + idx * 8); \
          else { const uint4* q_ = (const uint4*)(NV + (size_t)(sd * NCH + n_) * 128 + (idx - 2048) * 8); ring0[u_] = q_[0]; ring1[u_] = q_[1]; } } while (0)
#pragma unroll
        for (int u = 0; u < 4; ++u) { ring1[u] = uint4{0u, 0u, 0u, 0u}; SC_FETCH(u, u); }
        for (int i0 = 0; i0 < NCH; i0 += 4) {
#pragma unroll
          for (int u = 0; u < 4; ++u) {
            const int i = i0 + u;
            if (i < NCH) {
              const int n = chunk_ord(dir, i);
              const float amax = ra[u], F = rf[u];
              const uint4 c0 = ring0[u], c1 = ring1[u];
              if (i + 4 < NCH) SC_FETCH(i + 4, u);
              const float Mx = fmaxf(m, amax), dcy = __expf(m - Mx), scl = __expf(amax - Mx);
              if (idx < 2048) {
                uint4* ptr = (uint4*)(ST + (size_t)(sd * NCH + n) * 16384 + idx * 8);
                uint4 o; o.x = pk2(cst[0], cst[1]); o.y = pk2(cst[2], cst[3]); o.z = pk2(cst[4], cst[5]); o.w = pk2(cst[6], cst[7]);
                *ptr = o;
                cst[0] = dcy * cst[0] + scl * bflo(c0.x); cst[1] = dcy * cst[1] + scl * bfhi(c0.x);
                cst[2] = dcy * cst[2] + scl * bflo(c0.y); cst[3] = dcy * cst[3] + scl * bfhi(c0.y);
                cst[4] = dcy * cst[4] + scl * bflo(c0.z); cst[5] = dcy * cst[5] + scl * bfhi(c0.z);
                cst[6] = dcy * cst[6] + scl * bflo(c0.w); cst[7] = dcy * cst[7] + scl * bfhi(c0.w);
              } else {
                uint4* ptr = (uint4*)(NV + (size_t)(sd * NCH + n) * 128 + (idx - 2048) * 8);
                uint4 o0, o1;
                o0.x = __float_as_uint(cst[0]); o0.y = __float_as_uint(cst[1]); o0.z = __float_as_uint(cst[2]); o0.w = __float_as_uint(cst[3]);
                o1.x = __float_as_uint(cst[4]); o1.y = __float_as_uint(cst[5]); o1.z = __float_as_uint(cst[6]); o1.w = __float_as_uint(cst[7]);
                ptr[0] = o0; ptr[1] = o1;
                cst[0] = dcy * cst[0] + scl * __uint_as_float(c0.x); cst[1] = dcy * cst[1] + scl * __uint_as_float(c0.y);
                cst[2] = dcy * cst[2] + scl * __uint_as_float(c0.z); cst[3] = dcy * cst[3] + scl * __uint_as_float(c0.w);
                cst[4] = dcy * cst[4] + scl * __uint_as_float(c1.x); cst[5] = dcy * cst[5] + scl * __uint_as_float(c1.y);
                cst[6] = dcy * cst[6] + scl * __uint_as_float(c1.z); cst[7] = dcy * cst[7] + scl * __uint_as_float(c1.w);
              }
              if (idx == 0) MS[sd * NCH + n] = m;
              m = F + Mx;
            }
          }
        }
#undef SC_FETCH
      }
    } break;
    case 6: {
      const bf16_t* Vt = (const bf16_t*)(AR + A0_VT); const bf16_t* Qc = (const bf16_t*)(AR + A0_QC); const bf16_t* Kc = (const bf16_t*)(AR + A0_KC);
      const bf16_t* ST = (const bf16_t*)(AR + A0_ST); const bf16_t* Ob = (const bf16_t*)(AR + A0_O);
      float* aA = sF; float* aM = sF + 256; float* aI = sF + 512; float* aE = sF + 768; float* sN = sF + 1024; float* sQN = sF + 1280; float* sSC = sF + 1536;
      for (int t = blockIdx.x; t < 12 * NCH; t += gridDim.x) {
        const int bh = t / NCH, n = t % NCH, b = bh / 6, h = bh % 6;
        const int r0 = b * S_ + n * 128;
        __syncthreads();
        if (w < 2) {
          const int dir = w, sd = (dir * 2 + b) * 6 + h;
          const GateScan g = gate_scan(Gt, r0, dir, h, lane);
          const float mp = MS[sd * NCH + n];
          const float M0 = fmaxf(mp, g.pm0), M1 = fmaxf(mp, g.pm1);
          aA[dir * 128 + g.pos0] = __expf(g.a0 - g.amax); aA[dir * 128 + g.pos1] = __expf(g.a1 - g.amax);
          aM[dir * 128 + g.pos0] = __expf(g.amax - M0); aM[dir * 128 + g.pos1] = __expf(g.amax - M1);
          aI[dir * 128 + g.pos0] = __expf(mp - M0); aI[dir * 128 + g.pos1] = __expf(mp - M1);
          aE[dir * 128 + g.pos0] = __expf(-(g.b0 + M0)); aE[dir * 128 + g.pos1] = __expf(-(g.b1 + M1));
        } else {
          const int dir = w - 2, sd = (dir * 2 + b) * 6 + h;
          sN[dir * 128 + lane] = NV[(size_t)(sd * NCH + n) * 128 + lane];
          sN[dir * 128 + 64 + lane] = NV[(size_t)(sd * NCH + n) * 128 + 64 + lane];
        }
        __syncthreads();
        const bf16_t* Qb = Qc + (size_t)r0 * 768 + h * 128;
        const bf16_t* Kb = Kc + (size_t)r0 * 768 + h * 128;
        {
          const int qr = tid >> 1, k0 = (tid & 1) * 64;
          float sf = 0.f, sb = 0.f;
#pragma unroll
          for (int c8 = 0; c8 < 8; ++c8) {
            const uint4 u = *(const uint4*)(Qb + (size_t)qr * 768 + k0 + c8 * 8);
            const float* nf = sN + k0 + c8 * 8; const float* nb = sN + 128 + k0 + c8 * 8;
            sf += bflo(u.x) * nf[0] + bfhi(u.x) * nf[1] + bflo(u.y) * nf[2] + bfhi(u.y) * nf[3] + bflo(u.z) * nf[4] + bfhi(u.z) * nf[5] + bflo(u.w) * nf[6] + bfhi(u.w) * nf[7];
            sb += bflo(u.x) * nb[0] + bfhi(u.x) * nb[1] + bflo(u.y) * nb[2] + bfhi(u.y) * nb[3] + bflo(u.z) * nb[4] + bfhi(u.z) * nb[5] + bflo(u.w) * nb[6] + bfhi(u.w) * nb[7];
          }
          sf += __shfl_xor(sf, 1); sb += __shfl_xor(sb, 1);
          if ((tid & 1) == 0) { sQN[qr] = sf; sQN[128 + qr] = sb; }
        }
        f32x4 acc[2][8]; zero_acc(acc);
        block_gemm<false>(acc, 2,
            [&](int row, int k) { return *(const uint4*)(Qb + (size_t)row * 768 + k); },
            [&](int row, int k) { return *(const uint4*)(Kb + (size_t)row * 768 + k); }, smem, nullptr, 0);
        __syncthreads();
        {
          float rsf[2] = {0.f, 0.f}, rsb[2] = {0.f, 0.f};
#pragma unroll
          for (int ni = 0; ni < 8; ++ni) {
            const int s0 = 16 * ni + 4 * fq;
            const f32x4 ef = *(const f32x4*)(aA + s0), eb = *(const f32x4*)(aA + 128 + s0);
#pragma unroll
            for (int mi = 0; mi < 2; ++mi) {
              const int tr = 32 * w + 16 * mi + fr;
#pragma unroll
              for (int j = 0; j < 4; ++j) {
                const float sv = acc[mi][ni][j];
                rsf[mi] += (s0 + j <= tr) ? sv * ef[j] : 0.f;
                rsb[mi] += (s0 + j >= tr) ? sv * eb[j] : 0.f;
              }
            }
          }
          float cf[2], cb[2];
#pragma unroll
          for (int mi = 0; mi < 2; ++mi) {
            const int tr = 32 * w + 16 * mi + fr;
            float a = rsf[mi], c2 = rsb[mi];
            a += __shfl_xor(a, 16); a += __shfl_xor(a, 32); c2 += __shfl_xor(c2, 16); c2 += __shfl_xor(c2, 32);
            const float denf = a * aM[tr] + aI[tr] * sQN[tr], denb = c2 * aM[128 + tr] + aI[128 + tr] * sQN[128 + tr];
            const float ddf = 1.f / fmaxf(fabsf(denf), aE[tr]), ddb = 1.f / fmaxf(fabsf(denb), aE[128 + tr]);
            if (fq == 0) { sSC[tr] = aI[tr] * ddf; sSC[128 + tr] = aI[128 + tr] * ddb; }
            cf[mi] = aM[tr] * ddf; cb[mi] = aM[128 + tr] * ddb;
          }
#pragma unroll
          for (int ni = 0; ni < 8; ++ni) {
            const int s0 = 16 * ni + 4 * fq;
            const f32x4 ef = *(const f32x4*)(aA + s0), eb = *(const f32x4*)(aA + 128 + s0);
#pragma unroll
            for (int mi = 0; mi < 2; ++mi) {
              const int tr = 32 * w + 16 * mi + fr;
              f32x4 pv;
#pragma unroll
              for (int j = 0; j < 4; ++j) {
                const float df = (s0 + j <= tr) ? ef[j] * cf[mi] : 0.f;
                const float db = (s0 + j >= tr) ? eb[j] * cb[mi] : 0.f;
                pv[j] = acc[mi][ni][j] * (df + db);
              }
              uint2 o; o.x = pk2(pv[0], pv[1]); o.y = pk2(pv[2], pv[3]);
              *(uint2*)&sP[tr * LDP + s0] = o;
            }
          }
        }
        __syncthreads();
        zero_acc(acc);
        {
          const bf16_t* Vb = Vt + (size_t)(b * 768 + h * 128) * S_ + n * 128;
          block_gemm<true>(acc, 2, [&](int, int) { return uint4{0u, 0u, 0u, 0u}; },
              [&](int row, int k) { return *(const uint4*)(Vb + (size_t)row * S_ + k); }, smem, sP, LDP);
        }
#pragma unroll
        for (int dir = 0; dir < 2; ++dir) {
          const int sd = (dir * 2 + b) * 6 + h;
          const bf16_t* Cb = ST + (size_t)(sd * NCH + n) * 16384;
          block_gemm<false>(acc, 2,
              [&](int row, int k) {
                const uint4 u = *(const uint4*)(Qb + (size_t)row * 768 + k);
                const float sc = sSC[dir * 128 + row];
                uint4 o; o.x = pk2(bflo(u.x) * sc, bfhi(u.x) * sc); o.y = pk2(bflo(u.y) * sc, bfhi(u.y) * sc);
                o.z = pk2(bflo(u.z) * sc, bfhi(u.z) * sc); o.w = pk2(bflo(u.w) * sc, bfhi(u.w) * sc); return o;
              },
              [&](int row, int k) { return *(const uint4*)(Cb + (size_t)row * 128 + k); }, smem, nullptr, 0);
        }
#pragma unroll
        for (int mi = 0; mi < 2; ++mi) {
          const int tr = 32 * w + 16 * mi + fr, row = r0 + tr;
          float ss = 0.f;
#pragma unroll
          for (int ni = 0; ni < 8; ++ni)
#pragma unroll
            for (int j = 0; j < 4; ++j) ss += acc[mi][ni][j] * acc[mi][ni][j];
          ss += __shfl_xor(ss, 16); ss += __shfl_xor(ss, 32);
          const float rstd = rsqrtf(ss * (1.f / 128.f) + EPS);
#pragma unroll
          for (int ni = 0; ni < 8; ++ni) {
            const int col = h * 128 + 16 * ni + 4 * fq;
            const f32x4 gg = *(const f32x4*)(p.g_head + col);
            const uint2 ou = *(const uint2*)(Ob + (size_t)row * 768 + col);
            f32x4 v;
            v[0] = acc[mi][ni][0] * rstd * gg[0] * sigmoidf_(bflo(ou.x)); v[1] = acc[mi][ni][1] * rstd * gg[1] * sigmoidf_(bfhi(ou.x));
            v[2] = acc[mi][ni][2] * rstd * gg[2] * sigmoidf_(bflo(ou.y)); v[3] = acc[mi][ni][3] * rstd * gg[3] * sigmoidf_(bfhi(ou.y));
            store_bf16_row(Hb, LDH, row, col, v);
          }
        }
      }
    } break;
    case 7: case 10: case 15: case 18: {
      const bool is_ff2 = (ph == 10 || ph == 18);
      const int layer = ph >= 15 ? 1 : 0;
      const bool from_input = (ph == 7);
      const bf16_t* A = is_ff2 ? (const bf16_t*)AR : Hb;
      const int K = is_ff2 ? DFF : D;
      const bf16_t* Bt = (const bf16_t*)((unsigned char*)WT + (is_ff2 ? WT_FF2 : WT_OUT));
      const int gidx = is_ff2 ? 5 : 2;
      auto epi = [&](f32x4 (&acc)[2][8], int mt, int nt) {
#pragma unroll
        for (int mi = 0; mi < 2; ++mi) {
          const int row = mt * 128 + 32 * w + 16 * mi + fr;
          const float* xs = xsrc_row(p, from_input, row);
          float* xd = xdst_row(p, row);
          const float* gate = mod_row(p, layer, row) + gidx * 1024;
#pragma unroll
          for (int ni = 0; ni < 8; ++ni) {
            const int col = nt * 128 + 16 * ni + 4 * fq;
            const f32x4 xv = *(const f32x4*)(xs + col), gv = *(const f32x4*)(gate + col);
            f32x4 o = xv + gv * acc[mi][ni];
            *(f32x4*)(xd + col) = o;
          }
        }
      };
      const int lda = is_ff2 ? LDHID : LDH;
      gemm_phase(A, lda, Bt, K, M / 128, 8, true, epi, smem);
      if (layer == 0) {
        const int ldb = K + 64, kper = K / 4;
        float* PART = (float*)(AR + A_PART);
        for (int u = blockIdx.x; u < 32 * 4; u += gridDim.x) {
          const int tile = u >> 2, ks = u & 3, mc = tile >> 3, nt = tile & 7, mt = (mc >> 1) * NCH + (mc & 1);
          f32x4 acc[2][8]; zero_acc(acc);
          block_gemm_glds(acc, kper / 64, A + (size_t)mt * 128 * lda + ks * kper, (size_t)lda, Bt + (size_t)nt * 128 * ldb + ks * kper, (size_t)ldb, smem);
#pragma unroll
          for (int mi = 0; mi < 2; ++mi) {
            const int row = mt * 128 + 32 * w + 16 * mi + fr, rc = (row / S_) * CTX + (row % S_);
            const float* gate = mod_row(p, layer, row) + gidx * 1024;
            float* pd = PART + ((size_t)ks * 512 + rc) * 1024;
#pragma unroll
            for (int ni = 0; ni < 8; ++ni) {
              const int col = nt * 128 + 16 * ni + 4 * fq;
              const f32x4 gv = *(const f32x4*)(gate + col);
              *(f32x4*)(pd + col) = gv * acc[mi][ni];
            }
          }
        }
      }
    } break;
    case 8: norm_phase(p, 0, 1, false, false, 1); break;
    case 9: case 17: {
      bf16_t* Hid = (bf16_t*)AR;
      auto epi = [&](f32x4 (&acc)[2][8], int mt, int nt) {
#pragma unroll
        for (int mi = 0; mi < 2; ++mi)
#pragma unroll
          for (int ni = 0; ni < 8; ++ni) {
            f32x4 v = acc[mi][ni];
#pragma unroll
            for (int j = 0; j < 4; ++j) { const float r = fmaxf(v[j], 0.f); v[j] = r * r; }
            store_bf16_row(Hid, LDHID, mt * 128 + 32 * w + 16 * mi + fr, nt * 128 + 16 * ni + 4 * fq, v);
          }
      };
      gemm_phase(Hb, LDH, (const bf16_t*)((unsigned char*)WT + WT_FF1), D, M / 128, 32, ph == 17, epi, smem);
    } break;
    case 11: {
      norm_phase(p, 1, 0, false, false, 2);
    } break;
    case 12: {
      bf16_t* Qb = (bf16_t*)(AR + A1_Q); bf16_t* Kb = (bf16_t*)(AR + A1_K); bf16_t* Vt = (bf16_t*)(AR + A1_VT); bf16_t* GL = (bf16_t*)(AR + A1_GLU);
      const float* cT = (const float*)(ws + OFF_ROPE); const float* sT = cT + 8192 * 32;
      auto epi = [&](f32x4 (&acc)[2][8], int mt, int nt) {
        const int b = mt / NCH;
        if (nt < 12) {
#pragma unroll
          for (int mi = 0; mi < 2; ++mi) {
            const int row = mt * 128 + 32 * w + 16 * mi + fr, s = row - b * S_;
            if (s >= CTX) {
              const int tpos = s - CTX;
#pragma unroll
              for (int g2 = 0; g2 < 2; ++g2)
#pragma unroll
                for (int nn = 0; nn < 2; ++nn) {
                  const int ni = g2 * 4 + nn, d0 = nn * 16 + 4 * fq;
                  const f32x4 cc = *(const f32x4*)(cT + tpos * 32 + d0), sn = *(const f32x4*)(sT + tpos * 32 + d0);
                  const f32x4 x1 = acc[mi][ni], x2 = acc[mi][ni + 2];
                  acc[mi][ni] = x1 * cc - x2 * sn; acc[mi][ni + 2] = x2 * cc + x1 * sn;
                }
            }
          }
        }
#pragma unroll
        for (int mi = 0; mi < 2; ++mi)
#pragma unroll
          for (int ni = 0; ni < 8; ++ni) {
            const int row = mt * 128 + 32 * w + 16 * mi + fr, col = nt * 128 + 16 * ni + 4 * fq;
            f32x4 v = acc[mi][ni];
            if (nt < 6) { v *= 0.18033688011112042f; store_bf16_row(Qb, 768, row, col, v); }
            else if (nt < 12) store_bf16_row(Kb, 768, row, col - 768, v);
            else if (nt < 18) store_bf16_T(Vt + (size_t)b * 768 * S_, col - 1536, row - b * S_, v);
            else store_bf16_row(GL, 512, row, col - 2304, v);
          }
      };
      gemm_phase(Hb, LDH, (const bf16_t*)((unsigned char*)WT + WT_IN), D, M / 128, 22, false, epi, smem);
    } break;
    case 13: {
      const bf16_t* Qb = (const bf16_t*)(AR + A1_Q); const bf16_t* Kb = (const bf16_t*)(AR + A1_K); const bf16_t* Vt = (const bf16_t*)(AR + A1_VT);
      bf16_t* OA = (bf16_t*)(AR + A1_OA);
      const int r = lane & 31, hh = lane >> 5;
      constexpr int STAGE = 24576, SV_OFF = 8192, NKT = S_ / 64;
      for (int t = blockIdx.x; t < NB * 6 * 2 * 64; t += gridDim.x) {
        const int qt = t & 63, mp = (t >> 6) & 1, bh = t >> 7, b = bh / 6, h = bh % 6;
        const int rq0 = b * S_ + CTX + qt * 128;
        const bf16_t* Qp = Qb + (size_t)rq0 * 768 + h * 128 + mp * 64;
        const bf16_t* Kp = Kb + (size_t)b * S_ * 768 + h * 128 + mp * 64;
        const bf16_t* Vp = Vt + (size_t)(b * 768 + h * 128) * S_;
        bf16x8 qf[4];
#pragma unroll
        for (int ks = 0; ks < 4; ++ks) qf[ks] = *(const bf16x8*)(Qp + (size_t)(32 * w + r) * 768 + 16 * ks + 8 * hh);
        f32x16 o[4];
#pragma unroll
        for (int db = 0; db < 4; ++db)
#pragma unroll
          for (int i = 0; i < 16; ++i) o[db][i] = 0.f;
        float mrun = -INFINITY, lrun = 0.f;
        LASG unsigned char* lb = (LASG unsigned char*)smem;
        const int g8 = lane >> 3, gp = lane & 7;
#define ATT_ISSUE(st_, kt_) do { \
          _Pragma("unroll") for (int i = 0; i < 2; ++i) { const int rho = 16 * w + 8 * i + g8, key_ = (rho & ~12) | ((rho & 4) << 1) | ((rho & 8) >> 1); \
            __builtin_amdgcn_global_load_lds((const unsigned*)(Kp + (size_t)((kt_) * 64 + key_) * 768 + ((gp ^ ((rho >> 1) & 7)) * 8)), (LASG unsigned*)(lb + (st_) * STAGE + (16 * w + 8 * i) * 128 + lane * 16), 16, 0, 0); } \
          _Pragma("unroll") for (int i = 0; i < 4; ++i) { const int rho = 32 * w + 8 * i + g8; \
            __builtin_amdgcn_global_load_lds((const unsigned*)(Vp + (size_t)rho * S_ + (kt_) * 64 + ((gp ^ ((rho >> 1) & 7)) * 8)), (LASG unsigned*)(lb + (st_) * STAGE + SV_OFF + (32 * w + 8 * i) * 128 + lane * 16), 16, 0, 0); } } while (0)
        const int rsw = (r >> 1) & 7;
        __syncthreads();
        ATT_ISSUE(0, 0);
        for (int kt = 0; kt < NKT; ++kt) {
          const int st = kt & 1;
          __syncthreads();
          if (kt + 1 < NKT) ATT_ISSUE(st ^ 1, kt + 1);
          const unsigned char* sK = smem + st * STAGE; const unsigned char* sV = sK + SV_OFF;
          f32x16 sx[2];
#pragma unroll
          for (int kb = 0; kb < 2; ++kb) {
#pragma unroll
            for (int i = 0; i < 16; ++i) sx[kb][i] = 0.f;
#pragma unroll
            for (int ks = 0; ks < 4; ++ks) {
              const bf16x8 kf = *(const bf16x8*)(sK + (32 * kb + r) * 128 + (((2 * ks + hh) ^ rsw) * 16));
              sx[kb] = __builtin_amdgcn_mfma_f32_32x32x16_bf16(kf, qf[ks], sx[kb], 0, 0, 0);
            }
          }
          float mx = sx[0][0];
#pragma unroll
          for (int i = 0; i < 16; ++i) { mx = fmaxf(mx, sx[0][i]); mx = fmaxf(mx, sx[1][i]); }
          mx = xor32_max(mx);
          const float mnew = fmaxf(mrun, mx), alpha = __builtin_amdgcn_exp2f(mrun - mnew);
          float rs = 0.f;
#pragma unroll
          for (int kb = 0; kb < 2; ++kb)
#pragma unroll
            for (int i = 0; i < 16; ++i) { const float pv = __builtin_amdgcn_exp2f(sx[kb][i] - mnew); sx[kb][i] = pv; rs += pv; }
          rs = xor32_sum(rs);
          lrun = lrun * alpha + rs; mrun = mnew;
          if (__any(alpha != 1.f)) {
#pragma unroll
            for (int db = 0; db < 4; ++db) o[db] *= alpha;
          }
#pragma unroll
          for (int kb = 0; kb < 2; ++kb)
#pragma unroll
            for (int s2 = 0; s2 < 2; ++s2) {
              uint4 xp;
              xp.x = pk2(sx[kb][8 * s2 + 0], sx[kb][8 * s2 + 1]); xp.y = pk2(sx[kb][8 * s2 + 2], sx[kb][8 * s2 + 3]);
              xp.z = pk2(sx[kb][8 * s2 + 4], sx[kb][8 * s2 + 5]); xp.w = pk2(sx[kb][8 * s2 + 6], sx[kb][8 * s2 + 7]);
              const bf16x8 xs = __builtin_bit_cast(bf16x8, xp);
#pragma unroll
              for (int db = 0; db < 4; ++db) {
                const bf16x8 pa = *(const bf16x8*)(sV + (32 * db + r) * 128 + (((4 * kb + 2 * s2 + hh) ^ rsw) * 16));
                o[db] = __builtin_amdgcn_mfma_f32_32x32x16_bf16(pa, xs, o[db], 0, 0, 0);
              }
            }
        }
#undef ATT_ISSUE
        bf16_t* Od = OA + (size_t)mp * M * 768 + (size_t)(rq0 + 32 * w + r) * 768 + h * 128;
        const float inv = 1.f / lrun;
#pragma unroll
        for (int db = 0; db < 4; ++db)
#pragma unroll
          for (int g = 0; g < 4; ++g) {
            uint2 ov; ov.x = pk2(o[db][4 * g] * inv, o[db][4 * g + 1] * inv); ov.y = pk2(o[db][4 * g + 2] * inv, o[db][4 * g + 3] * inv);
            *(uint2*)(Od + 32 * db + 8 * g + 4 * hh) = ov;
          }
      }
    } break;
    case 14: {
      const bf16_t* OA = (const bf16_t*)(AR + A1_OA); const bf16_t* GL = (const bf16_t*)(AR + A1_GLU);
      const float lam_init = 0.8f - 0.6f * 0.7408182206817179f;
      {
        float l1 = p.lam_p[lane] * p.lam_p[64 + lane], l2 = p.lam_p[128 + lane] * p.lam_p[192 + lane];
        l1 = wsum(l1); l2 = wsum(l2);
        const float lam = __expf(l1) - __expf(l2) + lam_init;
        const int gw = blockIdx.x * 4 + w, ngw = gridDim.x * 4;
        const int l16 = lane & 15, g4 = lane >> 4;
        const f32x4 gs0 = *(const f32x4*)(p.g_sub + 8 * l16), gs1 = *(const f32x4*)(p.g_sub + 8 * l16 + 4);
        for (int it = gw; it < NB * SEQ * 6 / 4; it += ngw) {
          const int item = it * 4 + g4, rl = item / 6, h = item - rl * 6;
          const int b = rl / SEQ, tpos = rl % SEQ, row = b * S_ + CTX + tpos;
          const uint4 u0 = *(const uint4*)(OA + (size_t)row * 768 + h * 128 + 8 * l16);
          const uint4 u1 = *(const uint4*)(OA + (size_t)M * 768 + (size_t)row * 768 + h * 128 + 8 * l16);
          float o[8];
          o[0] = bflo(u0.x) - lam * bflo(u1.x); o[1] = bfhi(u0.x) - lam * bfhi(u1.x); o[2] = bflo(u0.y) - lam * bflo(u1.y); o[3] = bfhi(u0.y) - lam * bfhi(u1.y);
          o[4] = bflo(u0.z) - lam * bflo(u1.z); o[5] = bfhi(u0.z) - lam * bfhi(u1.z); o[6] = bflo(u0.w) - lam * bflo(u1.w); o[7] = bfhi(u0.w) - lam * bfhi(u1.w);
          float ss = 0.f;
#pragma unroll
          for (int e = 0; e < 8; ++e) ss += o[e] * o[e];
          ss += __shfl_xor(ss, 1); ss += __shfl_xor(ss, 2); ss += __shfl_xor(ss, 4); ss += __shfl_xor(ss, 8);
          const float rstd = rsqrtf(ss * (1.f / 128.f) + EPS) * (1.f - lam_init);
          uint4 ov;
          ov.x = pk2(o[0] * rstd * gs0[0], o[1] * rstd * gs0[1]); ov.y = pk2(o[2] * rstd * gs0[2], o[3] * rstd * gs0[3]);
          ov.z = pk2(o[4] * rstd * gs1[0], o[5] * rstd * gs1[1]); ov.w = pk2(o[6] * rstd * gs1[2], o[7] * rstd * gs1[3]);
          *(uint4*)(Hb + (size_t)row * LDH + h * 128 + 8 * l16) = ov;
        }
      }
      {
        float* su = (float*)smem;
        for (int t = blockIdx.x; t < NB * SEQ / 32; t += gridDim.x) {
          const int b = t / (SEQ / 32), t0 = (t % (SEQ / 32)) * 32;
          __syncthreads();
          for (int i = tid; i < 62 * 64; i += 256) {
            const int rr = i >> 6, c4 = (i & 63) * 4, tp = t0 + rr - 15;
            f32x4 u = {0.f, 0.f, 0.f, 0.f};
            if (tp >= 0 && tp < SEQ) {
              const size_t ro = (size_t)(b * S_ + CTX + tp) * 512;
              const uint2 av = *(const uint2*)(GL + ro + c4), gv = *(const uint2*)(GL + ro + 256 + c4);
              u[0] = bflo(av.x) * sigmoidf_(bflo(gv.x)); u[1] = bfhi(av.x) * sigmoidf_(bfhi(gv.x));
              u[2] = bflo(av.y) * sigmoidf_(bflo(gv.y)); u[3] = bfhi(av.y) * sigmoidf_(bfhi(gv.y));
            }
            *(f32x4*)(su + rr * 256 + c4) = u;
          }
          __syncthreads();
          float z[32], wj[31];
#pragma unroll
          for (int tt = 0; tt < 32; ++tt) z[tt] = 0.f;
#pragma unroll
          for (int j = 0; j < 31; ++j) wj[j] = p.w_dw[j * 256 + tid];
#pragma unroll
          for (int rr = 0; rr < 62; ++rr) {
            const float u = su[rr * 256 + tid];
#pragma unroll
            for (int tt = 0; tt < 32; ++tt) { const int j = rr - tt; if (j >= 0 && j < 31) z[tt] += wj[j] * u; }
          }
          __syncthreads();
#pragma unroll
          for (int tt = 0; tt < 32; ++tt) su[tt * 256 + tid] = z[tt];
          __syncthreads();
          for (int tt = w; tt < 32; tt += 4) {
            f32x4 v = *(const f32x4*)(su + tt * 256 + 4 * lane);
            const float mu = wsum(v[0] + v[1] + v[2] + v[3]) * (1.f / 256.f);
            v -= mu;
            const float rstd = rsqrtf(wsum(v[0] * v[0] + v[1] * v[1] + v[2] * v[2] + v[3] * v[3]) * (1.f / 256.f) + EPS);
            const f32x4 gl = *(const f32x4*)(p.g_cln + 4 * lane), bl = *(const f32x4*)(p.b_cln + 4 * lane);
            float y[4];
#pragma unroll
            for (int e = 0; e < 4; ++e) y[e] = siluf_(v[e] * rstd * gl[e] + bl[e]);
            uint2 o; o.x = pk2(y[0], y[1]); o.y = pk2(y[2], y[3]);
            *(uint2*)(Hb + (size_t)(b * S_ + CTX + t0 + tt) * LDH + 768 + 4 * lane) = o;
          }
        }
      }
    } break;
    case 16: norm_phase(p, 1, 1, false, true); break;
    case 19: {
      const int gw = blockIdx.x * 4 + w, ngw = gridDim.x * 4;
      for (int r = gw; r < NB * SEQ; r += ngw) {
        f32x4* xr = (f32x4*)(p.out + (size_t)r * D) + lane;
        f32x4 v[4]; float ss = 0.f;
#pragma unroll
        for (int j = 0; j < 4; ++j) { v[j] = xr[64 * j]; ss += v[j][0] * v[j][0] + v[j][1] * v[j][1] + v[j][2] * v[j][2] + v[j][3] * v[j][3]; }
        const float rstd = rsqrtf(wsum(ss) * (1.f / D) + EPS);
#pragma unroll
        for (int j = 0; j < 4; ++j) { const f32x4 gg = *(const f32x4*)(p.g_final + 4 * lane + 256 * j); xr[64 * j] = v[j] * rstd * gg; }
      }
    } break;
    default: break;
    }
}

__global__ void __launch_bounds__(256, LB2) mega(Params p) {
  extern __shared__ __attribute__((aligned(16))) unsigned char smem[];
  {
    volatile LAS unsigned* st = (volatile LAS unsigned*)(smem + LDS_BYTES - 16);
    if (threadIdx.x == 0) { st[0] = 0u; st[1] = 0u; }
    __syncthreads();
  }
  if (p.ph_hi == 7777) cg::this_grid().sync();
  const XcdBarrier xb = xcd_barrier_post((unsigned*)(p.ws + OFF_BAR), (volatile LAS unsigned*)(smem + LDS_BYTES - 16));
#ifndef REP_PH
#define REP_PH -1
#endif
#define RUN(k) if (p.ph_lo <= k && k < p.ph_hi) { if (k > p.ph_lo) { xcd_barrier(xb); } run_phase<k>(p, smem); \
    if (k == REP_PH) { xcd_barrier(xb); run_phase<k>(p, smem); } }
  RUN(0) RUN(1) RUN(2) RUN(3) RUN(4) RUN(5) RUN(6) RUN(7) RUN(8) RUN(9) RUN(10) RUN(11) RUN(12) RUN(13) RUN(14) RUN(15) RUN(16) RUN(17) RUN(18) RUN(19)
#undef RUN
  if (p.ph_lo == 20) {
    const bf16_t* src = (const bf16_t*)(p.ws + DUMP_OFF);
    for (size_t i = (size_t)blockIdx.x * 256 + threadIdx.x; i < (size_t)NB * SEQ * D; i += (size_t)gridDim.x * 256) p.out[i] = bf2f(src[i]) + bf2f(((const bf16_t*)(p.ws + OFF_H))[i]);
  }
}

extern "C" void kernel_launch(void* const* d_in, const int* in_sizes, int n_in, void* d_out, int out_size, void* d_ws, size_t ws_size, hipStream_t stream) {
  static int grid_blocks = 0;
  if (!grid_blocks) {
    if (ws_size < WS_NEED) { fprintf(stderr, "kernel_launch: workspace too small: %zu < %zu\n", ws_size, (size_t)WS_NEED); grid_blocks = -1; return; }
    int dev = 0, cus = 0, per_cu = 0;
    hipGetDevice(&dev);
    hipDeviceGetAttribute(&cus, hipDeviceAttributeMultiprocessorCount, dev);
    hipFuncSetAttribute((const void*)mega, hipFuncAttributeMaxDynamicSharedMemorySize, LDS_BYTES);
    hipOccupancyMaxActiveBlocksPerMultiprocessor(&per_cu, (const void*)mega, 256, LDS_BYTES);
    if (per_cu < 1) per_cu = 1;
    if (per_cu > 2) per_cu = 2;
    grid_blocks = cus * per_cu;
    fprintf(stderr, "kernel_launch: cus %d per_cu %d grid %d ws %zu\n", cus, per_cu, grid_blocks, ws_size);
  }
  if (grid_blocks < 0) return;
  Params p{};
  const float** pp = (const float**)&p;
  for (int i = 0; i < 22; ++i) pp[i] = (const float*)d_in[i];
  p.out = (float*)d_out; p.ws = (unsigned char*)d_ws;
#if MULTI_LAUNCH
  for (int ph = 0; ph < NPH_RUN; ++ph) {
    p.ph_lo = ph; p.ph_hi = ph + 1;
    hipLaunchKernelGGL(mega, dim3(grid_blocks), dim3(256), LDS_BYTES, stream, p);
  }
#if NPH_RUN < 20
  p.ph_lo = 20; p.ph_hi = 21;
  hipLaunchKernelGGL(mega, dim3(grid_blocks), dim3(256), LDS_BYTES, stream, p);
#endif
#else
  hipMemsetAsync((unsigned char*)d_ws + OFF_BAR, 0, XCD_BAR_WORDS * 4, stream);
  p.ph_lo = 0; p.ph_hi = NPH;
  void* args[] = {&p};
  hipError_t e = hipLaunchCooperativeKernel((void*)mega, dim3(grid_blocks), dim3(256), args, LDS_BYTES, stream);
  if (e != hipSuccess) fprintf(stderr, "cooperative launch failed: %s (grid %d)\n", hipGetErrorString(e), grid_blocks);
#endif
}
```

```cpp
#include <hip/hip_runtime.h>
#include <hip/hip_cooperative_groups.h>
#include <cstdio>
#include <cstdint>
namespace cg = cooperative_groups;

#ifndef LB2
#define LB2 2
#endif
#ifndef NPH_RUN
#define NPH_RUN 20
#endif
#ifndef DUMP_OFF
#define DUMP_OFF (OFF_AR + A0_QK)
#endif
#ifndef MULTI_LAUNCH
#define MULTI_LAUNCH 0
#endif

typedef unsigned short bf16_t;
typedef short bf16x8 __attribute__((ext_vector_type(8)));
typedef float f32x4 __attribute__((ext_vector_type(4)));
typedef float f32x16 __attribute__((ext_vector_type(16)));
#define DEV __device__ __forceinline__

constexpr int D = 1024, NB = 2, SEQ = 8192, CTX = 256, S_ = SEQ + CTX, M = NB * S_, DFF = 4096;
constexpr int LDH = D + 64, LDHID = DFF + 64;
constexpr int NCH = S_ / 128;
constexpr int NPH = 20;
constexpr float EPS = 1e-6f;

constexpr size_t OFF_MOD = 0;
constexpr size_t MOD_BYTES = 2 * 3 * 6144 * 4;
constexpr size_t OFF_ROPE = 0x40000;
constexpr size_t OFF_XC = 0x240000;
constexpr size_t OFF_G = 0x440000;
constexpr size_t OFF_CS = 0x5D0000;
constexpr size_t OFF_MS = 0x5D8000;
constexpr size_t OFF_NV = 0x5DA000;
constexpr size_t OFF_WT = 0x700000;
constexpr size_t WT_IN = 0, WT_OUT = 0x770000, WT_FF1 = 0x990000, WT_FF2 = 0x1210000;
constexpr size_t OFF_H = 0x2200000;
constexpr size_t OFF_AR = 0x4510000;
constexpr size_t A0_QK = 0, A0_ST = 0, A0_VT = 0x3180000, A0_O = 0x4A40000, A0_QC = 0x6300000, A0_KC = 0x7BC0000;
constexpr size_t DO_KCT = 0, DO_ZT = 0x18C0000, DO_F = 0x2940000;
constexpr size_t A1_Q = 0, A1_K = 0x18C0000, A1_VT = 0x3180000, A1_GLU = 0x4A40000, A1_OA = 0x5AC0000;
constexpr size_t OFF_WT2 = OFF_AR + 0x9480000;
constexpr size_t WS_NEED = OFF_WT2 + 0x1A30000;

struct Params {
  const float *x, *c, *ctx, *c_ctx, *w_mod, *b_mod, *g_norm, *w_in_even, *b_gate, *w_qk_conv, *g_head, *w_out_even,
      *w_in_odd, *lam_p, *g_sub, *w_dw, *g_cln, *b_cln, *w_out_odd, *w_ff1, *w_ff2, *g_final;
  float* out;
  unsigned char* ws;
  int ph_lo, ph_hi;
};

typedef float f32x2 __attribute__((ext_vector_type(2)));
typedef __bf16 bf16x2_t __attribute__((ext_vector_type(2)));
DEV unsigned pk2(float lo, float hi) { f32x2 v = {lo, hi}; bf16x2_t b = __builtin_convertvector(v, bf16x2_t); return __builtin_bit_cast(unsigned, b); }
DEV bf16_t f2bf(float f) { return (bf16_t)(pk2(f, 0.f) & 0xffff); }
DEV float bf2f(unsigned h) { return __uint_as_float(h << 16); }
DEV float bflo(unsigned u) { return __uint_as_float(u << 16); }
DEV float bfhi(unsigned u) { return __uint_as_float(u & 0xffff0000u); }
DEV float wsum(float v) { for (int o = 32; o; o >>= 1) v += __shfl_xor(v, o); return v; }
DEV float xor32_max(float v) { auto r = __builtin_amdgcn_permlane32_swap(__float_as_uint(v), __float_as_uint(v), false, false); return fmaxf(__uint_as_float(r[0]), __uint_as_float(r[1])); }
DEV float xor32_sum(float v) { auto r = __builtin_amdgcn_permlane32_swap(__float_as_uint(v), __float_as_uint(v), false, false); return __uint_as_float(r[0]) + __uint_as_float(r[1]); }
DEV float sigmoidf_(float x) { return __builtin_amdgcn_rcpf(1.f + __expf(-x)); }
DEV float siluf_(float x) { return x * __builtin_amdgcn_rcpf(1.f + __expf(-x)); }
DEV float logsigf_(float x) { return fminf(x, 0.f) - log1pf(__expf(-fabsf(x))); }

constexpr int LDT = 72;
constexpr int LDP = 136;
constexpr int LDS_A = 0, LDS_B = 18432, LDS_P = 36864, LDS_F = 71680, LDS_BYTES = 79872;

template <bool A_LDS, class LA, class LB>
DEV void block_gemm(f32x4 (&acc)[2][8], int nk, LA la, LB lb, unsigned char* smem, const bf16_t* pA, int ldp) {
  bf16_t* sA = (bf16_t*)(smem + LDS_A);
  bf16_t* sB = (bf16_t*)(smem + LDS_B);
  const int tid = threadIdx.x, lane = tid & 63, w = tid >> 6;
  const int srow = tid >> 3, scol = (tid & 7) * 8;
  const int fr = lane & 15, fq = lane >> 4;
  uint4 ra[4], rb[4];
#pragma unroll
  for (int i = 0; i < 4; ++i) { if (!A_LDS) ra[i] = la(srow + 32 * i, scol); rb[i] = lb(srow + 32 * i, scol); }
  for (int kt = 0; kt < nk; ++kt) {
    __syncthreads();
#pragma unroll
    for (int i = 0; i < 4; ++i) {
      if (!A_LDS) *(uint4*)&sA[(srow + 32 * i) * LDT + scol] = ra[i];
      *(uint4*)&sB[(srow + 32 * i) * LDT + scol] = rb[i];
    }
    __syncthreads();
    if (kt + 1 < nk) {
#pragma unroll
      for (int i = 0; i < 4; ++i) { if (!A_LDS) ra[i] = la(srow + 32 * i, (kt + 1) * 64 + scol); rb[i] = lb(srow + 32 * i, (kt + 1) * 64 + scol); }
    }
#pragma unroll
    for (int kk = 0; kk < 2; ++kk) {
      bf16x8 af[2], bfr[8];
#pragma unroll
      for (int mi = 0; mi < 2; ++mi) {
        if (A_LDS) af[mi] = *(const bf16x8*)&pA[(32 * w + 16 * mi + fr) * ldp + kt * 64 + kk * 32 + 8 * fq];
        else af[mi] = *(const bf16x8*)&sA[(32 * w + 16 * mi + fr) * LDT + kk * 32 + 8 * fq];
      }
#pragma unroll
      for (int ni = 0; ni < 8; ++ni) bfr[ni] = *(const bf16x8*)&sB[(16 * ni + fr) * LDT + kk * 32 + 8 * fq];
#pragma unroll
      for (int mi = 0; mi < 2; ++mi)
#pragma unroll
        for (int ni = 0; ni < 8; ++ni) acc[mi][ni] = __builtin_amdgcn_mfma_f32_16x16x32_bf16(bfr[ni], af[mi], acc[mi][ni], 0, 0, 0);
    }
  }
}

DEV void zero_acc(f32x4 (&acc)[2][8]) {
#pragma unroll
  for (int mi = 0; mi < 2; ++mi)
#pragma unroll
    for (int ni = 0; ni < 8; ++ni) acc[mi][ni] = (f32x4){0.f, 0.f, 0.f, 0.f};
}

#define LASG __attribute__((address_space(3)))
DEV void block_gemm_glds(f32x4 (&acc)[2][8], int nk, const bf16_t* Ag, size_t lda, const bf16_t* Bg, size_t ldb, unsigned char* smem) {
  const int tid = threadIdx.x, lane = tid & 63, w = tid >> 6;
  const int srow = tid >> 3, sc = ((tid & 7) ^ (srow & 7)) * 8;
  const int fr = lane & 15, fq = lane >> 4;
  const bf16_t* ag = Ag + (size_t)srow * lda + sc;
  const bf16_t* bg = Bg + (size_t)srow * ldb + sc;
  LASG unsigned char* lbase = (LASG unsigned char*)smem;
#define GLDS_ISSUE(st_, k0_) do { \
    _Pragma("unroll") for (int i = 0; i < 4; ++i) { \
      __builtin_amdgcn_global_load_lds((const unsigned*)(ag + (size_t)(32 * i) * lda + (k0_)), (LASG unsigned*)(lbase + (st_) * 32768 + (tid + 256 * i) * 16), 16, 0, 0); \
      __builtin_amdgcn_global_load_lds((const unsigned*)(bg + (size_t)(32 * i) * ldb + (k0_)), (LASG unsigned*)(lbase + (st_) * 32768 + 16384 + (tid + 256 * i) * 16), 16, 0, 0); } } while (0)
  __syncthreads();
  GLDS_ISSUE(0, 0);
  for (int kt = 0; kt < nk; ++kt) {
    __syncthreads();
    if (kt + 1 < nk) GLDS_ISSUE((kt + 1) & 1, (kt + 1) * 64);
    const unsigned char* sA = smem + (kt & 1) * 32768;
    const unsigned char* sB = sA + 16384;
#pragma unroll
    for (int kk = 0; kk < 2; ++kk) {
      const int swz = ((kk * 4 + fq) ^ (fr & 7)) * 16;
      bf16x8 af[2], bfr[8];
#pragma unroll
      for (int mi = 0; mi < 2; ++mi) af[mi] = *(const bf16x8*)(sA + (32 * w + 16 * mi + fr) * 128 + swz);
#pragma unroll
      for (int ni = 0; ni < 8; ++ni) bfr[ni] = *(const bf16x8*)(sB + (16 * ni + fr) * 128 + swz);
#pragma unroll
      for (int mi = 0; mi < 2; ++mi)
#pragma unroll
        for (int ni = 0; ni < 8; ++ni) acc[mi][ni] = __builtin_amdgcn_mfma_f32_16x16x32_bf16(bfr[ni], af[mi], acc[mi][ni], 0, 0, 0);
    }
  }
#undef GLDS_ISSUE
}

DEV void block_gemm_glds2(f32x4 (&acc0)[2][8], f32x4 (&acc1)[2][8], int nk, const bf16_t* Ag, size_t lda, const bf16_t* Bg, size_t ldb, unsigned char* smem) {
  const int tid = threadIdx.x, lane = tid & 63, w = tid >> 6;
  const int fr = lane & 15, fq = lane >> 4;
  const int lr = lane >> 2, lp = lane & 3;
  const int sc = (lp ^ ((0x78 >> (2 * ((lr >> 2) & 3))) & 3)) * 8;
  const bf16_t* ag = Ag + (size_t)(32 * w + lr) * lda + sc;
  const bf16_t* bg = Bg + (size_t)(64 * w + lr) * ldb + sc;
  LASG unsigned char* lbase = (LASG unsigned char*)smem;
#define G2_ISSUE(st_, k0_) do { \
    _Pragma("unroll") for (int i = 0; i < 2; ++i) \
      __builtin_amdgcn_global_load_lds((const unsigned*)(ag + (size_t)(16 * i) * lda + (k0_)), (LASG unsigned*)(lbase + (st_) * 24576 + (32 * w + 16 * i) * 64 + lane * 16), 16, 0, 0); \
    _Pragma("unroll") for (int i = 0; i < 4; ++i) \
      __builtin_amdgcn_global_load_lds((const unsigned*)(bg + (size_t)(16 * i) * ldb + (k0_)), (LASG unsigned*)(lbase + (st_) * 24576 + 8192 + (64 * w + 16 * i) * 64 + lane * 16), 16, 0, 0); } while (0)
  __syncthreads();
  G2_ISSUE(0, 0);
  if (nk > 1) G2_ISSUE(1, 32);
  const int roff = (fq ^ ((0x78 >> (2 * ((fr >> 2) & 3))) & 3)) * 16 + fr * 64;
  int st = 0;
  for (int kt = 0; kt < nk; ++kt) {
    if (kt + 1 < nk) asm volatile("s_waitcnt vmcnt(6)" ::: "memory"); else asm volatile("s_waitcnt vmcnt(0)" ::: "memory");
    __builtin_amdgcn_s_barrier();
    asm volatile("" ::: "memory");
    if (kt + 2 < nk) { const int st2 = st >= 1 ? st - 1 : 2; G2_ISSUE(st2, (kt + 2) * 32); }
    const unsigned char* sA = smem + st * 24576;
    const unsigned char* sB = sA + 8192;
    bf16x8 af[2];
#pragma unroll
    for (int mi = 0; mi < 2; ++mi) af[mi] = *(const bf16x8*)(sA + (32 * w + 16 * mi) * 64 + roff);
    {
      bf16x8 bfr[8];
#pragma unroll
      for (int ni = 0; ni < 8; ++ni) bfr[ni] = *(const bf16x8*)(sB + (16 * ni) * 64 + roff);
#pragma unroll
      for (int mi = 0; mi < 2; ++mi)
#pragma unroll
        for (int ni = 0; ni < 8; ++ni) acc0[mi][ni] = __builtin_amdgcn_mfma_f32_16x16x32_bf16(bfr[ni], af[mi], acc0[mi][ni], 0, 0, 0);
    }
    {
      bf16x8 bfr[8];
#pragma unroll
      for (int ni = 0; ni < 8; ++ni) bfr[ni] = *(const bf16x8*)(sB + (128 + 16 * ni) * 64 + roff);
#pragma unroll
      for (int mi = 0; mi < 2; ++mi)
#pragma unroll
        for (int ni = 0; ni < 8; ++ni) acc1[mi][ni] = __builtin_amdgcn_mfma_f32_16x16x32_bf16(bfr[ni], af[mi], acc1[mi][ni], 0, 0, 0);
    }
    st = st == 2 ? 0 : st + 1;
  }
#undef G2_ISSUE
}

constexpr size_t OFF_BAR = 0x28000;
#define XB_TMO      128
#define XB_XCNT(j)  (256  + 64 * (j))
#define XB_XSUB(j)  (1280 + 64 * (j))
#define XB_XGEN(j)  (2304 + 64 * (j))
#define XB_TOP      3328
#define XB_TOPGEN   3392
#define XCD_BAR_WORDS 3456
#define XB_SPIN_CAP (1u << 18)
#define LAS __attribute__((address_space(3)))

__device__ __forceinline__ unsigned xb_ld(unsigned* p)              { return __hip_atomic_load(p, __ATOMIC_RELAXED, __HIP_MEMORY_SCOPE_AGENT); }
__device__ __forceinline__ unsigned xb_add(unsigned* p, unsigned v) { return __hip_atomic_fetch_add(p, v, __ATOMIC_RELAXED, __HIP_MEMORY_SCOPE_AGENT); }
__device__ __forceinline__ unsigned xb_xcc_id() { return (unsigned)__builtin_amdgcn_s_getreg((3 << 11) | 20) & 0xFu; }
#define XB_SPIN(cond, bar) do { unsigned _sp = 0; while (cond) { __builtin_amdgcn_s_sleep(1); \
    if ((++_sp & 255u) == 0u) { if (xb_ld(&(bar)[XB_TMO])) break; if (_sp > XB_SPIN_CAP) { atomicAdd(&(bar)[XB_TMO], 1u); break; } } } } while (0)

struct XcdBarrier {
    unsigned* bar; unsigned x;
    volatile LAS unsigned* st;
};

__device__ __forceinline__ XcdBarrier xcd_barrier_post(unsigned* bar, volatile LAS unsigned* st) {
    XcdBarrier b; b.bar = bar; b.x = xb_xcc_id(); b.st = st;
    if (threadIdx.x == 0) (void)xb_add(&bar[XB_XCNT(b.x)], 1u);
    return b;
}
__device__ __forceinline__ void xcd_barrier_complete(unsigned* bar, unsigned x, unsigned& nloc, unsigned& nx) {
    const unsigned G = gridDim.x * gridDim.y * gridDim.z;
    unsigned sum, cnt, mine, sp = 0u;
    for (;;) {
        sum = 0u; cnt = 0u; mine = 0u;
#pragma unroll
        for (unsigned j = 0; j < 16; ++j) { const unsigned c = xb_ld(&bar[XB_XCNT(j)]); sum += c; cnt += (c > 0u) ? 1u : 0u; mine = (j == x) ? c : mine; }
        if (sum == G) break;
        __builtin_amdgcn_s_sleep(1);
        if ((++sp & 255u) == 0u) { if (xb_ld(&bar[XB_TMO])) break; if (sp > XB_SPIN_CAP) { atomicAdd(&bar[XB_TMO], 1u); break; } }
    }
    nloc = mine > 0u ? mine : 1u; nx = cnt > 0u ? cnt : 1u;
}

__device__ __forceinline__ void xcd_barrier(const XcdBarrier& b) {
    asm volatile("s_waitcnt vmcnt(0)" ::: "memory");
    __syncthreads();
    if (threadIdx.x == 0) {
        unsigned* bar = b.bar;
        __builtin_amdgcn_s_waitcnt(0);
        unsigned nloc = b.st[0], nx = b.st[1];
        if (nloc == 0u) { xcd_barrier_complete(bar, b.x, nloc, nx); b.st[0] = nloc; b.st[1] = nx; }
        const unsigned old = xb_add(&bar[XB_XSUB(b.x)], 1u);
        const unsigned gen = old / nloc;
        if (old + 1u == (gen + 1u) * nloc) {
            __builtin_amdgcn_fence(__ATOMIC_RELEASE, "agent");
            asm volatile("s_waitcnt vmcnt(0)" ::: "memory");
            const unsigned og = xb_add(&bar[XB_TOP], 1u);
            const unsigned tg = og / nx;
            if (og + 1u == (tg + 1u) * nx) xb_add(&bar[XB_TOPGEN], 1u);
            else XB_SPIN(xb_ld(&bar[XB_TOPGEN]) == tg, bar);
            __builtin_amdgcn_fence(__ATOMIC_ACQUIRE, "agent");
            xb_add(&bar[XB_XGEN(b.x)], 1u);
            asm volatile("s_waitcnt vmcnt(0)" ::: "memory");
        } else {
            XB_SPIN(xb_ld(&bar[XB_XGEN(b.x)]) == gen, bar);
            __builtin_amdgcn_fence(__ATOMIC_ACQUIRE, "agent");
            asm volatile("s_waitcnt vmcnt(0)" ::: "memory");
        }
    }
    __syncthreads();
}

DEV const float* xsrc_row(const Params& p, bool from_input, int r) {
  const int b = r / S_, s = r - b * S_;
  if (from_input) return s < CTX ? p.ctx + (size_t)(b * CTX + s) * D : p.x + (size_t)(b * SEQ + s - CTX) * D;
  return s < CTX ? (const float*)(p.ws + OFF_XC) + (size_t)(b * CTX + s) * D : p.out + (size_t)(b * SEQ + s - CTX) * D;
}
DEV float* xdst_row(const Params& p, int r) {
  const int b = r / S_, s = r - b * S_;
  return s < CTX ? (float*)(p.ws + OFF_XC) + (size_t)(b * CTX + s) * D : p.out + (size_t)(b * SEQ + s - CTX) * D;
}
DEV const float* mod_row(const Params& p, int layer, int r) {
  const int b = r / S_, s = r - b * S_;
  return (const float*)(p.ws + OFF_MOD) + (size_t)(layer * 3 + (s < CTX ? 2 : b)) * 6144;
}

DEV void transpose_tile(const float* W, int K, int N, bf16_t* WT, int remap, int kt, int nt, unsigned char* smem) {
  float* tile = (float*)smem;
  const int tid = threadIdx.x;
  __syncthreads();
#pragma unroll
  for (int i = 0; i < 4; ++i) {
    const int kk = (tid >> 4) + 16 * i, c4 = (tid & 15) * 4;
    const int n = nt * 64 + c4;
    int src = n;
    if (remap) src = n < 3072 ? n : (n < 3328 ? n + 24 : (n < 3352 ? n - 256 : -1));
    else if (n >= N) src = -1;
    f32x4 v = (f32x4){0.f, 0.f, 0.f, 0.f};
    if (src >= 0) v = *(const f32x4*)(W + (size_t)(kt * 64 + kk) * N + src);
    tile[kk * 65 + c4 + 0] = v[0]; tile[kk * 65 + c4 + 1] = v[1]; tile[kk * 65 + c4 + 2] = v[2]; tile[kk * 65 + c4 + 3] = v[3];
  }
  __syncthreads();
  const int n = tid >> 2, kc = (tid & 3) * 16;
  uint4 o0, o1;
  const float* t = tile + kc * 65 + n;
  o0.x = pk2(t[0 * 65], t[1 * 65]); o0.y = pk2(t[2 * 65], t[3 * 65]); o0.z = pk2(t[4 * 65], t[5 * 65]); o0.w = pk2(t[6 * 65], t[7 * 65]);
  o1.x = pk2(t[8 * 65], t[9 * 65]); o1.y = pk2(t[10 * 65], t[11 * 65]); o1.z = pk2(t[12 * 65], t[13 * 65]); o1.w = pk2(t[14 * 65], t[15 * 65]);
  bf16_t* dst = WT + (size_t)(nt * 64 + n) * (K + 64) + kt * 64 + kc;
  *(uint4*)dst = o0; *(uint4*)(dst + 8) = o1;
}
DEV void transpose_mat(const float* Wm, int K, int N, int Npad, bf16_t* dst, int remap, unsigned char* smem, int b0, int nb) {
  const int nkt = K / 64, nnt = Npad / 64;
  if ((int)blockIdx.x < b0) return;
  for (int t = blockIdx.x - b0; t < nkt * nnt; t += nb) transpose_tile(Wm, K, N, dst, remap, t / nnt, t % nnt, smem);
}
DEV void convert_weights(const Params& p, int part, unsigned char* smem, int b0, int nb) {
  unsigned char* wt = p.ws + OFF_WT; unsigned char* wt2 = p.ws + OFF_WT2;
  if (part == 0) { transpose_mat(p.w_in_even, 1024, 3352, 3584, (bf16_t*)(wt + WT_IN), 1, smem, b0, nb); return; }
  transpose_mat(p.w_out_even, 1024, 1024, 1024, (bf16_t*)(wt + WT_OUT), 0, smem, b0, nb);
  transpose_mat(p.w_ff1, 1024, 4096, 4096, (bf16_t*)(wt + WT_FF1), 0, smem, b0, nb);
  transpose_mat(p.w_ff2, 4096, 1024, 1024, (bf16_t*)(wt + WT_FF2), 0, smem, b0, nb);
  transpose_mat(p.w_in_odd, 1024, 2816, 2816, (bf16_t*)(wt2 + WT_IN), 0, smem, b0, nb);
  transpose_mat(p.w_out_odd, 1024, 1024, 1024, (bf16_t*)(wt2 + WT_OUT), 0, smem, b0, nb);
  transpose_mat(p.w_ff1 + (size_t)1024 * 4096, 1024, 4096, 4096, (bf16_t*)(wt2 + WT_FF1), 0, smem, b0, nb);
  transpose_mat(p.w_ff2 + (size_t)1024 * 4096, 4096, 1024, 1024, (bf16_t*)(wt2 + WT_FF2), 0, smem, b0, nb);
}

DEV void mod_phase(const Params& p, unsigned char* smem) {
  float* MOD = (float*)(p.ws + OFF_MOD);
  float* sS = (float*)smem;
  float* red = sS + 3072;
  const int tid = threadIdx.x, cl = tid & 31, kg = tid >> 5;
  if ((int)blockIdx.x >= 2 * 192) return;
  __syncthreads();
  for (int i = tid; i < 3072; i += 256) { const int v = i >> 10, k = i & 1023; sS[i] = siluf_(v == 0 ? p.c[k] : (v == 1 ? p.c[1024 + k] : p.c_ctx[k])); }
  __syncthreads();
  for (int it = blockIdx.x; it < 2 * 192; it += gridDim.x) {
    const int l = it / 192, n = (it % 192) * 32 + cl;
    const float* W = p.w_mod + (size_t)l * 1024 * 6144 + n;
    float a0 = 0.f, a1 = 0.f, a2 = 0.f;
#pragma unroll 16
    for (int k = kg * 128; k < kg * 128 + 128; ++k) {
      const float wv = W[(size_t)k * 6144];
      a0 += sS[k] * wv; a1 += sS[1024 + k] * wv; a2 += sS[2048 + k] * wv;
    }
    __syncthreads();
    red[(kg * 32 + cl) * 3 + 0] = a0; red[(kg * 32 + cl) * 3 + 1] = a1; red[(kg * 32 + cl) * 3 + 2] = a2;
    __syncthreads();
    if (kg == 0) {
      const float bv = p.b_mod[l * 6144 + n];
#pragma unroll
      for (int v = 0; v < 3; ++v) {
        float sacc = 0.f;
#pragma unroll
        for (int g2 = 0; g2 < 8; ++g2) sacc += red[(g2 * 32 + cl) * 3 + v];
        MOD[(l * 3 + v) * 6144 + n] = sacc + bv;
      }
    }
  }
}
DEV void rope_phase(const Params& p) {
  float* ct = (float*)(p.ws + OFF_ROPE);
  float* st = ct + 8192 * 32;
  for (int i = blockIdx.x * 256 + threadIdx.x; i < 8192 * 32; i += gridDim.x * 256) {
    const int t = i >> 5, d = i & 31;
    const float pos = (d < 16) ? (float)(t >> 6) : (float)(t & 63);
    const float inv = powf(10000.f, -(float)(d & 15) / 16.f);
    const float ang = pos * inv;
    ct[i] = cosf(ang); st[i] = sinf(ang);
  }
}

constexpr size_t A_PART = 0x8700000;
DEV void norm_phase(const Params& p, int layer, int which, bool from_input, bool skip_ctx, int ctx_fix = 0) {
  const int lane = threadIdx.x & 63;
  const int gw = blockIdx.x * 4 + (threadIdx.x >> 6), ngw = gridDim.x * 4;
  const float* g = p.g_norm + (layer * 2 + which) * D;
  bf16_t* H = (bf16_t*)(p.ws + OFF_H);
  for (int r = gw; r < M; r += ngw) {
    const int s = r % S_;
    if (skip_ctx && s < CTX) continue;
    const bool fix = ctx_fix && s < CTX;
    const f32x4* xr = (const f32x4*)xsrc_row(p, fix ? (ctx_fix == 1) : from_input, r) + lane;
    const float* mv = mod_row(p, layer, r) + which * 3 * 1024;
    f32x4 v[4]; float ss = 0.f;
#pragma unroll
    for (int j = 0; j < 4; ++j) v[j] = xr[64 * j];
    if (fix) {
      const int rc = (r / S_) * CTX + s;
      const f32x4* pp = (const f32x4*)(p.ws + OFF_AR + A_PART) + (size_t)rc * 256 + lane;
      f32x4* xw = (f32x4*)xdst_row(p, r) + lane;
#pragma unroll
      for (int j = 0; j < 4; ++j) {
        v[j] += (pp[64 * j] + pp[(size_t)512 * 256 + 64 * j]) + (pp[(size_t)2 * 512 * 256 + 64 * j] + pp[(size_t)3 * 512 * 256 + 64 * j]);
        xw[64 * j] = v[j];
      }
    }
#pragma unroll
    for (int j = 0; j < 4; ++j) ss += v[j][0] * v[j][0] + v[j][1] * v[j][1] + v[j][2] * v[j][2] + v[j][3] * v[j][3];
    const float rstd = rsqrtf(wsum(ss) * (1.f / D) + EPS);
    uint2* o = (uint2*)(H + (size_t)r * LDH) + lane;
#pragma unroll
    for (int j = 0; j < 4; ++j) {
      const int c = 4 * lane + 256 * j;
      const f32x4 gg = *(const f32x4*)(g + c), sh = *(const f32x4*)(mv + c), sc = *(const f32x4*)(mv + 1024 + c);
      float y[4];
#pragma unroll
      for (int e = 0; e < 4; ++e) y[e] = v[j][e] * rstd * gg[e] * (1.f + sc[e]) + sh[e];
      uint2 w2; w2.x = pk2(y[0], y[1]); w2.y = pk2(y[2], y[3]);
      o[64 * j] = w2;
    }
  }
}

template <class Epi>
DEV void gemm_phase(const bf16_t* A, int lda, const bf16_t* Bt, int K, int MT, int NT, bool skip_ctx, Epi epi, unsigned char* smem) {
  const int ldb = K + 64;
  const int MTv = skip_ctx ? MT - 2 * NB : MT;
  const int nwg = MTv * NT;
  for (int t = blockIdx.x; t < nwg; t += gridDim.x) {
    int wgid = t;
    { const int q = nwg / 8, r8 = nwg % 8, xcd = wgid % 8, off = wgid / 8; wgid = (xcd < r8 ? xcd * (q + 1) : r8 * (q + 1) + (xcd - r8) * q) + off; }
    const int nig = 8 * NT, gid = wgid / nig, fm = gid * 8, gsz = (MTv - fm) < 8 ? (MTv - fm) : 8;
    int mt = fm + (wgid % nig) % gsz; const int nt = (wgid % nig) / gsz;
    if (skip_ctx) mt = (mt / (NCH - 2)) * NCH + 2 + (mt % (NCH - 2));
    f32x4 acc[2][8]; zero_acc(acc);
    const bf16_t* Ab = A + (size_t)mt * 128 * lda;
    const bf16_t* Bb = Bt + (size_t)nt * 128 * ldb;
    block_gemm_glds(acc, K / 64, Ab, (size_t)lda, Bb, (size_t)ldb, smem);
    epi(acc, mt, nt);
  }
}

template <class Epi>
DEV void gemm_phase2(const bf16_t* A, int lda, const bf16_t* Bt, int K, int MT, int NP, bool skip_ctx, Epi epi, unsigned char* smem) {
  const int ldb = K + 64;
  const int MTv = skip_ctx ? MT - 2 * NB : MT;
  for (int t = blockIdx.x; t < MTv * NP; t += gridDim.x) {
    int mt = t / NP; const int np = t % NP;
    if (skip_ctx) mt = (mt / (NCH - 2)) * NCH + 2 + (mt % (NCH - 2));
    f32x4 acc0[2][8], acc1[2][8]; zero_acc(acc0); zero_acc(acc1);
    block_gemm_glds2(acc0, acc1, K / 32, A + (size_t)mt * 128 * lda, (size_t)lda, Bt + (size_t)np * 256 * ldb, (size_t)ldb, smem);
    epi(acc0, mt, 2 * np);
    epi(acc1, mt, 2 * np + 1);
  }
}

#define EPI_COORDS const int lane = threadIdx.x & 63, w = threadIdx.x >> 6, fr = lane & 15, fq = lane >> 4; (void)w; (void)fr; (void)fq;

DEV void store_bf16_row(bf16_t* base, size_t ld, int row, int col, const f32x4& v) {
  uint2 o; o.x = pk2(v[0], v[1]); o.y = pk2(v[2], v[3]);
  *(uint2*)(base + (size_t)row * ld + col) = o;
}
DEV void store_bf16_T(bf16_t* base, int col, int s, const f32x4& v) {
#pragma unroll
  for (int j = 0; j < 4; ++j) base[(size_t)(col + j) * S_ + s] = f2bf(v[j]);
}

struct GateScan { float a0, a1, b0, b1, pm0, pm1, F, amax; int pos0, pos1; };
DEV GateScan gate_scan(const float* G, const int r0, const int dir, const int h, const int lane) {
  GateScan g;
  const int j0 = 2 * lane, j1 = j0 + 1;
  g.pos0 = dir ? 127 - j0 : j0; g.pos1 = dir ? 127 - j1 : j1;
  const float i0 = G[(size_t)(r0 + g.pos0) * 24 + (dir * 2) * 6 + h], f0 = G[(size_t)(r0 + g.pos0) * 24 + (dir * 2 + 1) * 6 + h];
  const float i1 = G[(size_t)(r0 + g.pos1) * 24 + (dir * 2) * 6 + h], f1 = G[(size_t)(r0 + g.pos1) * 24 + (dir * 2 + 1) * 6 + h];
  const float lf0 = logsigf_(f0), lf1 = logsigf_(f1);
  const float s0 = lf0, s1 = lf0 + lf1;
  float tot = s1;
#pragma unroll
  for (int d = 1; d < 64; d <<= 1) { const float y = __shfl_up(tot, d); if (lane >= d) tot += y; }
  const float excl = tot - s1;
  g.b0 = s0 + excl; g.b1 = s1 + excl;
  g.F = __shfl(tot, 63);
  g.a0 = i0 - g.b0; g.a1 = i1 - g.b1;
  const float q0 = g.a0, q1 = fmaxf(g.a0, g.a1);
  float t = q1;
#pragma unroll
  for (int d = 1; d < 64; d <<= 1) { const float y = __shfl_up(t, d); if (lane >= d) t = fmaxf(t, y); }
  float ex = __shfl_up(t, 1); if (lane == 0) ex = -INFINITY;
  g.pm0 = fmaxf(q0, ex); g.pm1 = fmaxf(q1, ex);
  g.amax = __shfl(t, 63);
  return g;
}
DEV int chunk_ord(int dir, int i) { return dir == 0 ? i : (i < 2 ? 1 - i : 67 - i); }

template <int ph>
DEV void run_phase(const Params& p, unsigned char* smem) {
  const int tid = threadIdx.x, lane = tid & 63, w = tid >> 6, fr = lane & 15, fq = lane >> 4;
  unsigned char* ws = p.ws;
  bf16_t* const WT = (bf16_t*)(ws + (ph >= 11 ? OFF_WT2 : OFF_WT));
  bf16_t* const Hb = (bf16_t*)(ws + OFF_H);
  float* const Gt = (float*)(ws + OFF_G);
  float* const CS = (float*)(ws + OFF_CS);
  float* const MS = (float*)(ws + OFF_MS);
  float* const NV = (float*)(ws + OFF_NV);
  unsigned char* const AR = ws + OFF_AR;
  unsigned char* const DO = (unsigned char*)p.out;
  float* const sF = (float*)(smem + LDS_F);
  bf16_t* const sP = (bf16_t*)(smem + LDS_P);

    switch (ph) {
    case 0: {
      convert_weights(p, 0, smem, 0, gridDim.x);
      mod_phase(p, smem);
      rope_phase(p);
    } break;
    case 1: norm_phase(p, 0, 0, true, false); break;
    case 2: {
      bf16_t* QK = (bf16_t*)(AR + A0_QK); bf16_t* Vt = (bf16_t*)(AR + A0_VT); bf16_t* Ob = (bf16_t*)(AR + A0_O); bf16_t* Fb = (bf16_t*)(DO + DO_F);
      const float* bg = p.b_gate;
      auto epi = [&](f32x4 (&acc)[2][8], int mt, int nt) {
        const int b = mt / NCH;
        const int row0 = mt * 128 + 32 * w + fr, col0 = nt * 128 + 4 * fq;
        if (nt < 12 || (nt >= 18 && nt < 26)) {
          bf16_t* tb; int ld;
          if (nt < 12) { tb = QK + (size_t)row0 * 1536 + col0; ld = 1536; }
          else if (nt < 24) { tb = Ob + (size_t)row0 * 768 + (col0 - 2304); ld = 768; }
          else { tb = Fb + (size_t)row0 * 256 + (col0 - 3072); ld = 256; }
#pragma unroll
          for (int mi = 0; mi < 2; ++mi)
#pragma unroll
            for (int ni = 0; ni < 8; ++ni) {
              uint2 o; o.x = pk2(acc[mi][ni][0], acc[mi][ni][1]); o.y = pk2(acc[mi][ni][2], acc[mi][ni][3]);
              *(uint2*)(tb + (size_t)(16 * mi) * ld + 16 * ni) = o;
            }
        } else if (nt < 18) {
          bf16_t* tb = Vt + (size_t)b * 768 * S_ + (size_t)(col0 - 1536) * S_ + (row0 - b * S_);
#pragma unroll
          for (int mi = 0; mi < 2; ++mi)
#pragma unroll
            for (int ni = 0; ni < 8; ++ni)
#pragma unroll
              for (int j = 0; j < 4; ++j) tb[(size_t)(16 * ni + j) * S_ + 16 * mi] = f2bf(acc[mi][ni][j]);
        } else if (nt == 26) {
#pragma unroll
          for (int mi = 0; mi < 2; ++mi)
#pragma unroll
            for (int ni = 0; ni < 2; ++ni) {
              const int gc = 16 * ni + 4 * fq;
              if (gc < 24) { f32x4 o = acc[mi][ni]; o += *(const f32x4*)(bg + gc); *(f32x4*)(Gt + (size_t)(row0 + 16 * mi) * 24 + gc) = o; }
            }
        }
      };
      gemm_phase(Hb, LDH, (const bf16_t*)((unsigned char*)WT + WT_IN), D, M / 128, 27, false, epi, smem);
    } break;
    case 3: {
      const bf16_t* QK = (const bf16_t*)(AR + A0_QK);
      bf16_t* Qc = (bf16_t*)(AR + A0_QC); bf16_t* Kc = (bf16_t*)(AR + A0_KC); bf16_t* KcT = (bf16_t*)(DO + DO_KCT);
      bf16_t* ZT = (bf16_t*)(DO + DO_ZT); const bf16_t* Fb = (const bf16_t*)(DO + DO_F);
      for (int t = blockIdx.x; t < (M / 128) * 4; t += gridDim.x) {
        const int mt = t >> 2, g = t & 3;
        f32x4 acc[2][8]; zero_acc(acc);
        block_gemm<false>(acc, 1,
            [&](int row, int k) {
              const int cp = row & 63, im = row >> 6; float vv[8];
#pragma unroll
              for (int j = 0; j < 8; ++j) { const int mm = (cp * (k + j)) & 63; const float xx = (float)mm * (1.f / 64.f); vv[j] = im ? -__builtin_amdgcn_sinf(xx) : __builtin_amdgcn_cosf(xx); }
              uint4 o; o.x = pk2(vv[0], vv[1]); o.y = pk2(vv[2], vv[3]); o.z = pk2(vv[4], vv[5]); o.w = pk2(vv[6], vv[7]); return o;
            },
            [&](int row, int k) { return *(const uint4*)(Fb + (size_t)(mt * 128 + row) * 256 + g * 64 + k); },
            smem, nullptr, 0);
        const int b = mt / NCH;
#pragma unroll
        for (int mi = 0; mi < 2; ++mi) {
          const int n = 32 * w + 16 * mi + fr, cp = n & 63, im = n >> 6;
          bf16_t* zrow = ZT + (size_t)((b * 256 + g * 64 + cp) * 2 + im) * S_ + (mt * 128 - b * S_);
#pragma unroll
          for (int ni = 0; ni < 8; ++ni) {
            uint2 o; o.x = pk2(acc[mi][ni][0], acc[mi][ni][1]); o.y = pk2(acc[mi][ni][2], acc[mi][ni][3]);
            *(uint2*)(zrow + 16 * ni + 4 * fq) = o;
          }
        }
      }
      bf16_t* tl = (bf16_t*)smem;
      for (int t = blockIdx.x; t < (M / 64) * 12; t += gridDim.x) {
        const int rt = t / 12, ct = t % 12;
        const int r0 = rt * 64, b = r0 / S_, s0 = r0 - b * S_;
        const int lo = (s0 < CTX) ? 0 : CTX, hi = (s0 < CTX) ? CTX - 1 : S_ - 1;
        __syncthreads();
#pragma unroll
        for (int i = 0; i < 4; ++i) {
          const int id = tid + 256 * i, rr = id >> 4, cc = (id & 15) * 8;
          const int s = s0 + rr, c = ct * 128 + cc;
          const size_t base = (size_t)(r0 + rr) * 1536 + c;
          uint4 z = {0u, 0u, 0u, 0u};
          const uint4 u1 = *(const uint4*)(QK + base);
          const uint4 u0 = (s - 1 >= lo) ? *(const uint4*)(QK + base - 1536) : z;
          const uint4 u2 = (s + 1 <= hi) ? *(const uint4*)(QK + base + 1536) : z;
          const unsigned a0[4] = {u0.x, u0.y, u0.z, u0.w}, a1[4] = {u1.x, u1.y, u1.z, u1.w}, a2[4] = {u2.x, u2.y, u2.z, u2.w};
          float o[8];
          {
            const f32x4 wa0 = *(const f32x4*)(p.w_qk_conv + c), wa1 = *(const f32x4*)(p.w_qk_conv + c + 4);
            const f32x4 wb0 = *(const f32x4*)(p.w_qk_conv + 1536 + c), wb1 = *(const f32x4*)(p.w_qk_conv + 1536 + c + 4);
            const f32x4 wc0 = *(const f32x4*)(p.w_qk_conv + 3072 + c), wc1 = *(const f32x4*)(p.w_qk_conv + 3072 + c + 4);
            const float wA[8] = {wa0[0], wa0[1], wa0[2], wa0[3], wa1[0], wa1[1], wa1[2], wa1[3]};
            const float wB[8] = {wb0[0], wb0[1], wb0[2], wb0[3], wb1[0], wb1[1], wb1[2], wb1[3]};
            const float wC[8] = {wc0[0], wc0[1], wc0[2], wc0[3], wc1[0], wc1[1], wc1[2], wc1[3]};
#pragma unroll
            for (int e = 0; e < 4; ++e) {
              o[2 * e] = siluf_(wA[2 * e] * bflo(a0[e]) + wB[2 * e] * bflo(a1[e]) + wC[2 * e] * bflo(a2[e]));
              o[2 * e + 1] = siluf_(wA[2 * e + 1] * bfhi(a0[e]) + wB[2 * e + 1] * bfhi(a1[e]) + wC[2 * e + 1] * bfhi(a2[e]));
            }
          }
          if (ct < 6) {
            const float sc = 0.08838834764831845f;
            uint4 q; q.x = pk2(o[0] * sc, o[1] * sc); q.y = pk2(o[2] * sc, o[3] * sc); q.z = pk2(o[4] * sc, o[5] * sc); q.w = pk2(o[6] * sc, o[7] * sc);
            *(uint4*)(Qc + (size_t)(r0 + rr) * 768 + c) = q;
          } else {
            uint4 q; q.x = pk2(o[0], o[1]); q.y = pk2(o[2], o[3]); q.z = pk2(o[4], o[5]); q.w = pk2(o[6], o[7]);
            *(uint4*)(Kc + (size_t)(r0 + rr) * 768 + c - 768) = q;
#pragma unroll
            for (int e = 0; e < 8; ++e) tl[(cc + e) * LDT + rr] = f2bf(o[e]);
          }
        }
        __syncthreads();
        if (ct >= 6) {
#pragma unroll
          for (int i = 0; i < 4; ++i) {
            const int id = tid + 256 * i, cc = id >> 3, sc8 = (id & 7) * 8;
            const uint4 v = *(const uint4*)&tl[cc * LDT + sc8];
            *(uint4*)(KcT + (size_t)(b * 768 + (ct - 6) * 128 + cc) * S_ + s0 + sc8) = v;
          }
        }
      }
    } break;
    case 4: {
      const bf16_t* ZT = (const bf16_t*)(DO + DO_ZT);
      const int NF = 512 + 8;
      bf16_t* ApT = (bf16_t*)(DO + DO_F);
      const bf16_t* Vt = (const bf16_t*)(AR + A0_VT); const bf16_t* KcT = (const bf16_t*)(DO + DO_KCT); const bf16_t* Kc = (const bf16_t*)(AR + A0_KC);
      bf16_t* ST = (bf16_t*)(AR + A0_ST);
      for (int t = blockIdx.x; t < NF + 24 * NCH; t += gridDim.x) {
        if (t < 512) {
          const int mt = t & 1, ct = t >> 1;
          f32x4 acc[2][8]; zero_acc(acc);
          block_gemm<false>(acc, 4,
              [&](int row, int k) {
                const int p1 = mt * 64 + (row >> 1), op = row & 1, part = k >> 7, t1 = k & 127; float vv[8];
#pragma unroll
                for (int j = 0; j < 8; ++j) {
                  const float xx = (float)((p1 * (t1 + j)) & 127) * (1.f / 128.f);
                  const float cv = __builtin_amdgcn_cosf(xx), sv = __builtin_amdgcn_sinf(xx);
                  vv[j] = op == 0 ? (part == 0 ? cv : sv) : (part == 0 ? -sv : cv);
                }
                uint4 o; o.x = pk2(vv[0], vv[1]); o.y = pk2(vv[2], vv[3]); o.z = pk2(vv[4], vv[5]); o.w = pk2(vv[6], vv[7]); return o;
              },
              [&](int row, int k) {
                const int n = 2 * ct + (row >> 6), t2 = row & 63, part = k >> 7, t1 = k & 127;
                const bf16_t* src = ZT + (size_t)(n * 2 + part) * S_ + CTX + 64 * t1 + t2;
                unsigned e[8];
#pragma unroll
                for (int j = 0; j < 8; ++j) e[j] = src[64 * j];
                uint4 o; o.x = e[0] | (e[1] << 16); o.y = e[2] | (e[3] << 16); o.z = e[4] | (e[5] << 16); o.w = e[6] | (e[7] << 16); return o;
              }, smem, nullptr, 0);
#pragma unroll
          for (int mi = 0; mi < 2; ++mi) {
            const int row = 32 * w + 16 * mi + fr, p1 = mt * 64 + (row >> 1), op = row & 1;
#pragma unroll
            for (int ni = 0; ni < 8; ++ni) {
              const int col = 16 * ni + 4 * fq, n = 2 * ct + (col >> 6), t2 = col & 63;
              f32x4 v = acc[mi][ni], o;
#pragma unroll
              for (int j = 0; j < 4; ++j) {
                const float other = __shfl_xor(v[j], 1);
                const float xx = (float)((p1 * (t2 + j)) & 8191) * (1.f / 8192.f);
                const float cv = __builtin_amdgcn_cosf(xx), sv = __builtin_amdgcn_sinf(xx);
                o[j] = op == 0 ? (v[j] * cv + other * sv) : (v[j] * cv - other * sv);
              }
              store_bf16_row(ApT, 128, p1 * 512 + n, op * 64 + t2, o);
            }
          }
        } else if (t < NF) {
          const int tt = t - 512, mt = tt >> 2, nt = tt & 3;
          const int T = 256, tmask = T - 1;
          const float invT = 1.f / (float)T;
          f32x4 acc[2][8]; zero_acc(acc);
          block_gemm<false>(acc, 2 * T / 64,
              [&](int row, int k) {
                const int pp = mt * 128 + row, part = k >= T, t0 = k & tmask; float vv[8];
#pragma unroll
                for (int j = 0; j < 8; ++j) { const int mm = (pp * (t0 + j)) & tmask; const float xx = (float)mm * invT; vv[j] = part ? __builtin_amdgcn_sinf(xx) : __builtin_amdgcn_cosf(xx); }
                uint4 o; o.x = pk2(vv[0], vv[1]); o.y = pk2(vv[2], vv[3]); o.z = pk2(vv[4], vv[5]); o.w = pk2(vv[6], vv[7]); return o;
              },
              [&](int row, int k) { const int part = k >= T, t0 = k & tmask; return *(const uint4*)(ZT + (size_t)((nt * 128 + row) * 2 + part) * S_ + t0); },
              smem, nullptr, 0);
#pragma unroll
          for (int mi = 0; mi < 2; ++mi)
#pragma unroll
            for (int ni = 0; ni < 8; ++ni) {
              const int pp = mt * 128 + 32 * w + 16 * mi + fr, n = nt * 128 + 16 * ni + 4 * fq, b = n >> 8;
              f32x4 v = acc[mi][ni]; v *= (1.f / 128.f);
              store_bf16_row(Hb, LDH, b * S_ + pp, 768 + (n & 255), v);
            }
        } else {
          const int ta = t - NF, sd = ta / NCH, n = ta % NCH;
          const int dir = sd / 12, b = (sd / 6) & 1, h = sd % 6;
          const int r0 = b * S_ + n * 128;
          float* sW = sF;
          __syncthreads();
          if (w == 0) {
            const GateScan g = gate_scan(Gt, r0, dir, h, lane);
            sW[g.pos0] = __expf(g.a0 - g.amax); sW[g.pos1] = __expf(g.a1 - g.amax);
            if (lane == 0) { CS[(sd * NCH + n) * 4 + 0] = g.amax; CS[(sd * NCH + n) * 4 + 1] = g.F; }
          }
          __syncthreads();
          f32x4 acc[2][8]; zero_acc(acc);
          const bf16_t* Ab = Vt + (size_t)(b * 768 + h * 128) * S_ + n * 128;
          const bf16_t* Bb = KcT + (size_t)(b * 768 + h * 128) * S_ + n * 128;
          block_gemm<false>(acc, 2,
              [&](int row, int k) { return *(const uint4*)(Ab + (size_t)row * S_ + k); },
              [&](int row, int k) {
                const uint4 u = *(const uint4*)(Bb + (size_t)row * S_ + k);
                uint4 o;
                o.x = pk2(bflo(u.x) * sW[k], bfhi(u.x) * sW[k + 1]); o.y = pk2(bflo(u.y) * sW[k + 2], bfhi(u.y) * sW[k + 3]);
                o.z = pk2(bflo(u.z) * sW[k + 4], bfhi(u.z) * sW[k + 5]); o.w = pk2(bflo(u.w) * sW[k + 6], bfhi(u.w) * sW[k + 7]);
                return o;
              }, smem, nullptr, 0);
          bf16_t* Sd = ST + (size_t)(sd * NCH + n) * 16384;
#pragma unroll
          for (int mi = 0; mi < 2; ++mi)
#pragma unroll
            for (int ni = 0; ni < 8; ++ni) store_bf16_row(Sd, 128, 32 * w + 16 * mi + fr, 16 * ni + 4 * fq, acc[mi][ni]);
          if (tid < 128) {
            int tix = tid; asm volatile("" : "+v"(tix));
            const uint4* krow = (const uint4*)(KcT + (size_t)(b * 768 + h * 128 + tix) * S_ + n * 128);
            float a = 0.f;
#pragma unroll
            for (int c = 0; c < 16; ++c) {
              const uint4 u = krow[c]; const float* ww = sW + 8 * c;
              a += bflo(u.x) * ww[0] + bfhi(u.x) * ww[1] + bflo(u.y) * ww[2] + bfhi(u.y) * ww[3] + bflo(u.z) * ww[4] + bfhi(u.z) * ww[5] + bflo(u.w) * ww[6] + bfhi(u.w) * ww[7];
            }
            NV[(size_t)(sd * NCH + n) * 128 + tix] = a;
          }
        }
      }
    } break;
    case 5: {
      {
        const bf16_t* ApT = (const bf16_t*)(DO + DO_F);
        for (int t = blockIdx.x; t < 512; t += gridDim.x) {
          const int p1 = t >> 2, n0 = (t & 3) * 128;
          f32x4 acc[2][8]; zero_acc(acc);
          block_gemm<false>(acc, 2,
              [&](int row, int k) { return *(const uint4*)(ApT + (size_t)(t * 128 + row) * 128 + k); },
              [&](int row, int k) {
                uint4 o = {0u, 0u, 0u, 0u};
                if (row < 64) {
                  const int part = k >> 6, t2 = k & 63; float vv[8];
#pragma unroll
                  for (int j = 0; j < 8; ++j) { const float xx = (float)((row * (t2 + j)) & 63) * (1.f / 64.f); vv[j] = part ? __builtin_amdgcn_sinf(xx) : __builtin_amdgcn_cosf(xx); }
                  o.x = pk2(vv[0], vv[1]); o.y = pk2(vv[2], vv[3]); o.z = pk2(vv[4], vv[5]); o.w = pk2(vv[6], vv[7]);
                }
                return o;
              }, smem, nullptr, 0);
#pragma unroll
          for (int mi = 0; mi < 2; ++mi) {
            const int n = n0 + 32 * w + 16 * mi + fr, b = n >> 8;
#pragma unroll
            for (int ni = 0; ni < 4; ++ni)
#pragma unroll
              for (int j = 0; j < 4; ++j) {
                const int p2 = 16 * ni + 4 * fq + j;
                Hb[(size_t)(b * S_ + CTX + p1 + 128 * p2) * LDH + 768 + (n & 255)] = f2bf(acc[mi][ni][j] * 0.0013810679320049757f);
              }
          }
        }
      }
      if (gridDim.x >= 400) convert_weights(p, 1, smem, 200, gridDim.x - 200); else convert_weights(p, 1, smem, 0, gridDim.x);
      bf16_t* ST = (bf16_t*)(AR + A0_ST);
      for (int e = blockIdx.x * 256 + tid; e < 24 * 2064; e += gridDim.x * 256) {
        const int sd = e / 2064, idx = e % 2064, dir = sd / 12;
        float cst[8];
#pragma unroll
        for (int j = 0; j < 8; ++j) cst[j] = 0.f;
        float m = 0.f;
        uint4 ring0[4], ring1[4]; float ra[4], rf[4];
#define SC_FETCH(i_, u_) do { const int n_ = chunk_ord(dir, (i_)); ra[u_] = CS[(sd * NCH + n_) * 4 + 0]; rf[u_] = CS[(sd * NCH + n_) * 4 + 1]; \
          if (idx < 2048) ring0[u_] = *(const uint4*)(ST + (size_t)(sd * NCH + n_) * 16384 + idx * 8); \
          else { const uint4* q_ = (const uint4*)(NV + (size_t)(sd * NCH + n_) * 128 + (idx - 2048) * 8); ring0[u_] = q_[0]; ring1[u_] = q_[1]; } } while (0)
#pragma unroll
        for (int u = 0; u < 4; ++u) { ring1[u] = uint4{0u, 0u, 0u, 0u}; SC_FETCH(u, u); }
        for (int i0 = 0; i0 < NCH; i0 += 4) {
#pragma unroll
          for (int u = 0; u < 4; ++u) {
            const int i = i0 + u;
            if (i < NCH) {
              const int n = chunk_ord(dir, i);
              const float amax = ra[u], F = rf[u];
              const uint4 c0 = ring0[u], c1 = ring1[u];
              if (i + 4 < NCH) SC_FETCH(i + 4, u);
              const float Mx = fmaxf(m, amax), dcy = __expf(m - Mx), scl = __expf(amax - Mx);
              if (idx < 2048) {
                uint4* ptr = (uint4*)(ST + (size_t)(sd * NCH + n) * 16384 + idx * 8);
                uint4 o; o.x = pk2(cst[0], cst[1]); o.y = pk2(cst[2], cst[3]); o.z = pk2(cst[4], cst[5]); o.w = pk2(cst[6], cst[7]);
                *ptr = o;
                cst[0] = dcy * cst[0] + scl * bflo(c0.x); cst[1] = dcy * cst[1] + scl * bfhi(c0.x);
                cst[2] = dcy * cst[2] + scl * bflo(c0.y); cst[3] = dcy * cst[3] + scl * bfhi(c0.y);
                cst[4] = dcy * cst[4] + scl * bflo(c0.z); cst[5] = dcy * cst[5] + scl * bfhi(c0.z);
                cst[6] = dcy * cst[6] + scl * bflo(c0.w); cst[7] = dcy * cst[7] + scl * bfhi(c0.w);
              } else {
                uint4* ptr = (uint4*)(NV + (size_t)(sd * NCH + n) * 128 + (idx - 2048) * 8);
                uint4 o0, o1;
                o0.x = __float_as_uint(cst[0]); o0.y = __float_as_uint(cst[1]); o0.z = __float_as_uint(cst[2]); o0.w = __float_as_uint(cst[3]);
                o1.x = __float_as_uint(cst[4]); o1.y = __float_as_uint(cst[5]); o1.z = __float_as_uint(cst[6]); o1.w = __float_as_uint(cst[7]);
                ptr[0] = o0; ptr[1] = o1;
                cst[0] = dcy * cst[0] + scl * __uint_as_float(c0.x); cst[1] = dcy * cst[1] + scl * __uint_as_float(c0.y);
                cst[2] = dcy * cst[2] + scl * __uint_as_float(c0.z); cst[3] = dcy * cst[3] + scl * __uint_as_float(c0.w);
                cst[4] = dcy * cst[4] + scl * __uint_as_float(c1.x); cst[5] = dcy * cst[5] + scl * __uint_as_float(c1.y);
                cst[6] = dcy * cst[6] + scl * __uint_as_float(c1.z); cst[7] = dcy * cst[7] + scl * __uint_as_float(c1.w);
              }
              if (idx == 0) MS[sd * NCH + n] = m;
              m = F + Mx;
            }
          }
        }
#undef SC_FETCH
      }
    } break;
    case 6: {
      const bf16_t* Vt = (const bf16_t*)(AR + A0_VT); const bf16_t* Qc = (const bf16_t*)(AR + A0_QC); const bf16_t* Kc = (const bf16_t*)(AR + A0_KC);
      const bf16_t* ST = (const bf16_t*)(AR + A0_ST); const bf16_t* Ob = (const bf16_t*)(AR + A0_O);
      float* aA = sF; float* aM = sF + 256; float* aI = sF + 512; float* aE = sF + 768; float* sN = sF + 1024; float* sQN = sF + 1280; float* sSC = sF + 1536;
      for (int t = blockIdx.x; t < 12 * NCH; t += gridDim.x) {
        const int bh = t / NCH, n = t % NCH, b = bh / 6, h = bh % 6;
        const int r0 = b * S_ + n * 128;
        __syncthreads();
        if (w < 2) {
          const int dir = w, sd = (dir * 2 + b) * 6 + h;
          const GateScan g = gate_scan(Gt, r0, dir, h, lane);
          const float mp = MS[sd * NCH + n];
          const float M0 = fmaxf(mp, g.pm0), M1 = fmaxf(mp, g.pm1);
          aA[dir * 128 + g.pos0] = __expf(g.a0 - g.amax); aA[dir * 128 + g.pos1] = __expf(g.a1 - g.amax);
          aM[dir * 128 + g.pos0] = __expf(g.amax - M0); aM[dir * 128 + g.pos1] = __expf(g.amax - M1);
          aI[dir * 128 + g.pos0] = __expf(mp - M0); aI[dir * 128 + g.pos1] = __expf(mp - M1);
          aE[dir * 128 + g.pos0] = __expf(-(g.b0 + M0)); aE[dir * 128 + g.pos1] = __expf(-(g.b1 + M1));
        } else {
          const int dir = w - 2, sd = (dir * 2 + b) * 6 + h;
          sN[dir * 128 + lane] = NV[(size_t)(sd * NCH + n) * 128 + lane];
          sN[dir * 128 + 64 + lane] = NV[(size_t)(sd * NCH + n) * 128 + 64 + lane];
        }
        __syncthreads();
        const bf16_t* Qb = Qc + (size_t)r0 * 768 + h * 128;
        const bf16_t* Kb = Kc + (size_t)r0 * 768 + h * 128;
        {
          const int qr = tid >> 1, k0 = (tid & 1) * 64;
          float sf = 0.f, sb = 0.f;
#pragma unroll
          for (int c8 = 0; c8 < 8; ++c8) {
            const uint4 u = *(const uint4*)(Qb + (size_t)qr * 768 + k0 + c8 * 8);
            const float* nf = sN + k0 + c8 * 8; const float* nb = sN + 128 + k0 + c8 * 8;
            sf += bflo(u.x) * nf[0] + bfhi(u.x) * nf[1] + bflo(u.y) * nf[2] + bfhi(u.y) * nf[3] + bflo(u.z) * nf[4] + bfhi(u.z) * nf[5] + bflo(u.w) * nf[6] + bfhi(u.w) * nf[7];
            sb += bflo(u.x) * nb[0] + bfhi(u.x) * nb[1] + bflo(u.y) * nb[2] + bfhi(u.y) * nb[3] + bflo(u.z) * nb[4] + bfhi(u.z) * nb[5] + bflo(u.w) * nb[6] + bfhi(u.w) * nb[7];
          }
          sf += __shfl_xor(sf, 1); sb += __shfl_xor(sb, 1);
          if ((tid & 1) == 0) { sQN[qr] = sf; sQN[128 + qr] = sb; }
        }
        f32x4 acc[2][8]; zero_acc(acc);
        block_gemm<false>(acc, 2,
            [&](int row, int k) { return *(const uint4*)(Qb + (size_t)row * 768 + k); },
            [&](int row, int k) { return *(const uint4*)(Kb + (size_t)row * 768 + k); }, smem, nullptr, 0);
        __syncthreads();
        {
          float rsf[2] = {0.f, 0.f}, rsb[2] = {0.f, 0.f};
#pragma unroll
          for (int ni = 0; ni < 8; ++ni) {
            const int s0 = 16 * ni + 4 * fq;
            const f32x4 ef = *(const f32x4*)(aA + s0), eb = *(const f32x4*)(aA + 128 + s0);
#pragma unroll
            for (int mi = 0; mi < 2; ++mi) {
              const int tr = 32 * w + 16 * mi + fr;
#pragma unroll
              for (int j = 0; j < 4; ++j) {
                const float sv = acc[mi][ni][j];
                rsf[mi] += (s0 + j <= tr) ? sv * ef[j] : 0.f;
                rsb[mi] += (s0 + j >= tr) ? sv * eb[j] : 0.f;
              }
            }
          }
          float cf[2], cb[2];
#pragma unroll
          for (int mi = 0; mi < 2; ++mi) {
            const int tr = 32 * w + 16 * mi + fr;
            float a = rsf[mi], c2 = rsb[mi];
            a += __shfl_xor(a, 16); a += __shfl_xor(a, 32); c2 += __shfl_xor(c2, 16); c2 += __shfl_xor(c2, 32);
            const float denf = a * aM[tr] + aI[tr] * sQN[tr], denb = c2 * aM[128 + tr] + aI[128 + tr] * sQN[128 + tr];
            const float ddf = 1.f / fmaxf(fabsf(denf), aE[tr]), ddb = 1.f / fmaxf(fabsf(denb), aE[128 + tr]);
            if (fq == 0) { sSC[tr] = aI[tr] * ddf; sSC[128 + tr] = aI[128 + tr] * ddb; }
            cf[mi] = aM[tr] * ddf; cb[mi] = aM[128 + tr] * ddb;
          }
#pragma unroll
          for (int ni = 0; ni < 8; ++ni) {
            const int s0 = 16 * ni + 4 * fq;
            const f32x4 ef = *(const f32x4*)(aA + s0), eb = *(const f32x4*)(aA + 128 + s0);
#pragma unroll
            for (int mi = 0; mi < 2; ++mi) {
              const int tr = 32 * w + 16 * mi + fr;
              f32x4 pv;
#pragma unroll
              for (int j = 0; j < 4; ++j) {
                const float df = (s0 + j <= tr) ? ef[j] * cf[mi] : 0.f;
                const float db = (s0 + j >= tr) ? eb[j] * cb[mi] : 0.f;
                pv[j] = acc[mi][ni][j] * (df + db);
              }
              uint2 o; o.x = pk2(pv[0], pv[1]); o.y = pk2(pv[2], pv[3]);
              *(uint2*)&sP[tr * LDP + s0] = o;
            }
          }
        }
        __syncthreads();
        zero_acc(acc);
        {
          const bf16_t* Vb = Vt + (size_t)(b * 768 + h * 128) * S_ + n * 128;
          block_gemm<true>(acc, 2, [&](int, int) { return uint4{0u, 0u, 0u, 0u}; },
              [&](int row, int k) { return *(const uint4*)(Vb + (size_t)row * S_ + k); }, smem, sP, LDP);
        }
#pragma unroll
        for (int dir = 0; dir < 2; ++dir) {
          const int sd = (dir * 2 + b) * 6 + h;
          const bf16_t* Cb = ST + (size_t)(sd * NCH + n) * 16384;
          block_gemm<false>(acc, 2,
              [&](int row, int k) {
                const uint4 u = *(const uint4*)(Qb + (size_t)row * 768 + k);
                const float sc = sSC[dir * 128 + row];
                uint4 o; o.x = pk2(bflo(u.x) * sc, bfhi(u.x) * sc); o.y = pk2(bflo(u.y) * sc, bfhi(u.y) * sc);
                o.z = pk2(bflo(u.z) * sc, bfhi(u.z) * sc); o.w = pk2(bflo(u.w) * sc, bfhi(u.w) * sc); return o;
              },
              [&](int row, int k) { return *(const uint4*)(Cb + (size_t)row * 128 + k); }, smem, nullptr, 0);
        }
#pragma unroll
        for (int mi = 0; mi < 2; ++mi) {
          const int tr = 32 * w + 16 * mi + fr, row = r0 + tr;
          float ss = 0.f;
#pragma unroll
          for (int ni = 0; ni < 8; ++ni)
#pragma unroll
            for (int j = 0; j < 4; ++j) ss += acc[mi][ni][j] * acc[mi][ni][j];
          ss += __shfl_xor(ss, 16); ss += __shfl_xor(ss, 32);
          const float rstd = rsqrtf(ss * (1.f / 128.f) + EPS);
#pragma unroll
          for (int ni = 0; ni < 8; ++ni) {
            const int col = h * 128 + 16 * ni + 4 * fq;
            const f32x4 gg = *(const f32x4*)(p.g_head + col);
            const uint2 ou = *(const uint2*)(Ob + (size_t)row * 768 + col);
            f32x4 v;
            v[0] = acc[mi][ni][0] * rstd * gg[0] * sigmoidf_(bflo(ou.x)); v[1] = acc[mi][ni][1] * rstd * gg[1] * sigmoidf_(bfhi(ou.x));
            v[2] = acc[mi][ni][2] * rstd * gg[2] * sigmoidf_(bflo(ou.y)); v[3] = acc[mi][ni][3] * rstd * gg[3] * sigmoidf_(bfhi(ou.y));
            store_bf16_row(Hb, LDH, row, col, v);
          }
        }
      }
    } break;
    case 7: case 10: case 15: case 18: {
      const bool is_ff2 = (ph == 10 || ph == 18);
      const int layer = ph >= 15 ? 1 : 0;
      const bool from_input = (ph == 7);
      const bf16_t* A = is_ff2 ? (const bf16_t*)AR : Hb;
      const int K = is_ff2 ? DFF : D;
      const bf16_t* Bt = (const bf16_t*)((unsigned char*)WT + (is_ff2 ? WT_FF2 : WT_OUT));
      const int gidx = is_ff2 ? 5 : 2;
      auto epi = [&](f32x4 (&acc)[2][8], int mt, int nt) {
#pragma unroll
        for (int mi = 0; mi < 2; ++mi) {
          const int row = mt * 128 + 32 * w + 16 * mi + fr;
          const float* xs = xsrc_row(p, from_input, row);
          float* xd = xdst_row(p, row);
          const float* gate = mod_row(p, layer, row) + gidx * 1024;
#pragma unroll
          for (int ni = 0; ni < 8; ++ni) {
            const int col = nt * 128 + 16 * ni + 4 * fq;
            const f32x4 xv = *(const f32x4*)(xs + col), gv = *(const f32x4*)(gate + col);
            f32x4 o = xv + gv * acc[mi][ni];
            *(f32x4*)(xd + col) = o;
          }
        }
      };
      const int lda = is_ff2 ? LDHID : LDH;
      gemm_phase(A, lda, Bt, K, M / 128, 8, true, epi, smem);
      if (layer == 0) {
        const int ldb = K + 64, kper = K / 4;
        float* PART = (float*)(AR + A_PART);
        for (int u = blockIdx.x; u < 32 * 4; u += gridDim.x) {
          const int tile = u >> 2, ks = u & 3, mc = tile >> 3, nt = tile & 7, mt = (mc >> 1) * NCH + (mc & 1);
          f32x4 acc[2][8]; zero_acc(acc);
          block_gemm_glds(acc, kper / 64, A + (size_t)mt * 128 * lda + ks * kper, (size_t)lda, Bt + (size_t)nt * 128 * ldb + ks * kper, (size_t)ldb, smem);
#pragma unroll
          for (int mi = 0; mi < 2; ++mi) {
            const int row = mt * 128 + 32 * w + 16 * mi + fr, rc = (row / S_) * CTX + (row % S_);
            const float* gate = mod_row(p, layer, row) + gidx * 1024;
            float* pd = PART + ((size_t)ks * 512 + rc) * 1024;
#pragma unroll
            for (int ni = 0; ni < 8; ++ni) {
              const int col = nt * 128 + 16 * ni + 4 * fq;
              const f32x4 gv = *(const f32x4*)(gate + col);
              *(f32x4*)(pd + col) = gv * acc[mi][ni];
            }
          }
        }
      }
    } break;
    case 8: norm_phase(p, 0, 1, false, false, 1); break;
    case 9: case 17: {
      bf16_t* Hid = (bf16_t*)AR;
      auto epi = [&](f32x4 (&acc)[2][8], int mt, int nt) {
#pragma unroll
        for (int mi = 0; mi < 2; ++mi)
#pragma unroll
          for (int ni = 0; ni < 8; ++ni) {
            f32x4 v = acc[mi][ni];
#pragma unroll
            for (int j = 0; j < 4; ++j) { const float r = fmaxf(v[j], 0.f); v[j] = r * r; }
            store_bf16_row(Hid, LDHID, mt * 128 + 32 * w + 16 * mi + fr, nt * 128 + 16 * ni + 4 * fq, v);
          }
      };
      gemm_phase(Hb, LDH, (const bf16_t*)((unsigned char*)WT + WT_FF1), D, M / 128, 32, ph == 17, epi, smem);
    } break;
    case 11: {
      norm_phase(p, 1, 0, false, false, 2);
    } break;
    case 12: {
      bf16_t* Qb = (bf16_t*)(AR + A1_Q); bf16_t* Kb = (bf16_t*)(AR + A1_K); bf16_t* Vt = (bf16_t*)(AR + A1_VT); bf16_t* GL = (bf16_t*)(AR + A1_GLU);
      const float* cT = (const float*)(ws + OFF_ROPE); const float* sT = cT + 8192 * 32;
      auto epi = [&](f32x4 (&acc)[2][8], int mt, int nt) {
        const int b = mt / NCH;
        if (nt < 12) {
#pragma unroll
          for (int mi = 0; mi < 2; ++mi) {
            const int row = mt * 128 + 32 * w + 16 * mi + fr, s = row - b * S_;
            if (s >= CTX) {
              const int tpos = s - CTX;
#pragma unroll
              for (int g2 = 0; g2 < 2; ++g2)
#pragma unroll
                for (int nn = 0; nn < 2; ++nn) {
                  const int ni = g2 * 4 + nn, d0 = nn * 16 + 4 * fq;
                  const f32x4 cc = *(const f32x4*)(cT + tpos * 32 + d0), sn = *(const f32x4*)(sT + tpos * 32 + d0);
                  const f32x4 x1 = acc[mi][ni], x2 = acc[mi][ni + 2];
                  acc[mi][ni] = x1 * cc - x2 * sn; acc[mi][ni + 2] = x2 * cc + x1 * sn;
                }
            }
          }
        }
#pragma unroll
        for (int mi = 0; mi < 2; ++mi)
#pragma unroll
          for (int ni = 0; ni < 8; ++ni) {
            const int row = mt * 128 + 32 * w + 16 * mi + fr, col = nt * 128 + 16 * ni + 4 * fq;
            f32x4 v = acc[mi][ni];
            if (nt < 6) { v *= 0.18033688011112042f; store_bf16_row(Qb, 768, row, col, v); }
            else if (nt < 12) store_bf16_row(Kb, 768, row, col - 768, v);
            else if (nt < 18) store_bf16_T(Vt + (size_t)b * 768 * S_, col - 1536, row - b * S_, v);
            else store_bf16_row(GL, 512, row, col - 2304, v);
          }
      };
      gemm_phase(Hb, LDH, (const bf16_t*)((unsigned char*)WT + WT_IN), D, M / 128, 22, false, epi, smem);
    } break;
    case 13: {
      const bf16_t* Qb = (const bf16_t*)(AR + A1_Q); const bf16_t* Kb = (const bf16_t*)(AR + A1_K); const bf16_t* Vt = (const bf16_t*)(AR + A1_VT);
      bf16_t* OA = (bf16_t*)(AR + A1_OA);
      const int r = lane & 31, hh = lane >> 5;
      constexpr int STAGE = 24576, SV_OFF = 8192, NKT = S_ / 64;
      for (int t = blockIdx.x; t < NB * 6 * 2 * 64; t += gridDim.x) {
        const int qt = t & 63, mp = (t >> 6) & 1, bh = t >> 7, b = bh / 6, h = bh % 6;
        const int rq0 = b * S_ + CTX + qt * 128;
        const bf16_t* Qp = Qb + (size_t)rq0 * 768 + h * 128 + mp * 64;
        const bf16_t* Kp = Kb + (size_t)b * S_ * 768 + h * 128 + mp * 64;
        const bf16_t* Vp = Vt + (size_t)(b * 768 + h * 128) * S_;
        bf16x8 qf[4];
#pragma unroll
        for (int ks = 0; ks < 4; ++ks) qf[ks] = *(const bf16x8*)(Qp + (size_t)(32 * w + r) * 768 + 16 * ks + 8 * hh);
        f32x16 o[4];
#pragma unroll
        for (int db = 0; db < 4; ++db)
#pragma unroll
          for (int i = 0; i < 16; ++i) o[db][i] = 0.f;
        float mrun = -INFINITY, lrun = 0.f;
        LASG unsigned char* lb = (LASG unsigned char*)smem;
        const int g8 = lane >> 3, gp = lane & 7;
#define ATT_ISSUE(st_, kt_) do { \
          _Pragma("unroll") for (int i = 0; i < 2; ++i) { const int rho = 16 * w + 8 * i + g8, key_ = (rho & ~12) | ((rho & 4) << 1) | ((rho & 8) >> 1); \
            __builtin_amdgcn_global_load_lds((const unsigned*)(Kp + (size_t)((kt_) * 64 + key_) * 768 + ((gp ^ ((rho >> 1) & 7)) * 8)), (LASG unsigned*)(lb + (st_) * STAGE + (16 * w + 8 * i) * 128 + lane * 16), 16, 0, 0); } \
          _Pragma("unroll") for (int i = 0; i < 4; ++i) { const int rho = 32 * w + 8 * i + g8; \
            __builtin_amdgcn_global_load_lds((const unsigned*)(Vp + (size_t)rho * S_ + (kt_) * 64 + ((gp ^ ((rho >> 1) & 7)) * 8)), (LASG unsigned*)(lb + (st_) * STAGE + SV_OFF + (32 * w + 8 * i) * 128 + lane * 16), 16, 0, 0); } } while (0)
        const int rsw = (r >> 1) & 7;
        __syncthreads();
        ATT_ISSUE(0, 0);
        for (int kt = 0; kt < NKT; ++kt) {
          const int st = kt & 1;
          __syncthreads();
          if (kt + 1 < NKT) ATT_ISSUE(st ^ 1, kt + 1);
          const unsigned char* sK = smem + st * STAGE; const unsigned char* sV = sK + SV_OFF;
          f32x16 sx[2];
#pragma unroll
          for (int kb = 0; kb < 2; ++kb) {
#pragma unroll
            for (int i = 0; i < 16; ++i) sx[kb][i] = 0.f;
#pragma unroll
            for (int ks = 0; ks < 4; ++ks) {
              const bf16x8 kf = *(const bf16x8*)(sK + (32 * kb + r) * 128 + (((2 * ks + hh) ^ rsw) * 16));
              sx[kb] = __builtin_amdgcn_mfma_f32_32x32x16_bf16(kf, qf[ks], sx[kb], 0, 0, 0);
            }
          }
          float mx = sx[0][0];
#pragma unroll
          for (int i = 0; i < 16; ++i) { mx = fmaxf(mx, sx[0][i]); mx = fmaxf(mx, sx[1][i]); }
          mx = xor32_max(mx);
          const float mnew = fmaxf(mrun, mx), alpha = __builtin_amdgcn_exp2f(mrun - mnew);
          float rs = 0.f;
#pragma unroll
          for (int kb = 0; kb < 2; ++kb)
#pragma unroll
            for (int i = 0; i < 16; ++i) { const float pv = __builtin_amdgcn_exp2f(sx[kb][i] - mnew); sx[kb][i] = pv; rs += pv; }
          rs = xor32_sum(rs);
          lrun = lrun * alpha + rs; mrun = mnew;
          if (__any(alpha != 1.f)) {
#pragma unroll
            for (int db = 0; db < 4; ++db) o[db] *= alpha;
          }
#pragma unroll
          for (int kb = 0; kb < 2; ++kb)
#pragma unroll
            for (int s2 = 0; s2 < 2; ++s2) {
              uint4 xp;
              xp.x = pk2(sx[kb][8 * s2 + 0], sx[kb][8 * s2 + 1]); xp.y = pk2(sx[kb][8 * s2 + 2], sx[kb][8 * s2 + 3]);
              xp.z = pk2(sx[kb][8 * s2 + 4], sx[kb][8 * s2 + 5]); xp.w = pk2(sx[kb][8 * s2 + 6], sx[kb][8 * s2 + 7]);
              const bf16x8 xs = __builtin_bit_cast(bf16x8, xp);
#pragma unroll
              for (int db = 0; db < 4; ++db) {
                const bf16x8 pa = *(const bf16x8*)(sV + (32 * db + r) * 128 + (((4 * kb + 2 * s2 + hh) ^ rsw) * 16));
                o[db] = __builtin_amdgcn_mfma_f32_32x32x16_bf16(pa, xs, o[db], 0, 0, 0);
              }
            }
        }
#undef ATT_ISSUE
        bf16_t* Od = OA + (size_t)mp * M * 768 + (size_t)(rq0 + 32 * w + r) * 768 + h * 128;
        const float inv = 1.f / lrun;
#pragma unroll
        for (int db = 0; db < 4; ++db)
#pragma unroll
          for (int g = 0; g < 4; ++g) {
            uint2 ov; ov.x = pk2(o[db][4 * g] * inv, o[db][4 * g + 1] * inv); ov.y = pk2(o[db][4 * g + 2] * inv, o[db][4 * g + 3] * inv);
            *(uint2*)(Od + 32 * db + 8 * g + 4 * hh) = ov;
          }
      }
    } break;
    case 14: {
      const bf16_t* OA = (const bf16_t*)(AR + A1_OA); const bf16_t* GL = (const bf16_t*)(AR + A1_GLU);
      const float lam_init = 0.8f - 0.6f * 0.7408182206817179f;
      {
        float l1 = p.lam_p[lane] * p.lam_p[64 + lane], l2 = p.lam_p[128 + lane] * p.lam_p[192 + lane];
        l1 = wsum(l1); l2 = wsum(l2);
        const float lam = __expf(l1) - __expf(l2) + lam_init;
        const int gw = blockIdx.x * 4 + w, ngw = gridDim.x * 4;
        const int l16 = lane & 15, g4 = lane >> 4;
        const f32x4 gs0 = *(const f32x4*)(p.g_sub + 8 * l16), gs1 = *(const f32x4*)(p.g_sub + 8 * l16 + 4);
        for (int it = gw; it < NB * SEQ * 6 / 4; it += ngw) {
          const int item = it * 4 + g4, rl = item / 6, h = item - rl * 6;
          const int b = rl / SEQ, tpos = rl % SEQ, row = b * S_ + CTX + tpos;
          const uint4 u0 = *(const uint4*)(OA + (size_t)row * 768 + h * 128 + 8 * l16);
          const uint4 u1 = *(const uint4*)(OA + (size_t)M * 768 + (size_t)row * 768 + h * 128 + 8 * l16);
          float o[8];
          o[0] = bflo(u0.x) - lam * bflo(u1.x); o[1] = bfhi(u0.x) - lam * bfhi(u1.x); o[2] = bflo(u0.y) - lam * bflo(u1.y); o[3] = bfhi(u0.y) - lam * bfhi(u1.y);
          o[4] = bflo(u0.z) - lam * bflo(u1.z); o[5] = bfhi(u0.z) - lam * bfhi(u1.z); o[6] = bflo(u0.w) - lam * bflo(u1.w); o[7] = bfhi(u0.w) - lam * bfhi(u1.w);
          float ss = 0.f;
#pragma unroll
          for (int e = 0; e < 8; ++e) ss += o[e] * o[e];
          ss += __shfl_xor(ss, 1); ss += __shfl_xor(ss, 2); ss += __shfl_xor(ss, 4); ss += __shfl_xor(ss, 8);
          const float rstd = rsqrtf(ss * (1.f / 128.f) + EPS) * (1.f - lam_init);
          uint4 ov;
          ov.x = pk2(o[0] * rstd * gs0[0], o[1] * rstd * gs0[1]); ov.y = pk2(o[2] * rstd * gs0[2], o[3] * rstd * gs0[3]);
          ov.z = pk2(o[4] * rstd * gs1[0], o[5] * rstd * gs1[1]); ov.w = pk2(o[6] * rstd * gs1[2], o[7] * rstd * gs1[3]);
          *(uint4*)(Hb + (size_t)row * LDH + h * 128 + 8 * l16) = ov;
        }
      }
      {
        float* su = (float*)smem;
        for (int t = blockIdx.x; t < NB * SEQ / 32; t += gridDim.x) {
          const int b = t / (SEQ / 32), t0 = (t % (SEQ / 32)) * 32;
          __syncthreads();
          for (int i = tid; i < 62 * 64; i += 256) {
            const int rr = i >> 6, c4 = (i & 63) * 4, tp = t0 + rr - 15;
            f32x4 u = {0.f, 0.f, 0.f, 0.f};
            if (tp >= 0 && tp < SEQ) {
              const size_t ro = (size_t)(b * S_ + CTX + tp) * 512;
              const uint2 av = *(const uint2*)(GL + ro + c4), gv = *(const uint2*)(GL + ro + 256 + c4);
              u[0] = bflo(av.x) * sigmoidf_(bflo(gv.x)); u[1] = bfhi(av.x) * sigmoidf_(bfhi(gv.x));
              u[2] = bflo(av.y) * sigmoidf_(bflo(gv.y)); u[3] = bfhi(av.y) * sigmoidf_(bfhi(gv.y));
            }
            *(f32x4*)(su + rr * 256 + c4) = u;
          }
          __syncthreads();
          float z[32], wj[31];
#pragma unroll
          for (int tt = 0; tt < 32; ++tt) z[tt] = 0.f;
#pragma unroll
          for (int j = 0; j < 31; ++j) wj[j] = p.w_dw[j * 256 + tid];
#pragma unroll
          for (int rr = 0; rr < 62; ++rr) {
            const float u = su[rr * 256 + tid];
#pragma unroll
            for (int tt = 0; tt < 32; ++tt) { const int j = rr - tt; if (j >= 0 && j < 31) z[tt] += wj[j] * u; }
          }
          __syncthreads();
#pragma unroll
          for (int tt = 0; tt < 32; ++tt) su[tt * 256 + tid] = z[tt];
          __syncthreads();
          for (int tt = w; tt < 32; tt += 4) {
            f32x4 v = *(const f32x4*)(su + tt * 256 + 4 * lane);
            const float mu = wsum(v[0] + v[1] + v[2] + v[3]) * (1.f / 256.f);
            v -= mu;
            const float rstd = rsqrtf(wsum(v[0] * v[0] + v[1] * v[1] + v[2] * v[2] + v[3] * v[3]) * (1.f / 256.f) + EPS);
            const f32x4 gl = *(const f32x4*)(p.g_cln + 4 * lane), bl = *(const f32x4*)(p.b_cln + 4 * lane);
            float y[4];
#pragma unroll
            for (int e = 0; e < 4; ++e) y[e] = siluf_(v[e] * rstd * gl[e] + bl[e]);
            uint2 o; o.x = pk2(y[0], y[1]); o.y = pk2(y[2], y[3]);
            *(uint2*)(Hb + (size_t)(b * S_ + CTX + t0 + tt) * LDH + 768 + 4 * lane) = o;
          }
        }
      }
    } break;
    case 16: norm_phase(p, 1, 1, false, true); break;
    case 19: {
      const int gw = blockIdx.x * 4 + w, ngw = gridDim.x * 4;
      for (int r = gw; r < NB * SEQ; r += ngw) {
        f32x4* xr = (f32x4*)(p.out + (size_t)r * D) + lane;
        f32x4 v[4]; float ss = 0.f;
#pragma unroll
        for (int j = 0; j < 4; ++j) { v[j] = xr[64 * j]; ss += v[j][0] * v[j][0] + v[j][1] * v[j][1] + v[j][2] * v[j][2] + v[j][3] * v[j][3]; }
        const float rstd = rsqrtf(wsum(ss) * (1.f / D) + EPS);
#pragma unroll
        for (int j = 0; j < 4; ++j) { const f32x4 gg = *(const f32x4*)(p.g_final + 4 * lane + 256 * j); xr[64 * j] = v[j] * rstd * gg; }
      }
    } break;
    default: break;
    }
}

__global__ void __launch_bounds__(256, LB2) mega(Params p) {
  extern __shared__ __attribute__((aligned(16))) unsigned char smem[];
  {
    volatile LAS unsigned* st = (volatile LAS unsigned*)(smem + LDS_BYTES - 16);
    if (threadIdx.x == 0) { st[0] = 0u; st[1] = 0u; }
    __syncthreads();
  }
  if (p.ph_hi == 7777) cg::this_grid().sync();
  const XcdBarrier xb = xcd_barrier_post((unsigned*)(p.ws + OFF_BAR), (volatile LAS unsigned*)(smem + LDS_BYTES - 16));
#ifndef REP_PH
#define REP_PH -1
#endif
#define RUN(k) if (p.ph_lo <= k && k < p.ph_hi) { if (k > p.ph_lo) { xcd_barrier(xb); } run_phase<k>(p, smem); \
    if (k == REP_PH) { xcd_barrier(xb); run_phase<k>(p, smem); } }
  RUN(0) RUN(1) RUN(2) RUN(3) RUN(4) RUN(5) RUN(6) RUN(7) RUN(8) RUN(9) RUN(10) RUN(11) RUN(12) RUN(13) RUN(14) RUN(15) RUN(16) RUN(17) RUN(18) RUN(19)
#undef RUN
  if (p.ph_lo == 20) {
    const bf16_t* src = (const bf16_t*)(p.ws + DUMP_OFF);
    for (size_t i = (size_t)blockIdx.x * 256 + threadIdx.x; i < (size_t)NB * SEQ * D; i += (size_t)gridDim.x * 256) p.out[i] = bf2f(src[i]) + bf2f(((const bf16_t*)(p.ws + OFF_H))[i]);
  }
}

extern "C" void kernel_launch(void* const* d_in, const int* in_sizes, int n_in, void* d_out, int out_size, void* d_ws, size_t ws_size, hipStream_t stream) {
  static int grid_blocks = 0;
  if (!grid_blocks) {
    if (ws_size < WS_NEED) { fprintf(stderr, "kernel_launch: workspace too small: %zu < %zu\n", ws_size, (size_t)WS_NEED); grid_blocks = -1; return; }
    int dev = 0, cus = 0, per_cu = 0;
    hipGetDevice(&dev);
    hipDeviceGetAttribute(&cus, hipDeviceAttributeMultiprocessorCount, dev);
    hipFuncSetAttribute((const void*)mega, hipFuncAttributeMaxDynamicSharedMemorySize, LDS_BYTES);
    hipOccupancyMaxActiveBlocksPerMultiprocessor(&per_cu, (const void*)mega, 256, LDS_BYTES);
    if (per_cu < 1) per_cu = 1;
    if (per_cu > 2) per_cu = 2;
    grid_blocks = cus * per_cu;
    fprintf(stderr, "kernel_launch: cus %d per_cu %d grid %d ws %zu\n", cus, per_cu, grid_blocks, ws_size);
  }
  if (grid_blocks < 0) return;
  Params p{};
  const float** pp = (const float**)&p;
  for (int i = 0; i < 22; ++i) pp[i] = (const float*)d_in[i];
  p.out = (float*)d_out; p.ws = (unsigned char*)d_ws;
#if MULTI_LAUNCH
  for (int ph = 0; ph < NPH_RUN; ++ph) {
    p.ph_lo = ph; p.ph_hi = ph + 1;
    hipLaunchKernelGGL(mega, dim3(grid_blocks), dim3(256), LDS_BYTES, stream, p);
  }
#if NPH_RUN < 20
  p.ph_lo = 20; p.ph_hi = 21;
  hipLaunchKernelGGL(mega, dim3(grid_blocks), dim3(256), LDS_BYTES, stream, p);
#endif
#else
  hipMemsetAsync((unsigned char*)d_ws + OFF_BAR, 0, XCD_BAR_WORDS * 4, stream);
  p.ph_lo = 0; p.ph_hi = NPH;
  void* args[] = {&p};
  hipError_t e = hipLaunchCooperativeKernel((void*)mega, dim3(grid_blocks), dim3(256), args, LDS_BYTES, stream);
  if (e != hipSuccess) fprintf(stderr, "cooperative launch failed: %s (grid %d)\n", hipGetErrorString(e), grid_blocks);
#endif
}
```

```cpp
#include <hip/hip_runtime.h>
#include <hip/hip_cooperative_groups.h>
#include <cstdio>
#include <cstdint>
namespace cg = cooperative_groups;

#ifndef LB2
#define LB2 2
#endif
#ifndef NPH_RUN
#define NPH_RUN 20
#endif
#ifndef DUMP_OFF
#define DUMP_OFF (OFF_AR + A0_QK)
#endif
#ifndef MULTI_LAUNCH
#define MULTI_LAUNCH 0
#endif

typedef unsigned short bf16_t;
typedef short bf16x8 __attribute__((ext_vector_type(8)));
typedef float f32x4 __attribute__((ext_vector_type(4)));
typedef float f32x16 __attribute__((ext_vector_type(16)));
#define DEV __device__ __forceinline__

constexpr int D = 1024, NB = 2, SEQ = 8192, CTX = 256, S_ = SEQ + CTX, M = NB * S_, DFF = 4096;
constexpr int LDH = D + 64, LDHID = DFF + 64;
constexpr int NCH = S_ / 128;
constexpr int NPH = 20;
constexpr float EPS = 1e-6f;

constexpr size_t OFF_MOD = 0;
constexpr size_t MOD_BYTES = 2 * 3 * 6144 * 4;
constexpr size_t OFF_ROPE = 0x40000;
constexpr size_t OFF_XC = 0x240000;
constexpr size_t OFF_G = 0x440000;
constexpr size_t OFF_CS = 0x5D0000;
constexpr size_t OFF_MS = 0x5D8000;
constexpr size_t OFF_NV = 0x5DA000;
constexpr size_t OFF_WT = 0x700000;
constexpr size_t WT_IN = 0, WT_OUT = 0x770000, WT_FF1 = 0x990000, WT_FF2 = 0x1210000;
constexpr size_t OFF_H = 0x2200000;
constexpr size_t OFF_AR = 0x4510000;
constexpr size_t A0_QK = 0, A0_ST = 0, A0_VT = 0x3180000, A0_O = 0x4A40000, A0_QC = 0x6300000, A0_KC = 0x7BC0000;
constexpr size_t DO_KCT = 0, DO_ZT = 0x18C0000, DO_F = 0x2940000;
constexpr size_t A1_Q = 0, A1_K = 0x18C0000, A1_VT = 0x3180000, A1_GLU = 0x4A40000, A1_OA = 0x5AC0000;
constexpr size_t OFF_WT2 = OFF_AR + 0x9480000;
constexpr size_t WS_NEED = OFF_WT2 + 0x1A30000;

struct Params {
  const float *x, *c, *ctx, *c_ctx, *w_mod, *b_mod, *g_norm, *w_in_even, *b_gate, *w_qk_conv, *g_head, *w_out_even,
      *w_in_odd, *lam_p, *g_sub, *w_dw, *g_cln, *b_cln, *w_out_odd, *w_ff1, *w_ff2, *g_final;
  float* out;
  unsigned char* ws;
  int ph_lo, ph_hi;
};

typedef float f32x2 __attribute__((ext_vector_type(2)));
typedef __bf16 bf16x2_t __attribute__((ext_vector_type(2)));
DEV unsigned pk2(float lo, float hi) { f32x2 v = {lo, hi}; bf16x2_t b = __builtin_convertvector(v, bf16x2_t); return __builtin_bit_cast(unsigned, b); }
DEV bf16_t f2bf(float f) { return (bf16_t)(pk2(f, 0.f) & 0xffff); }
DEV float bf2f(unsigned h) { return __uint_as_float(h << 16); }
DEV float bflo(unsigned u) { return __uint_as_float(u << 16); }
DEV float bfhi(unsigned u) { return __uint_as_float(u & 0xffff0000u); }
DEV float wsum(float v) { for (int o = 32; o; o >>= 1) v += __shfl_xor(v, o); return v; }
DEV float xor32_max(float v) { auto r = __builtin_amdgcn_permlane32_swap(__float_as_uint(v), __float_as_uint(v), false, false); return fmaxf(__uint_as_float(r[0]), __uint_as_float(r[1])); }
DEV float xor32_sum(float v) { auto r = __builtin_amdgcn_permlane32_swap(__float_as_uint(v), __float_as_uint(v), false, false); return __uint_as_float(r[0]) + __uint_as_float(r[1]); }
DEV float sigmoidf_(float x) { return __builtin_amdgcn_rcpf(1.f + __expf(-x)); }
DEV float siluf_(float x) { return x * __builtin_amdgcn_rcpf(1.f + __expf(-x)); }
DEV float logsigf_(float x) { return fminf(x, 0.f) - log1pf(__expf(-fabsf(x))); }

constexpr int LDT = 72;
constexpr int LDP = 136;
constexpr int LDS_A = 0, LDS_B = 18432, LDS_P = 36864, LDS_F = 71680, LDS_BYTES = 79872;

template <bool A_LDS, class LA, class LB>
DEV void block_gemm(f32x4 (&acc)[2][8], int nk, LA la, LB lb, unsigned char* smem, const bf16_t* pA, int ldp) {
  bf16_t* sA = (bf16_t*)(smem + LDS_A);
  bf16_t* sB = (bf16_t*)(smem + LDS_B);
  const int tid = threadIdx.x, lane = tid & 63, w = tid >> 6;
  const int srow = tid >> 3, scol = (tid & 7) * 8;
  const int fr = lane & 15, fq = lane >> 4;
  uint4 ra[4], rb[4];
#pragma unroll
  for (int i = 0; i < 4; ++i) { if (!A_LDS) ra[i] = la(srow + 32 * i, scol); rb[i] = lb(srow + 32 * i, scol); }
  for (int kt = 0; kt < nk; ++kt) {
    __syncthreads();
#pragma unroll
    for (int i = 0; i < 4; ++i) {
      if (!A_LDS) *(uint4*)&sA[(srow + 32 * i) * LDT + scol] = ra[i];
      *(uint4*)&sB[(srow + 32 * i) * LDT + scol] = rb[i];
    }
    __syncthreads();
    if (kt + 1 < nk) {
#pragma unroll
      for (int i = 0; i < 4; ++i) { if (!A_LDS) ra[i] = la(srow + 32 * i, (kt + 1) * 64 + scol); rb[i] = lb(srow + 32 * i, (kt + 1) * 64 + scol); }
    }
#pragma unroll
    for (int kk = 0; kk < 2; ++kk) {
      bf16x8 af[2], bfr[8];
#pragma unroll
      for (int mi = 0; mi < 2; ++mi) {
        if (A_LDS) af[mi] = *(const bf16x8*)&pA[(32 * w + 16 * mi + fr) * ldp + kt * 64 + kk * 32 + 8 * fq];
        else af[mi] = *(const bf16x8*)&sA[(32 * w + 16 * mi + fr) * LDT + kk * 32 + 8 * fq];
      }
#pragma unroll
      for (int ni = 0; ni < 8; ++ni) bfr[ni] = *(const bf16x8*)&sB[(16 * ni + fr) * LDT + kk * 32 + 8 * fq];
#pragma unroll
      for (int mi = 0; mi < 2; ++mi)
#pragma unroll
        for (int ni = 0; ni < 8; ++ni) acc[mi][ni] = __builtin_amdgcn_mfma_f32_16x16x32_bf16(bfr[ni], af[mi], acc[mi][ni], 0, 0, 0);
    }
  }
}

DEV void zero_acc(f32x4 (&acc)[2][8]) {
#pragma unroll
  for (int mi = 0; mi < 2; ++mi)
#pragma unroll
    for (int ni = 0; ni < 8; ++ni) acc[mi][ni] = (f32x4){0.f, 0.f, 0.f, 0.f};
}

#define LASG __attribute__((address_space(3)))
DEV void block_gemm_glds(f32x4 (&acc)[2][8], int nk, const bf16_t* Ag, size_t lda, const bf16_t* Bg, size_t ldb, unsigned char* smem) {
  const int tid = threadIdx.x, lane = tid & 63, w = tid >> 6;
  const int srow = tid >> 3, sc = ((tid & 7) ^ (srow & 7)) * 8;
  const int fr = lane & 15, fq = lane >> 4;
  const bf16_t* ag = Ag + (size_t)srow * lda + sc;
  const bf16_t* bg = Bg + (size_t)(8 * ((srow >> 2) & 3) + 4 * (srow >> 4) + (srow & 3)) * ldb + sc;
  LASG unsigned char* lbase = (LASG unsigned char*)smem;
#define GLDS_ISSUE(st_, k0_) do { \
    _Pragma("unroll") for (int i = 0; i < 4; ++i) { \
      __builtin_amdgcn_global_load_lds((const unsigned*)(ag + (size_t)(32 * i) * lda + (k0_)), (LASG unsigned*)(lbase + (st_) * 32768 + (tid + 256 * i) * 16), 16, 0, 0); \
      __builtin_amdgcn_global_load_lds((const unsigned*)(bg + (size_t)(32 * i) * ldb + (k0_)), (LASG unsigned*)(lbase + (st_) * 32768 + 16384 + (tid + 256 * i) * 16), 16, 0, 0); } } while (0)
  __syncthreads();
  GLDS_ISSUE(0, 0);
  for (int kt = 0; kt < nk; ++kt) {
    __syncthreads();
    if (kt + 1 < nk) GLDS_ISSUE((kt + 1) & 1, (kt + 1) * 64);
    const unsigned char* sA = smem + (kt & 1) * 32768;
    const unsigned char* sB = sA + 16384;
#pragma unroll
    for (int kk = 0; kk < 2; ++kk) {
      const int swz = ((kk * 4 + fq) ^ (fr & 7)) * 16;
      bf16x8 af[2], bfr[8];
#pragma unroll
      for (int mi = 0; mi < 2; ++mi) af[mi] = *(const bf16x8*)(sA + (32 * w + 16 * mi + fr) * 128 + swz);
#pragma unroll
      for (int ni = 0; ni < 8; ++ni) bfr[ni] = *(const bf16x8*)(sB + (16 * ni + fr) * 128 + swz);
#pragma unroll
      for (int mi = 0; mi < 2; ++mi)
#pragma unroll
        for (int ni = 0; ni < 8; ++ni) acc[mi][ni] = __builtin_amdgcn_mfma_f32_16x16x32_bf16(bfr[ni], af[mi], acc[mi][ni], 0, 0, 0);
    }
  }
#undef GLDS_ISSUE
}

DEV void block_gemm_glds2(f32x4 (&acc0)[2][8], f32x4 (&acc1)[2][8], int nk, const bf16_t* Ag, size_t lda, const bf16_t* Bg, size_t ldb, unsigned char* smem) {
  const int tid = threadIdx.x, lane = tid & 63, w = tid >> 6;
  const int fr = lane & 15, fq = lane >> 4;
  const int lr = lane >> 2, lp = lane & 3;
  const int sc = (lp ^ ((0x78 >> (2 * ((lr >> 2) & 3))) & 3)) * 8;
  const bf16_t* ag = Ag + (size_t)(32 * w + lr) * lda + sc;
  const bf16_t* bg = Bg + (size_t)(64 * w + lr) * ldb + sc;
  LASG unsigned char* lbase = (LASG unsigned char*)smem;
#define G2_ISSUE(st_, k0_) do { \
    _Pragma("unroll") for (int i = 0; i < 2; ++i) \
      __builtin_amdgcn_global_load_lds((const unsigned*)(ag + (size_t)(16 * i) * lda + (k0_)), (LASG unsigned*)(lbase + (st_) * 24576 + (32 * w + 16 * i) * 64 + lane * 16), 16, 0, 0); \
    _Pragma("unroll") for (int i = 0; i < 4; ++i) \
      __builtin_amdgcn_global_load_lds((const unsigned*)(bg + (size_t)(16 * i) * ldb + (k0_)), (LASG unsigned*)(lbase + (st_) * 24576 + 8192 + (64 * w + 16 * i) * 64 + lane * 16), 16, 0, 0); } while (0)
  __syncthreads();
  G2_ISSUE(0, 0);
  if (nk > 1) G2_ISSUE(1, 32);
  const int roff = (fq ^ ((0x78 >> (2 * ((fr >> 2) & 3))) & 3)) * 16 + fr * 64;
  int st = 0;
  for (int kt = 0; kt < nk; ++kt) {
    if (kt + 1 < nk) asm volatile("s_waitcnt vmcnt(6)" ::: "memory"); else asm volatile("s_waitcnt vmcnt(0)" ::: "memory");
    __builtin_amdgcn_s_barrier();
    asm volatile("" ::: "memory");
    if (kt + 2 < nk) { const int st2 = st >= 1 ? st - 1 : 2; G2_ISSUE(st2, (kt + 2) * 32); }
    const unsigned char* sA = smem + st * 24576;
    const unsigned char* sB = sA + 8192;
    bf16x8 af[2];
#pragma unroll
    for (int mi = 0; mi < 2; ++mi) af[mi] = *(const bf16x8*)(sA + (32 * w + 16 * mi) * 64 + roff);
    {
      bf16x8 bfr[8];
#pragma unroll
      for (int ni = 0; ni < 8; ++ni) bfr[ni] = *(const bf16x8*)(sB + (16 * ni) * 64 + roff);
#pragma unroll
      for (int mi = 0; mi < 2; ++mi)
#pragma unroll
        for (int ni = 0; ni < 8; ++ni) acc0[mi][ni] = __builtin_amdgcn_mfma_f32_16x16x32_bf16(bfr[ni], af[mi], acc0[mi][ni], 0, 0, 0);
    }
    {
      bf16x8 bfr[8];
#pragma unroll
      for (int ni = 0; ni < 8; ++ni) bfr[ni] = *(const bf16x8*)(sB + (128 + 16 * ni) * 64 + roff);
#pragma unroll
      for (int mi = 0; mi < 2; ++mi)
#pragma unroll
        for (int ni = 0; ni < 8; ++ni) acc1[mi][ni] = __builtin_amdgcn_mfma_f32_16x16x32_bf16(bfr[ni], af[mi], acc1[mi][ni], 0, 0, 0);
    }
    st = st == 2 ? 0 : st + 1;
  }
#undef G2_ISSUE
}

constexpr size_t OFF_BAR = 0x28000;
#define XB_TMO      128
#define XB_XCNT(j)  (256  + 64 * (j))
#define XB_XSUB(j)  (1280 + 64 * (j))
#define XB_XGEN(j)  (2304 + 64 * (j))
#define XB_TOP      3328
#define XB_TOPGEN   3392
#define XCD_BAR_WORDS 3456
#define XB_SPIN_CAP (1u << 18)
#define LAS __attribute__((address_space(3)))

__device__ __forceinline__ unsigned xb_ld(unsigned* p)              { return __hip_atomic_load(p, __ATOMIC_RELAXED, __HIP_MEMORY_SCOPE_AGENT); }
__device__ __forceinline__ unsigned xb_add(unsigned* p, unsigned v) { return __hip_atomic_fetch_add(p, v, __ATOMIC_RELAXED, __HIP_MEMORY_SCOPE_AGENT); }
__device__ __forceinline__ unsigned xb_xcc_id() { return (unsigned)__builtin_amdgcn_s_getreg((3 << 11) | 20) & 0xFu; }
#define XB_SPIN(cond, bar) do { unsigned _sp = 0; while (cond) { __builtin_amdgcn_s_sleep(1); \
    if ((++_sp & 255u) == 0u) { if (xb_ld(&(bar)[XB_TMO])) break; if (_sp > XB_SPIN_CAP) { atomicAdd(&(bar)[XB_TMO], 1u); break; } } } } while (0)

struct XcdBarrier {
    unsigned* bar; unsigned x;
    volatile LAS unsigned* st;
};

__device__ __forceinline__ XcdBarrier xcd_barrier_post(unsigned* bar, volatile LAS unsigned* st) {
    XcdBarrier b; b.bar = bar; b.x = xb_xcc_id(); b.st = st;
    if (threadIdx.x == 0) (void)xb_add(&bar[XB_XCNT(b.x)], 1u);
    return b;
}
__device__ __forceinline__ void xcd_barrier_complete(unsigned* bar, unsigned x, unsigned& nloc, unsigned& nx) {
    const unsigned G = gridDim.x * gridDim.y * gridDim.z;
    unsigned sum, cnt, mine, sp = 0u;
    for (;;) {
        sum = 0u; cnt = 0u; mine = 0u;
#pragma unroll
        for (unsigned j = 0; j < 16; ++j) { const unsigned c = xb_ld(&bar[XB_XCNT(j)]); sum += c; cnt += (c > 0u) ? 1u : 0u; mine = (j == x) ? c : mine; }
        if (sum == G) break;
        __builtin_amdgcn_s_sleep(1);
        if ((++sp & 255u) == 0u) { if (xb_ld(&bar[XB_TMO])) break; if (sp > XB_SPIN_CAP) { atomicAdd(&bar[XB_TMO], 1u); break; } }
    }
    nloc = mine > 0u ? mine : 1u; nx = cnt > 0u ? cnt : 1u;
}

__device__ __forceinline__ void xcd_barrier(const XcdBarrier& b) {
    asm volatile("s_waitcnt vmcnt(0)" ::: "memory");
    __syncthreads();
    if (threadIdx.x == 0) {
        unsigned* bar = b.bar;
        __builtin_amdgcn_s_waitcnt(0);
        unsigned nloc = b.st[0], nx = b.st[1];
        if (nloc == 0u) { xcd_barrier_complete(bar, b.x, nloc, nx); b.st[0] = nloc; b.st[1] = nx; }
        const unsigned old = xb_add(&bar[XB_XSUB(b.x)], 1u);
        const unsigned gen = old / nloc;
        if (old + 1u == (gen + 1u) * nloc) {
            __builtin_amdgcn_fence(__ATOMIC_RELEASE, "agent");
            asm volatile("s_waitcnt vmcnt(0)" ::: "memory");
            const unsigned og = xb_add(&bar[XB_TOP], 1u);
            const unsigned tg = og / nx;
            if (og + 1u == (tg + 1u) * nx) xb_add(&bar[XB_TOPGEN], 1u);
            else XB_SPIN(xb_ld(&bar[XB_TOPGEN]) == tg, bar);
            __builtin_amdgcn_fence(__ATOMIC_ACQUIRE, "agent");
            xb_add(&bar[XB_XGEN(b.x)], 1u);
            asm volatile("s_waitcnt vmcnt(0)" ::: "memory");
        } else {
            XB_SPIN(xb_ld(&bar[XB_XGEN(b.x)]) == gen, bar);
            __builtin_amdgcn_fence(__ATOMIC_ACQUIRE, "agent");
            asm volatile("s_waitcnt vmcnt(0)" ::: "memory");
        }
    }
    __syncthreads();
}

DEV const float* xsrc_row(const Params& p, bool from_input, int r) {
  const int b = r / S_, s = r - b * S_;
  if (from_input) return s < CTX ? p.ctx + (size_t)(b * CTX + s) * D : p.x + (size_t)(b * SEQ + s - CTX) * D;
  return s < CTX ? (const float*)(p.ws + OFF_XC) + (size_t)(b * CTX + s) * D : p.out + (size_t)(b * SEQ + s - CTX) * D;
}
DEV float* xdst_row(const Params& p, int r) {
  const int b = r / S_, s = r - b * S_;
  return s < CTX ? (float*)(p.ws + OFF_XC) + (size_t)(b * CTX + s) * D : p.out + (size_t)(b * SEQ + s - CTX) * D;
}
DEV const float* mod_row(const Params& p, int layer, int r) {
  const int b = r / S_, s = r - b * S_;
  return (const float*)(p.ws + OFF_MOD) + (size_t)(layer * 3 + (s < CTX ? 2 : b)) * 6144;
}

DEV void transpose_tile(const float* W, int K, int N, bf16_t* WT, int remap, int kt, int nt, unsigned char* smem) {
  float* tile = (float*)smem;
  const int tid = threadIdx.x;
  __syncthreads();
#pragma unroll
  for (int i = 0; i < 4; ++i) {
    const int kk = (tid >> 4) + 16 * i, c4 = (tid & 15) * 4;
    const int n = nt * 64 + c4;
    int src = n;
    if (remap) src = n < 3072 ? n : (n < 3328 ? n + 24 : (n < 3352 ? n - 256 : -1));
    else if (n >= N) src = -1;
    f32x4 v = (f32x4){0.f, 0.f, 0.f, 0.f};
    if (src >= 0) v = *(const f32x4*)(W + (size_t)(kt * 64 + kk) * N + src);
    tile[kk * 65 + c4 + 0] = v[0]; tile[kk * 65 + c4 + 1] = v[1]; tile[kk * 65 + c4 + 2] = v[2]; tile[kk * 65 + c4 + 3] = v[3];
  }
  __syncthreads();
  const int n = tid >> 2, kc = (tid & 3) * 16;
  uint4 o0, o1;
  const float* t = tile + kc * 65 + n;
  o0.x = pk2(t[0 * 65], t[1 * 65]); o0.y = pk2(t[2 * 65], t[3 * 65]); o0.z = pk2(t[4 * 65], t[5 * 65]); o0.w = pk2(t[6 * 65], t[7 * 65]);
  o1.x = pk2(t[8 * 65], t[9 * 65]); o1.y = pk2(t[10 * 65], t[11 * 65]); o1.z = pk2(t[12 * 65], t[13 * 65]); o1.w = pk2(t[14 * 65], t[15 * 65]);
  bf16_t* dst = WT + (size_t)(nt * 64 + n) * (K + 64) + kt * 64 + kc;
  *(uint4*)dst = o0; *(uint4*)(dst + 8) = o1;
}
DEV void transpose_mat(const float* Wm, int K, int N, int Npad, bf16_t* dst, int remap, unsigned char* smem, int b0, int nb) {
  const int nkt = K / 64, nnt = Npad / 64;
  if ((int)blockIdx.x < b0) return;
  for (int t = blockIdx.x - b0; t < nkt * nnt; t += nb) transpose_tile(Wm, K, N, dst, remap, t / nnt, t % nnt, smem);
}
DEV void convert_weights(const Params& p, int part, unsigned char* smem, int b0, int nb) {
  unsigned char* wt = p.ws + OFF_WT; unsigned char* wt2 = p.ws + OFF_WT2;
  if (part == 0) { transpose_mat(p.w_in_even, 1024, 3352, 3584, (bf16_t*)(wt + WT_IN), 1, smem, b0, nb); return; }
  transpose_mat(p.w_out_even, 1024, 1024, 1024, (bf16_t*)(wt + WT_OUT), 0, smem, b0, nb);
  transpose_mat(p.w_ff1, 1024, 4096, 4096, (bf16_t*)(wt + WT_FF1), 0, smem, b0, nb);
  transpose_mat(p.w_ff2, 4096, 1024, 1024, (bf16_t*)(wt + WT_FF2), 0, smem, b0, nb);
  transpose_mat(p.w_in_odd, 1024, 2816, 2816, (bf16_t*)(wt2 + WT_IN), 0, smem, b0, nb);
  transpose_mat(p.w_out_odd, 1024, 1024, 1024, (bf16_t*)(wt2 + WT_OUT), 0, smem, b0, nb);
  transpose_mat(p.w_ff1 + (size_t)1024 * 4096, 1024, 4096, 4096, (bf16_t*)(wt2 + WT_FF1), 0, smem, b0, nb);
  transpose_mat(p.w_ff2 + (size_t)1024 * 4096, 4096, 1024, 1024, (bf16_t*)(wt2 + WT_FF2), 0, smem, b0, nb);
}

DEV void mod_phase(const Params& p, unsigned char* smem) {
  float* MOD = (float*)(p.ws + OFF_MOD);
  float* sS = (float*)smem;
  float* red = sS + 3072;
  const int tid = threadIdx.x, cl = tid & 31, kg = tid >> 5;
  if ((int)blockIdx.x >= 2 * 192) return;
  __syncthreads();
  for (int i = tid; i < 3072; i += 256) { const int v = i >> 10, k = i & 1023; sS[i] = siluf_(v == 0 ? p.c[k] : (v == 1 ? p.c[1024 + k] : p.c_ctx[k])); }
  __syncthreads();
  for (int it = blockIdx.x; it < 2 * 192; it += gridDim.x) {
    const int l = it / 192, n = (it % 192) * 32 + cl;
    const float* W = p.w_mod + (size_t)l * 1024 * 6144 + n;
    float a0 = 0.f, a1 = 0.f, a2 = 0.f;
#pragma unroll 16
    for (int k = kg * 128; k < kg * 128 + 128; ++k) {
      const float wv = W[(size_t)k * 6144];
      a0 += sS[k] * wv; a1 += sS[1024 + k] * wv; a2 += sS[2048 + k] * wv;
    }
    __syncthreads();
    red[(kg * 32 + cl) * 3 + 0] = a0; red[(kg * 32 + cl) * 3 + 1] = a1; red[(kg * 32 + cl) * 3 + 2] = a2;
    __syncthreads();
    if (kg == 0) {
      const float bv = p.b_mod[l * 6144 + n];
#pragma unroll
      for (int v = 0; v < 3; ++v) {
        float sacc = 0.f;
#pragma unroll
        for (int g2 = 0; g2 < 8; ++g2) sacc += red[(g2 * 32 + cl) * 3 + v];
        MOD[(l * 3 + v) * 6144 + n] = sacc + bv;
      }
    }
  }
}
DEV void rope_phase(const Params& p) {
  float* ct = (float*)(p.ws + OFF_ROPE);
  float* st = ct + 8192 * 32;
  for (int i = blockIdx.x * 256 + threadIdx.x; i < 8192 * 32; i += gridDim.x * 256) {
    const int t = i >> 5, d = i & 31;
    const float pos = (d < 16) ? (float)(t >> 6) : (float)(t & 63);
    const float inv = powf(10000.f, -(float)(d & 15) / 16.f);
    const float ang = pos * inv;
    ct[i] = cosf(ang); st[i] = sinf(ang);
  }
}

constexpr size_t A_PART = 0x8700000;
DEV void norm_phase(const Params& p, int layer, int which, bool from_input, bool skip_ctx, int ctx_fix = 0) {
  const int lane = threadIdx.x & 63;
  const int gw = blockIdx.x * 4 + (threadIdx.x >> 6), ngw = gridDim.x * 4;
  const float* g = p.g_norm + (layer * 2 + which) * D;
  bf16_t* H = (bf16_t*)(p.ws + OFF_H);
  for (int r = gw; r < M; r += ngw) {
    const int s = r % S_;
    if (skip_ctx && s < CTX) continue;
    const bool fix = ctx_fix && s < CTX;
    const f32x4* xr = (const f32x4*)xsrc_row(p, fix ? (ctx_fix == 1) : from_input, r) + lane;
    const float* mv = mod_row(p, layer, r) + which * 3 * 1024;
    f32x4 v[4]; float ss = 0.f;
#pragma unroll
    for (int j = 0; j < 4; ++j) v[j] = xr[64 * j];
    if (fix) {
      const int rc = (r / S_) * CTX + s;
      const f32x4* pp = (const f32x4*)(p.ws + OFF_AR + A_PART) + (size_t)rc * 256 + lane;
      f32x4* xw = (f32x4*)xdst_row(p, r) + lane;
#pragma unroll
      for (int j = 0; j < 4; ++j) {
        v[j] += (pp[64 * j] + pp[(size_t)512 * 256 + 64 * j]) + (pp[(size_t)2 * 512 * 256 + 64 * j] + pp[(size_t)3 * 512 * 256 + 64 * j]);
        xw[64 * j] = v[j];
      }
    }
#pragma unroll
    for (int j = 0; j < 4; ++j) ss += v[j][0] * v[j][0] + v[j][1] * v[j][1] + v[j][2] * v[j][2] + v[j][3] * v[j][3];
    const float rstd = rsqrtf(wsum(ss) * (1.f / D) + EPS);
    uint2* o = (uint2*)(H + (size_t)r * LDH) + lane;
#pragma unroll
    for (int j = 0; j < 4; ++j) {
      const int c = 4 * lane + 256 * j;
      const f32x4 gg = *(const f32x4*)(g + c), sh = *(const f32x4*)(mv + c), sc = *(const f32x4*)(mv + 1024 + c);
      float y[4];
#pragma unroll
      for (int e = 0; e < 4; ++e) y[e] = v[j][e] * rstd * gg[e] * (1.f + sc[e]) + sh[e];
      uint2 w2; w2.x = pk2(y[0], y[1]); w2.y = pk2(y[2], y[3]);
      o[64 * j] = w2;
    }
  }
}

template <class Epi>
DEV void gemm_phase(const bf16_t* A, int lda, const bf16_t* Bt, int K, int MT, int NT, bool skip_ctx, Epi epi, unsigned char* smem) {
  const int ldb = K + 64;
  const int MTv = skip_ctx ? MT - 2 * NB : MT;
  const int nwg = MTv * NT;
  for (int t = blockIdx.x; t < nwg; t += gridDim.x) {
    int wgid = t;
    { const int q = nwg / 8, r8 = nwg % 8, xcd = wgid % 8, off = wgid / 8; wgid = (xcd < r8 ? xcd * (q + 1) : r8 * (q + 1) + (xcd - r8) * q) + off; }
    const int nig = 8 * NT, gid = wgid / nig, fm = gid * 8, gsz = (MTv - fm) < 8 ? (MTv - fm) : 8;
    int mt = fm + (wgid % nig) % gsz; const int nt = (wgid % nig) / gsz;
    if (skip_ctx) mt = (mt / (NCH - 2)) * NCH + 2 + (mt % (NCH - 2));
    f32x4 acc[2][8]; zero_acc(acc);
    const bf16_t* Ab = A + (size_t)mt * 128 * lda;
    const bf16_t* Bb = Bt + (size_t)nt * 128 * ldb;
    block_gemm_glds(acc, K / 64, Ab, (size_t)lda, Bb, (size_t)ldb, smem);
    epi(acc, mt, nt);
  }
}

template <class Epi>
DEV void gemm_phase2(const bf16_t* A, int lda, const bf16_t* Bt, int K, int MT, int NP, bool skip_ctx, Epi epi, unsigned char* smem) {
  const int ldb = K + 64;
  const int MTv = skip_ctx ? MT - 2 * NB : MT;
  for (int t = blockIdx.x; t < MTv * NP; t += gridDim.x) {
    int mt = t / NP; const int np = t % NP;
    if (skip_ctx) mt = (mt / (NCH - 2)) * NCH + 2 + (mt % (NCH - 2));
    f32x4 acc0[2][8], acc1[2][8]; zero_acc(acc0); zero_acc(acc1);
    block_gemm_glds2(acc0, acc1, K / 32, A + (size_t)mt * 128 * lda, (size_t)lda, Bt + (size_t)np * 256 * ldb, (size_t)ldb, smem);
    epi(acc0, mt, 2 * np);
    epi(acc1, mt, 2 * np + 1);
  }
}

#define ECOL(ni_) (32 * ((ni_) >> 1) + 8 * fq + 4 * ((ni_) & 1))
#define EPI_COORDS const int lane = threadIdx.x & 63, w = threadIdx.x >> 6, fr = lane & 15, fq = lane >> 4; (void)w; (void)fr; (void)fq;

DEV void store_bf16_row(bf16_t* base, size_t ld, int row, int col, const f32x4& v) {
  uint2 o; o.x = pk2(v[0], v[1]); o.y = pk2(v[2], v[3]);
  *(uint2*)(base + (size_t)row * ld + col) = o;
}
DEV void store_bf16_T(bf16_t* base, int col, int s, const f32x4& v) {
#pragma unroll
  for (int j = 0; j < 4; ++j) base[(size_t)(col + j) * S_ + s] = f2bf(v[j]);
}

struct GateScan { float a0, a1, b0, b1, pm0, pm1, F, amax; int pos0, pos1; };
DEV GateScan gate_scan(const float* G, const int r0, const int dir, const int h, const int lane) {
  GateScan g;
  const int j0 = 2 * lane, j1 = j0 + 1;
  g.pos0 = dir ? 127 - j0 : j0; g.pos1 = dir ? 127 - j1 : j1;
  const float i0 = G[(size_t)(r0 + g.pos0) * 24 + (dir * 2) * 6 + h], f0 = G[(size_t)(r0 + g.pos0) * 24 + (dir * 2 + 1) * 6 + h];
  const float i1 = G[(size_t)(r0 + g.pos1) * 24 + (dir * 2) * 6 + h], f1 = G[(size_t)(r0 + g.pos1) * 24 + (dir * 2 + 1) * 6 + h];
  const float lf0 = logsigf_(f0), lf1 = logsigf_(f1);
  const float s0 = lf0, s1 = lf0 + lf1;
  float tot = s1;
#pragma unroll
  for (int d = 1; d < 64; d <<= 1) { const float y = __shfl_up(tot, d); if (lane >= d) tot += y; }
  const float excl = tot - s1;
  g.b0 = s0 + excl; g.b1 = s1 + excl;
  g.F = __shfl(tot, 63);
  g.a0 = i0 - g.b0; g.a1 = i1 - g.b1;
  const float q0 = g.a0, q1 = fmaxf(g.a0, g.a1);
  float t = q1;
#pragma unroll
  for (int d = 1; d < 64; d <<= 1) { const float y = __shfl_up(t, d); if (lane >= d) t = fmaxf(t, y); }
  float ex = __shfl_up(t, 1); if (lane == 0) ex = -INFINITY;
  g.pm0 = fmaxf(q0, ex); g.pm1 = fmaxf(q1, ex);
  g.amax = __shfl(t, 63);
  return g;
}
DEV int chunk_ord(int dir, int i) { return dir == 0 ? i : (i < 2 ? 1 - i : 67 - i); }

template <int ph>
DEV void run_phase(const Params& p, unsigned char* smem) {
  const int tid = threadIdx.x, lane = tid & 63, w = tid >> 6, fr = lane & 15, fq = lane >> 4;
  unsigned char* ws = p.ws;
  bf16_t* const WT = (bf16_t*)(ws + (ph >= 11 ? OFF_WT2 : OFF_WT));
  bf16_t* const Hb = (bf16_t*)(ws + OFF_H);
  float* const Gt = (float*)(ws + OFF_G);
  float* const CS = (float*)(ws + OFF_CS);
  float* const MS = (float*)(ws + OFF_MS);
  float* const NV = (float*)(ws + OFF_NV);
  unsigned char* const AR = ws + OFF_AR;
  unsigned char* const DO = (unsigned char*)p.out;
  float* const sF = (float*)(smem + LDS_F);
  bf16_t* const sP = (bf16_t*)(smem + LDS_P);

    switch (ph) {
    case 0: {
      convert_weights(p, 0, smem, 0, gridDim.x);
      mod_phase(p, smem);
      rope_phase(p);
    } break;
    case 1: norm_phase(p, 0, 0, true, false); break;
    case 2: {
      bf16_t* QK = (bf16_t*)(AR + A0_QK); bf16_t* Vt = (bf16_t*)(AR + A0_VT); bf16_t* Ob = (bf16_t*)(AR + A0_O); bf16_t* Fb = (bf16_t*)(DO + DO_F);
      const float* bg = p.b_gate;
      auto epi = [&](f32x4 (&acc)[2][8], int mt, int nt) {
        const int b = mt / NCH;
        const int row0 = mt * 128 + 32 * w + fr, col0 = nt * 128 + 8 * fq;
        if (nt < 12 || (nt >= 18 && nt < 26)) {
          bf16_t* tb; int ld;
          if (nt < 12) { tb = QK + (size_t)row0 * 1536 + col0; ld = 1536; }
          else if (nt < 24) { tb = Ob + (size_t)row0 * 768 + (col0 - 2304); ld = 768; }
          else { tb = Fb + (size_t)row0 * 256 + (col0 - 3072); ld = 256; }
#pragma unroll
          for (int mi = 0; mi < 2; ++mi)
#pragma unroll
            for (int pq = 0; pq < 4; ++pq) {
              uint4 o; o.x = pk2(acc[mi][2 * pq][0], acc[mi][2 * pq][1]); o.y = pk2(acc[mi][2 * pq][2], acc[mi][2 * pq][3]);
              o.z = pk2(acc[mi][2 * pq + 1][0], acc[mi][2 * pq + 1][1]); o.w = pk2(acc[mi][2 * pq + 1][2], acc[mi][2 * pq + 1][3]);
              *(uint4*)(tb + (size_t)(16 * mi) * ld + 32 * pq) = o;
            }
        } else if (nt < 18) {
          bf16_t* tb = Vt + (size_t)b * 768 * S_ + (size_t)(col0 - 1536) * S_ + (row0 - b * S_);
#pragma unroll
          for (int mi = 0; mi < 2; ++mi)
#pragma unroll
            for (int ni = 0; ni < 8; ++ni)
#pragma unroll
              for (int j = 0; j < 4; ++j) tb[(size_t)(32 * (ni >> 1) + 4 * (ni & 1) + j) * S_ + 16 * mi] = f2bf(acc[mi][ni][j]);
        } else if (nt == 26) {
#pragma unroll
          for (int mi = 0; mi < 2; ++mi)
#pragma unroll
            for (int ni = 0; ni < 2; ++ni) {
              const int gc = ECOL(ni);
              if (gc < 24) { f32x4 o = acc[mi][ni]; o += *(const f32x4*)(bg + gc); *(f32x4*)(Gt + (size_t)(row0 + 16 * mi) * 24 + gc) = o; }
            }
        }
      };
      gemm_phase(Hb, LDH, (const bf16_t*)((unsigned char*)WT + WT_IN), D, M / 128, 27, false, epi, smem);
    } break;
    case 3: {
      const bf16_t* QK = (const bf16_t*)(AR + A0_QK);
      bf16_t* Qc = (bf16_t*)(AR + A0_QC); bf16_t* Kc = (bf16_t*)(AR + A0_KC); bf16_t* KcT = (bf16_t*)(DO + DO_KCT);
      bf16_t* ZT = (bf16_t*)(DO + DO_ZT); const bf16_t* Fb = (const bf16_t*)(DO + DO_F);
      for (int t = blockIdx.x; t < (M / 128) * 4; t += gridDim.x) {
        const int mt = t >> 2, g = t & 3;
        f32x4 acc[2][8]; zero_acc(acc);
        block_gemm<false>(acc, 1,
            [&](int row, int k) {
              const int cp = row & 63, im = row >> 6; float vv[8];
#pragma unroll
              for (int j = 0; j < 8; ++j) { const int mm = (cp * (k + j)) & 63; const float xx = (float)mm * (1.f / 64.f); vv[j] = im ? -__builtin_amdgcn_sinf(xx) : __builtin_amdgcn_cosf(xx); }
              uint4 o; o.x = pk2(vv[0], vv[1]); o.y = pk2(vv[2], vv[3]); o.z = pk2(vv[4], vv[5]); o.w = pk2(vv[6], vv[7]); return o;
            },
            [&](int row, int k) { return *(const uint4*)(Fb + (size_t)(mt * 128 + row) * 256 + g * 64 + k); },
            smem, nullptr, 0);
        const int b = mt / NCH;
#pragma unroll
        for (int mi = 0; mi < 2; ++mi) {
          const int n = 32 * w + 16 * mi + fr, cp = n & 63, im = n >> 6;
          bf16_t* zrow = ZT + (size_t)((b * 256 + g * 64 + cp) * 2 + im) * S_ + (mt * 128 - b * S_);
#pragma unroll
          for (int ni = 0; ni < 8; ++ni) {
            uint2 o; o.x = pk2(acc[mi][ni][0], acc[mi][ni][1]); o.y = pk2(acc[mi][ni][2], acc[mi][ni][3]);
            *(uint2*)(zrow + 16 * ni + 4 * fq) = o;
          }
        }
      }
      bf16_t* tl = (bf16_t*)smem;
      for (int t = blockIdx.x; t < (M / 64) * 12; t += gridDim.x) {
        const int rt = t / 12, ct = t % 12;
        const int r0 = rt * 64, b = r0 / S_, s0 = r0 - b * S_;
        const int lo = (s0 < CTX) ? 0 : CTX, hi = (s0 < CTX) ? CTX - 1 : S_ - 1;
        __syncthreads();
#pragma unroll
        for (int i = 0; i < 4; ++i) {
          const int id = tid + 256 * i, rr = id >> 4, cc = (id & 15) * 8;
          const int s = s0 + rr, c = ct * 128 + cc;
          const size_t base = (size_t)(r0 + rr) * 1536 + c;
          uint4 z = {0u, 0u, 0u, 0u};
          const uint4 u1 = *(const uint4*)(QK + base);
          const uint4 u0 = (s - 1 >= lo) ? *(const uint4*)(QK + base - 1536) : z;
          const uint4 u2 = (s + 1 <= hi) ? *(const uint4*)(QK + base + 1536) : z;
          const unsigned a0[4] = {u0.x, u0.y, u0.z, u0.w}, a1[4] = {u1.x, u1.y, u1.z, u1.w}, a2[4] = {u2.x, u2.y, u2.z, u2.w};
          float o[8];
          {
            const f32x4 wa0 = *(const f32x4*)(p.w_qk_conv + c), wa1 = *(const f32x4*)(p.w_qk_conv + c + 4);
            const f32x4 wb0 = *(const f32x4*)(p.w_qk_conv + 1536 + c), wb1 = *(const f32x4*)(p.w_qk_conv + 1536 + c + 4);
            const f32x4 wc0 = *(const f32x4*)(p.w_qk_conv + 3072 + c), wc1 = *(const f32x4*)(p.w_qk_conv + 3072 + c + 4);
            const float wA[8] = {wa0[0], wa0[1], wa0[2], wa0[3], wa1[0], wa1[1], wa1[2], wa1[3]};
            const float wB[8] = {wb0[0], wb0[1], wb0[2], wb0[3], wb1[0], wb1[1], wb1[2], wb1[3]};
            const float wC[8] = {wc0[0], wc0[1], wc0[2], wc0[3], wc1[0], wc1[1], wc1[2], wc1[3]};
#pragma unroll
            for (int e = 0; e < 4; ++e) {
              o[2 * e] = siluf_(wA[2 * e] * bflo(a0[e]) + wB[2 * e] * bflo(a1[e]) + wC[2 * e] * bflo(a2[e]));
              o[2 * e + 1] = siluf_(wA[2 * e + 1] * bfhi(a0[e]) + wB[2 * e + 1] * bfhi(a1[e]) + wC[2 * e + 1] * bfhi(a2[e]));
            }
          }
          if (ct < 6) {
            const float sc = 0.08838834764831845f;
            uint4 q; q.x = pk2(o[0] * sc, o[1] * sc); q.y = pk2(o[2] * sc, o[3] * sc); q.z = pk2(o[4] * sc, o[5] * sc); q.w = pk2(o[6] * sc, o[7] * sc);
            *(uint4*)(Qc + (size_t)(r0 + rr) * 768 + c) = q;
          } else {
            uint4 q; q.x = pk2(o[0], o[1]); q.y = pk2(o[2], o[3]); q.z = pk2(o[4], o[5]); q.w = pk2(o[6], o[7]);
            *(uint4*)(Kc + (size_t)(r0 + rr) * 768 + c - 768) = q;
#pragma unroll
            for (int e = 0; e < 8; ++e) tl[(cc + e) * LDT + rr] = f2bf(o[e]);
          }
        }
        __syncthreads();
        if (ct >= 6) {
#pragma unroll
          for (int i = 0; i < 4; ++i) {
            const int id = tid + 256 * i, cc = id >> 3, sc8 = (id & 7) * 8;
            const uint4 v = *(const uint4*)&tl[cc * LDT + sc8];
            *(uint4*)(KcT + (size_t)(b * 768 + (ct - 6) * 128 + cc) * S_ + s0 + sc8) = v;
          }
        }
      }
    } break;
    case 4: {
      const bf16_t* ZT = (const bf16_t*)(DO + DO_ZT);
      const int NF = 512 + 8;
      bf16_t* ApT = (bf16_t*)(DO + DO_F);
      const bf16_t* Vt = (const bf16_t*)(AR + A0_VT); const bf16_t* KcT = (const bf16_t*)(DO + DO_KCT); const bf16_t* Kc = (const bf16_t*)(AR + A0_KC);
      bf16_t* ST = (bf16_t*)(AR + A0_ST);
      for (int t = blockIdx.x; t < NF + 24 * NCH; t += gridDim.x) {
        if (t < 512) {
          const int mt = t & 1, ct = t >> 1;
          f32x4 acc[2][8]; zero_acc(acc);
          block_gemm<false>(acc, 4,
              [&](int row, int k) {
                const int p1 = mt * 64 + (row >> 1), op = row & 1, part = k >> 7, t1 = k & 127; float vv[8];
#pragma unroll
                for (int j = 0; j < 8; ++j) {
                  const float xx = (float)((p1 * (t1 + j)) & 127) * (1.f / 128.f);
                  const float cv = __builtin_amdgcn_cosf(xx), sv = __builtin_amdgcn_sinf(xx);
                  vv[j] = op == 0 ? (part == 0 ? cv : sv) : (part == 0 ? -sv : cv);
                }
                uint4 o; o.x = pk2(vv[0], vv[1]); o.y = pk2(vv[2], vv[3]); o.z = pk2(vv[4], vv[5]); o.w = pk2(vv[6], vv[7]); return o;
              },
              [&](int row, int k) {
                const int n = 2 * ct + (row >> 6), t2 = row & 63, part = k >> 7, t1 = k & 127;
                const bf16_t* src = ZT + (size_t)(n * 2 + part) * S_ + CTX + 64 * t1 + t2;
                unsigned e[8];
#pragma unroll
                for (int j = 0; j < 8; ++j) e[j] = src[64 * j];
                uint4 o; o.x = e[0] | (e[1] << 16); o.y = e[2] | (e[3] << 16); o.z = e[4] | (e[5] << 16); o.w = e[6] | (e[7] << 16); return o;
              }, smem, nullptr, 0);
#pragma unroll
          for (int mi = 0; mi < 2; ++mi) {
            const int row = 32 * w + 16 * mi + fr, p1 = mt * 64 + (row >> 1), op = row & 1;
#pragma unroll
            for (int ni = 0; ni < 8; ++ni) {
              const int col = 16 * ni + 4 * fq, n = 2 * ct + (col >> 6), t2 = col & 63;
              f32x4 v = acc[mi][ni], o;
#pragma unroll
              for (int j = 0; j < 4; ++j) {
                const float other = __shfl_xor(v[j], 1);
                const float xx = (float)((p1 * (t2 + j)) & 8191) * (1.f / 8192.f);
                const float cv = __builtin_amdgcn_cosf(xx), sv = __builtin_amdgcn_sinf(xx);
                o[j] = op == 0 ? (v[j] * cv + other * sv) : (v[j] * cv - other * sv);
              }
              store_bf16_row(ApT, 128, p1 * 512 + n, op * 64 + t2, o);
            }
          }
        } else if (t < NF) {
          const int tt = t - 512, mt = tt >> 2, nt = tt & 3;
          const int T = 256, tmask = T - 1;
          const float invT = 1.f / (float)T;
          f32x4 acc[2][8]; zero_acc(acc);
          block_gemm<false>(acc, 2 * T / 64,
              [&](int row, int k) {
                const int pp = mt * 128 + row, part = k >= T, t0 = k & tmask; float vv[8];
#pragma unroll
                for (int j = 0; j < 8; ++j) { const int mm = (pp * (t0 + j)) & tmask; const float xx = (float)mm * invT; vv[j] = part ? __builtin_amdgcn_sinf(xx) : __builtin_amdgcn_cosf(xx); }
                uint4 o; o.x = pk2(vv[0], vv[1]); o.y = pk2(vv[2], vv[3]); o.z = pk2(vv[4], vv[5]); o.w = pk2(vv[6], vv[7]); return o;
              },
              [&](int row, int k) { const int part = k >= T, t0 = k & tmask; return *(const uint4*)(ZT + (size_t)((nt * 128 + row) * 2 + part) * S_ + t0); },
              smem, nullptr, 0);
#pragma unroll
          for (int mi = 0; mi < 2; ++mi)
#pragma unroll
            for (int ni = 0; ni < 8; ++ni) {
              const int pp = mt * 128 + 32 * w + 16 * mi + fr, n = nt * 128 + 16 * ni + 4 * fq, b = n >> 8;
              f32x4 v = acc[mi][ni]; v *= (1.f / 128.f);
              store_bf16_row(Hb, LDH, b * S_ + pp, 768 + (n & 255), v);
            }
        } else {
          const int ta = t - NF, sd = ta / NCH, n = ta % NCH;
          const int dir = sd / 12, b = (sd / 6) & 1, h = sd % 6;
          const int r0 = b * S_ + n * 128;
          float* sW = sF;
          __syncthreads();
          if (w == 0) {
            const GateScan g = gate_scan(Gt, r0, dir, h, lane);
            sW[g.pos0] = __expf(g.a0 - g.amax); sW[g.pos1] = __expf(g.a1 - g.amax);
            if (lane == 0) { CS[(sd * NCH + n) * 4 + 0] = g.amax; CS[(sd * NCH + n) * 4 + 1] = g.F; }
          }
          __syncthreads();
          f32x4 acc[2][8]; zero_acc(acc);
          const bf16_t* Ab = Vt + (size_t)(b * 768 + h * 128) * S_ + n * 128;
          const bf16_t* Bb = KcT + (size_t)(b * 768 + h * 128) * S_ + n * 128;
          block_gemm<false>(acc, 2,
              [&](int row, int k) { return *(const uint4*)(Ab + (size_t)row * S_ + k); },
              [&](int row, int k) {
                const uint4 u = *(const uint4*)(Bb + (size_t)row * S_ + k);
                uint4 o;
                o.x = pk2(bflo(u.x) * sW[k], bfhi(u.x) * sW[k + 1]); o.y = pk2(bflo(u.y) * sW[k + 2], bfhi(u.y) * sW[k + 3]);
                o.z = pk2(bflo(u.z) * sW[k + 4], bfhi(u.z) * sW[k + 5]); o.w = pk2(bflo(u.w) * sW[k + 6], bfhi(u.w) * sW[k + 7]);
                return o;
              }, smem, nullptr, 0);
          bf16_t* Sd = ST + (size_t)(sd * NCH + n) * 16384;
#pragma unroll
          for (int mi = 0; mi < 2; ++mi)
#pragma unroll
            for (int ni = 0; ni < 8; ++ni) store_bf16_row(Sd, 128, 32 * w + 16 * mi + fr, 16 * ni + 4 * fq, acc[mi][ni]);
          if (tid < 128) {
            int tix = tid; asm volatile("" : "+v"(tix));
            const uint4* krow = (const uint4*)(KcT + (size_t)(b * 768 + h * 128 + tix) * S_ + n * 128);
            float a = 0.f;
#pragma unroll
            for (int c = 0; c < 16; ++c) {
              const uint4 u = krow[c]; const float* ww = sW + 8 * c;
              a += bflo(u.x) * ww[0] + bfhi(u.x) * ww[1] + bflo(u.y) * ww[2] + bfhi(u.y) * ww[3] + bflo(u.z) * ww[4] + bfhi(u.z) * ww[5] + bflo(u.w) * ww[6] + bfhi(u.w) * ww[7];
            }
            NV[(size_t)(sd * NCH + n) * 128 + tix] = a;
          }
        }
      }
    } break;
    case 5: {
      {
        const bf16_t* ApT = (const bf16_t*)(DO + DO_F);
        for (int t = blockIdx.x; t < 512; t += gridDim.x) {
          const int p1 = t >> 2, n0 = (t & 3) * 128;
          f32x4 acc[2][8]; zero_acc(acc);
          block_gemm<false>(acc, 2,
              [&](int row, int k) { return *(const uint4*)(ApT + (size_t)(t * 128 + row) * 128 + k); },
              [&](int row, int k) {
                uint4 o = {0u, 0u, 0u, 0u};
                if (row < 64) {
                  const int part = k >> 6, t2 = k & 63; float vv[8];
#pragma unroll
                  for (int j = 0; j < 8; ++j) { const float xx = (float)((row * (t2 + j)) & 63) * (1.f / 64.f); vv[j] = part ? __builtin_amdgcn_sinf(xx) : __builtin_amdgcn_cosf(xx); }
                  o.x = pk2(vv[0], vv[1]); o.y = pk2(vv[2], vv[3]); o.z = pk2(vv[4], vv[5]); o.w = pk2(vv[6], vv[7]);
                }
                return o;
              }, smem, nullptr, 0);
#pragma unroll
          for (int mi = 0; mi < 2; ++mi) {
            const int n = n0 + 32 * w + 16 * mi + fr, b = n >> 8;
#pragma unroll
            for (int ni = 0; ni < 4; ++ni)
#pragma unroll
              for (int j = 0; j < 4; ++j) {
                const int p2 = 16 * ni + 4 * fq + j;
                Hb[(size_t)(b * S_ + CTX + p1 + 128 * p2) * LDH + 768 + (n & 255)] = f2bf(acc[mi][ni][j] * 0.0013810679320049757f);
              }
          }
        }
      }
      if (gridDim.x >= 400) convert_weights(p, 1, smem, 200, gridDim.x - 200); else convert_weights(p, 1, smem, 0, gridDim.x);
      bf16_t* ST = (bf16_t*)(AR + A0_ST);
      for (int e = blockIdx.x * 256 + tid; e < 24 * 2064; e += gridDim.x * 256) {
        const int sd = e / 2064, idx = e % 2064, dir = sd / 12;
        float cst[8];
#pragma unroll
        for (int j = 0; j < 8; ++j) cst[j] = 0.f;
        float m = 0.f;
        uint4 ring0[4], ring1[4]; float ra[4], rf[4];
#define SC_FETCH(i_, u_) do { const int n_ = chunk_ord(dir, (i_)); ra[u_] = CS[(sd * NCH + n_) * 4 + 0]; rf[u_] = CS[(sd * NCH + n_) * 4 + 1]; \
          if (idx < 2048) ring0[u_] = *(const uint4*)(ST + (size_t)(sd * NCH + n_) * 16384 + idx * 8); \
          else { const uint4* q_ = (const uint4*)(NV + (size_t)(sd * NCH + n_) * 128 + (idx - 2048) * 8); ring0[u_] = q_[0]; ring1[u_] = q_[1]; } } while (0)
#pragma unroll
        for (int u = 0; u < 4; ++u) { ring1[u] = uint4{0u, 0u, 0u, 0u}; SC_FETCH(u, u); }
        for (int i0 = 0; i0 < NCH; i0 += 4) {
#pragma unroll
          for (int u = 0; u < 4; ++u) {
            const int i = i0 + u;
            if (i < NCH) {
              const int n = chunk_ord(dir, i);
              const float amax = ra[u], F = rf[u];
              const uint4 c0 = ring0[u], c1 = ring1[u];
              if (i + 4 < NCH) SC_FETCH(i + 4, u);
              const float Mx = fmaxf(m, amax), dcy = __expf(m - Mx), scl = __expf(amax - Mx);
              if (idx < 2048) {
                uint4* ptr = (uint4*)(ST + (size_t)(sd * NCH + n) * 16384 + idx * 8);
                uint4 o; o.x = pk2(cst[0], cst[1]); o.y = pk2(cst[2], cst[3]); o.z = pk2(cst[4], cst[5]); o.w = pk2(cst[6], cst[7]);
                *ptr = o;
                cst[0] = dcy * cst[0] + scl * bflo(c0.x); cst[1] = dcy * cst[1] + scl * bfhi(c0.x);
                cst[2] = dcy * cst[2] + scl * bflo(c0.y); cst[3] = dcy * cst[3] + scl * bfhi(c0.y);
                cst[4] = dcy * cst[4] + scl * bflo(c0.z); cst[5] = dcy * cst[5] + scl * bfhi(c0.z);
                cst[6] = dcy * cst[6] + scl * bflo(c0.w); cst[7] = dcy * cst[7] + scl * bfhi(c0.w);
              } else {
                uint4* ptr = (uint4*)(NV + (size_t)(sd * NCH + n) * 128 + (idx - 2048) * 8);
                uint4 o0, o1;
                o0.x = __float_as_uint(cst[0]); o0.y = __float_as_uint(cst[1]); o0.z = __float_as_uint(cst[2]); o0.w = __float_as_uint(cst[3]);
                o1.x = __float_as_uint(cst[4]); o1.y = __float_as_uint(cst[5]); o1.z = __float_as_uint(cst[6]); o1.w = __float_as_uint(cst[7]);
                ptr[0] = o0; ptr[1] = o1;
                cst[0] = dcy * cst[0] + scl * __uint_as_float(c0.x); cst[1] = dcy * cst[1] + scl * __uint_as_float(c0.y);
                cst[2] = dcy * cst[2] + scl * __uint_as_float(c0.z); cst[3] = dcy * cst[3] + scl * __uint_as_float(c0.w);
                cst[4] = dcy * cst[4] + scl * __uint_as_float(c1.x); cst[5] = dcy * cst[5] + scl * __uint_as_float(c1.y);
                cst[6] = dcy * cst[6] + scl * __uint_as_float(c1.z); cst[7] = dcy * cst[7] + scl * __uint_as_float(c1.w);
              }
              if (idx == 0) MS[sd * NCH + n] = m;
              m = F + Mx;
            }
          }
        }
#undef SC_FETCH
      }
    } break;
    case 6: {
      const bf16_t* Vt = (const bf16_t*)(AR + A0_VT); const bf16_t* Qc = (const bf16_t*)(AR + A0_QC); const bf16_t* Kc = (const bf16_t*)(AR + A0_KC);
      const bf16_t* ST = (const bf16_t*)(AR + A0_ST); const bf16_t* Ob = (const bf16_t*)(AR + A0_O);
      float* aA = sF; float* aM = sF + 256; float* aI = sF + 512; float* aE = sF + 768; float* sN = sF + 1024; float* sQN = sF + 1280; float* sSC = sF + 1536;
      for (int t = blockIdx.x; t < 12 * NCH; t += gridDim.x) {
        const int bh = t / NCH, n = t % NCH, b = bh / 6, h = bh % 6;
        const int r0 = b * S_ + n * 128;
        __syncthreads();
        if (w < 2) {
          const int dir = w, sd = (dir * 2 + b) * 6 + h;
          const GateScan g = gate_scan(Gt, r0, dir, h, lane);
          const float mp = MS[sd * NCH + n];
          const float M0 = fmaxf(mp, g.pm0), M1 = fmaxf(mp, g.pm1);
          aA[dir * 128 + g.pos0] = __expf(g.a0 - g.amax); aA[dir * 128 + g.pos1] = __expf(g.a1 - g.amax);
          aM[dir * 128 + g.pos0] = __expf(g.amax - M0); aM[dir * 128 + g.pos1] = __expf(g.amax - M1);
          aI[dir * 128 + g.pos0] = __expf(mp - M0); aI[dir * 128 + g.pos1] = __expf(mp - M1);
          aE[dir * 128 + g.pos0] = __expf(-(g.b0 + M0)); aE[dir * 128 + g.pos1] = __expf(-(g.b1 + M1));
        } else {
          const int dir = w - 2, sd = (dir * 2 + b) * 6 + h;
          sN[dir * 128 + lane] = NV[(size_t)(sd * NCH + n) * 128 + lane];
          sN[dir * 128 + 64 + lane] = NV[(size_t)(sd * NCH + n) * 128 + 64 + lane];
        }
        __syncthreads();
        const bf16_t* Qb = Qc + (size_t)r0 * 768 + h * 128;
        const bf16_t* Kb = Kc + (size_t)r0 * 768 + h * 128;
        {
          const int qr = tid >> 1, k0 = (tid & 1) * 64;
          float sf = 0.f, sb = 0.f;
#pragma unroll
          for (int c8 = 0; c8 < 8; ++c8) {
            const uint4 u = *(const uint4*)(Qb + (size_t)qr * 768 + k0 + c8 * 8);
            const float* nf = sN + k0 + c8 * 8; const float* nb = sN + 128 + k0 + c8 * 8;
            sf += bflo(u.x) * nf[0] + bfhi(u.x) * nf[1] + bflo(u.y) * nf[2] + bfhi(u.y) * nf[3] + bflo(u.z) * nf[4] + bfhi(u.z) * nf[5] + bflo(u.w) * nf[6] + bfhi(u.w) * nf[7];
            sb += bflo(u.x) * nb[0] + bfhi(u.x) * nb[1] + bflo(u.y) * nb[2] + bfhi(u.y) * nb[3] + bflo(u.z) * nb[4] + bfhi(u.z) * nb[5] + bflo(u.w) * nb[6] + bfhi(u.w) * nb[7];
          }
          sf += __shfl_xor(sf, 1); sb += __shfl_xor(sb, 1);
          if ((tid & 1) == 0) { sQN[qr] = sf; sQN[128 + qr] = sb; }
        }
        f32x4 acc[2][8]; zero_acc(acc);
        block_gemm<false>(acc, 2,
            [&](int row, int k) { return *(const uint4*)(Qb + (size_t)row * 768 + k); },
            [&](int row, int k) { return *(const uint4*)(Kb + (size_t)row * 768 + k); }, smem, nullptr, 0);
        __syncthreads();
        {
          float rsf[2] = {0.f, 0.f}, rsb[2] = {0.f, 0.f};
#pragma unroll
          for (int ni = 0; ni < 8; ++ni) {
            const int s0 = 16 * ni + 4 * fq;
            const f32x4 ef = *(const f32x4*)(aA + s0), eb = *(const f32x4*)(aA + 128 + s0);
#pragma unroll
            for (int mi = 0; mi < 2; ++mi) {
              const int tr = 32 * w + 16 * mi + fr;
#pragma unroll
              for (int j = 0; j < 4; ++j) {
                const float sv = acc[mi][ni][j];
                rsf[mi] += (s0 + j <= tr) ? sv * ef[j] : 0.f;
                rsb[mi] += (s0 + j >= tr) ? sv * eb[j] : 0.f;
              }
            }
          }
          float cf[2], cb[2];
#pragma unroll
          for (int mi = 0; mi < 2; ++mi) {
            const int tr = 32 * w + 16 * mi + fr;
            float a = rsf[mi], c2 = rsb[mi];
            a += __shfl_xor(a, 16); a += __shfl_xor(a, 32); c2 += __shfl_xor(c2, 16); c2 += __shfl_xor(c2, 32);
            const float denf = a * aM[tr] + aI[tr] * sQN[tr], denb = c2 * aM[128 + tr] + aI[128 + tr] * sQN[128 + tr];
            const float ddf = 1.f / fmaxf(fabsf(denf), aE[tr]), ddb = 1.f / fmaxf(fabsf(denb), aE[128 + tr]);
            if (fq == 0) { sSC[tr] = aI[tr] * ddf; sSC[128 + tr] = aI[128 + tr] * ddb; }
            cf[mi] = aM[tr] * ddf; cb[mi] = aM[128 + tr] * ddb;
          }
#pragma unroll
          for (int ni = 0; ni < 8; ++ni) {
            const int s0 = 16 * ni + 4 * fq;
            const f32x4 ef = *(const f32x4*)(aA + s0), eb = *(const f32x4*)(aA + 128 + s0);
#pragma unroll
            for (int mi = 0; mi < 2; ++mi) {
              const int tr = 32 * w + 16 * mi + fr;
              f32x4 pv;
#pragma unroll
              for (int j = 0; j < 4; ++j) {
                const float df = (s0 + j <= tr) ? ef[j] * cf[mi] : 0.f;
                const float db = (s0 + j >= tr) ? eb[j] * cb[mi] : 0.f;
                pv[j] = acc[mi][ni][j] * (df + db);
              }
              uint2 o; o.x = pk2(pv[0], pv[1]); o.y = pk2(pv[2], pv[3]);
              *(uint2*)&sP[tr * LDP + s0] = o;
            }
          }
        }
        __syncthreads();
        zero_acc(acc);
        {
          const bf16_t* Vb = Vt + (size_t)(b * 768 + h * 128) * S_ + n * 128;
          block_gemm<true>(acc, 2, [&](int, int) { return uint4{0u, 0u, 0u, 0u}; },
              [&](int row, int k) { return *(const uint4*)(Vb + (size_t)row * S_ + k); }, smem, sP, LDP);
        }
#pragma unroll
        for (int dir = 0; dir < 2; ++dir) {
          const int sd = (dir * 2 + b) * 6 + h;
          const bf16_t* Cb = ST + (size_t)(sd * NCH + n) * 16384;
          block_gemm<false>(acc, 2,
              [&](int row, int k) {
                const uint4 u = *(const uint4*)(Qb + (size_t)row * 768 + k);
                const float sc = sSC[dir * 128 + row];
                uint4 o; o.x = pk2(bflo(u.x) * sc, bfhi(u.x) * sc); o.y = pk2(bflo(u.y) * sc, bfhi(u.y) * sc);
                o.z = pk2(bflo(u.z) * sc, bfhi(u.z) * sc); o.w = pk2(bflo(u.w) * sc, bfhi(u.w) * sc); return o;
              },
              [&](int row, int k) { return *(const uint4*)(Cb + (size_t)row * 128 + k); }, smem, nullptr, 0);
        }
#pragma unroll
        for (int mi = 0; mi < 2; ++mi) {
          const int tr = 32 * w + 16 * mi + fr, row = r0 + tr;
          float ss = 0.f;
#pragma unroll
          for (int ni = 0; ni < 8; ++ni)
#pragma unroll
            for (int j = 0; j < 4; ++j) ss += acc[mi][ni][j] * acc[mi][ni][j];
          ss += __shfl_xor(ss, 16); ss += __shfl_xor(ss, 32);
          const float rstd = rsqrtf(ss * (1.f / 128.f) + EPS);
#pragma unroll
          for (int ni = 0; ni < 8; ++ni) {
            const int col = h * 128 + 16 * ni + 4 * fq;
            const f32x4 gg = *(const f32x4*)(p.g_head + col);
            const uint2 ou = *(const uint2*)(Ob + (size_t)row * 768 + col);
            f32x4 v;
            v[0] = acc[mi][ni][0] * rstd * gg[0] * sigmoidf_(bflo(ou.x)); v[1] = acc[mi][ni][1] * rstd * gg[1] * sigmoidf_(bfhi(ou.x));
            v[2] = acc[mi][ni][2] * rstd * gg[2] * sigmoidf_(bflo(ou.y)); v[3] = acc[mi][ni][3] * rstd * gg[3] * sigmoidf_(bfhi(ou.y));
            store_bf16_row(Hb, LDH, row, col, v);
          }
        }
      }
    } break;
    case 7: case 10: case 15: case 18: {
      const bool is_ff2 = (ph == 10 || ph == 18);
      const int layer = ph >= 15 ? 1 : 0;
      const bool from_input = (ph == 7);
      const bf16_t* A = is_ff2 ? (const bf16_t*)AR : Hb;
      const int K = is_ff2 ? DFF : D;
      const bf16_t* Bt = (const bf16_t*)((unsigned char*)WT + (is_ff2 ? WT_FF2 : WT_OUT));
      const int gidx = is_ff2 ? 5 : 2;
      auto epi = [&](f32x4 (&acc)[2][8], int mt, int nt) {
#pragma unroll
        for (int mi = 0; mi < 2; ++mi) {
          const int row = mt * 128 + 32 * w + 16 * mi + fr;
          const float* xs = xsrc_row(p, from_input, row);
          float* xd = xdst_row(p, row);
          const float* gate = mod_row(p, layer, row) + gidx * 1024;
#pragma unroll
          for (int ni = 0; ni < 8; ++ni) {
            const int col = nt * 128 + ECOL(ni);
            const f32x4 xv = *(const f32x4*)(xs + col), gv = *(const f32x4*)(gate + col);
            f32x4 o = xv + gv * acc[mi][ni];
            *(f32x4*)(xd + col) = o;
          }
        }
      };
      const int lda = is_ff2 ? LDHID : LDH;
      gemm_phase(A, lda, Bt, K, M / 128, 8, true, epi, smem);
      if (layer == 0) {
        const int ldb = K + 64, kper = K / 4;
        float* PART = (float*)(AR + A_PART);
        for (int u = blockIdx.x; u < 32 * 4; u += gridDim.x) {
          const int tile = u >> 2, ks = u & 3, mc = tile >> 3, nt = tile & 7, mt = (mc >> 1) * NCH + (mc & 1);
          f32x4 acc[2][8]; zero_acc(acc);
          block_gemm_glds(acc, kper / 64, A + (size_t)mt * 128 * lda + ks * kper, (size_t)lda, Bt + (size_t)nt * 128 * ldb + ks * kper, (size_t)ldb, smem);
#pragma unroll
          for (int mi = 0; mi < 2; ++mi) {
            const int row = mt * 128 + 32 * w + 16 * mi + fr, rc = (row / S_) * CTX + (row % S_);
            const float* gate = mod_row(p, layer, row) + gidx * 1024;
            float* pd = PART + ((size_t)ks * 512 + rc) * 1024;
#pragma unroll
            for (int ni = 0; ni < 8; ++ni) {
              const int col = nt * 128 + ECOL(ni);
              const f32x4 gv = *(const f32x4*)(gate + col);
              *(f32x4*)(pd + col) = gv * acc[mi][ni];
            }
          }
        }
      }
    } break;
    case 8: norm_phase(p, 0, 1, false, false, 1); break;
    case 9: case 17: {
      bf16_t* Hid = (bf16_t*)AR;
      auto epi = [&](f32x4 (&acc)[2][8], int mt, int nt) {
#pragma unroll
        for (int mi = 0; mi < 2; ++mi) {
          bf16_t* hr = Hid + (size_t)(mt * 128 + 32 * w + 16 * mi + fr) * LDHID + nt * 128 + 8 * fq;
#pragma unroll
          for (int pq = 0; pq < 4; ++pq) {
            float r[8];
#pragma unroll
            for (int j = 0; j < 4; ++j) { const float a = fmaxf(acc[mi][2 * pq][j], 0.f), c2 = fmaxf(acc[mi][2 * pq + 1][j], 0.f); r[j] = a * a; r[4 + j] = c2 * c2; }
            uint4 o; o.x = pk2(r[0], r[1]); o.y = pk2(r[2], r[3]); o.z = pk2(r[4], r[5]); o.w = pk2(r[6], r[7]);
            *(uint4*)(hr + 32 * pq) = o;
          }
        }
      };
      gemm_phase(Hb, LDH, (const bf16_t*)((unsigned char*)WT + WT_FF1), D, M / 128, 32, ph == 17, epi, smem);
    } break;
    case 11: {
      norm_phase(p, 1, 0, false, false, 2);
    } break;
    case 12: {
      bf16_t* Qb = (bf16_t*)(AR + A1_Q); bf16_t* Kb = (bf16_t*)(AR + A1_K); bf16_t* Vt = (bf16_t*)(AR + A1_VT); bf16_t* GL = (bf16_t*)(AR + A1_GLU);
      const float* cT = (const float*)(ws + OFF_ROPE); const float* sT = cT + 8192 * 32;
      auto epi = [&](f32x4 (&acc)[2][8], int mt, int nt) {
        const int b = mt / NCH;
        if (nt < 12) {
#pragma unroll
          for (int mi = 0; mi < 2; ++mi) {
            const int row = mt * 128 + 32 * w + 16 * mi + fr, s = row - b * S_;
            if (s >= CTX) {
              const int tpos = s - CTX;
#pragma unroll
              for (int g2 = 0; g2 < 2; ++g2)
#pragma unroll
                for (int nn = 0; nn < 2; ++nn) {
                  const int ni = g2 * 4 + nn, d0 = 8 * fq + 4 * nn;
                  const f32x4 cc = *(const f32x4*)(cT + tpos * 32 + d0), sn = *(const f32x4*)(sT + tpos * 32 + d0);
                  const f32x4 x1 = acc[mi][ni], x2 = acc[mi][ni + 2];
                  acc[mi][ni] = x1 * cc - x2 * sn; acc[mi][ni + 2] = x2 * cc + x1 * sn;
                }
            }
          }
        }
#pragma unroll
        for (int mi = 0; mi < 2; ++mi)
#pragma unroll
          for (int ni = 0; ni < 8; ++ni) {
            const int row = mt * 128 + 32 * w + 16 * mi + fr, col = nt * 128 + ECOL(ni);
            f32x4 v = acc[mi][ni];
            if (nt < 6) { v *= 0.18033688011112042f; store_bf16_row(Qb, 768, row, col, v); }
            else if (nt < 12) store_bf16_row(Kb, 768, row, col - 768, v);
            else if (nt < 18) store_bf16_T(Vt + (size_t)b * 768 * S_, col - 1536, row - b * S_, v);
            else store_bf16_row(GL, 512, row, col - 2304, v);
          }
      };
      gemm_phase(Hb, LDH, (const bf16_t*)((unsigned char*)WT + WT_IN), D, M / 128, 22, false, epi, smem);
    } break;
    case 13: {
      const bf16_t* Qb = (const bf16_t*)(AR + A1_Q); const bf16_t* Kb = (const bf16_t*)(AR + A1_K); const bf16_t* Vt = (const bf16_t*)(AR + A1_VT);
      bf16_t* OA = (bf16_t*)(AR + A1_OA);
      const int r = lane & 31, hh = lane >> 5;
      constexpr int STAGE = 24576, SV_OFF = 8192, NKT = S_ / 64;
      for (int t = blockIdx.x; t < NB * 6 * 2 * 64; t += gridDim.x) {
        const int qt = t & 63, mp = (t >> 6) & 1, bh = t >> 7, b = bh / 6, h = bh % 6;
        const int rq0 = b * S_ + CTX + qt * 128;
        const bf16_t* Qp = Qb + (size_t)rq0 * 768 + h * 128 + mp * 64;
        const bf16_t* Kp = Kb + (size_t)b * S_ * 768 + h * 128 + mp * 64;
        const bf16_t* Vp = Vt + (size_t)(b * 768 + h * 128) * S_;
        bf16x8 qf[4];
#pragma unroll
        for (int ks = 0; ks < 4; ++ks) qf[ks] = *(const bf16x8*)(Qp + (size_t)(32 * w + r) * 768 + 16 * ks + 8 * hh);
        f32x16 o[4];
#pragma unroll
        for (int db = 0; db < 4; ++db)
#pragma unroll
          for (int i = 0; i < 16; ++i) o[db][i] = 0.f;
        float mrun = -INFINITY, lrun = 0.f;
        LASG unsigned char* lb = (LASG unsigned char*)smem;
        const int g8 = lane >> 3, gp = lane & 7;
#define ATT_ISSUE(st_, kt_) do { \
          _Pragma("unroll") for (int i = 0; i < 2; ++i) { const int rho = 16 * w + 8 * i + g8, key_ = (rho & ~12) | ((rho & 4) << 1) | ((rho & 8) >> 1); \
            __builtin_amdgcn_global_load_lds((const unsigned*)(Kp + (size_t)((kt_) * 64 + key_) * 768 + ((gp ^ ((rho >> 1) & 7)) * 8)), (LASG unsigned*)(lb + (st_) * STAGE + (16 * w + 8 * i) * 128 + lane * 16), 16, 0, 0); } \
          _Pragma("unroll") for (int i = 0; i < 4; ++i) { const int rho = 32 * w + 8 * i + g8; \
            __builtin_amdgcn_global_load_lds((const unsigned*)(Vp + (size_t)rho * S_ + (kt_) * 64 + ((gp ^ ((rho >> 1) & 7)) * 8)), (LASG unsigned*)(lb + (st_) * STAGE + SV_OFF + (32 * w + 8 * i) * 128 + lane * 16), 16, 0, 0); } } while (0)
        const int rsw = (r >> 1) & 7;
        __syncthreads();
        ATT_ISSUE(0, 0);
        for (int kt = 0; kt < NKT; ++kt) {
          const int st = kt & 1;
          __syncthreads();
          if (kt + 1 < NKT) ATT_ISSUE(st ^ 1, kt + 1);
          const unsigned char* sK = smem + st * STAGE; const unsigned char* sV = sK + SV_OFF;
          f32x16 sx[2];
#pragma unroll
          for (int kb = 0; kb < 2; ++kb) {
#pragma unroll
            for (int i = 0; i < 16; ++i) sx[kb][i] = 0.f;
#pragma unroll
            for (int ks = 0; ks < 4; ++ks) {
              const bf16x8 kf = *(const bf16x8*)(sK + (32 * kb + r) * 128 + (((2 * ks + hh) ^ rsw) * 16));
              sx[kb] = __builtin_amdgcn_mfma_f32_32x32x16_bf16(kf, qf[ks], sx[kb], 0, 0, 0);
            }
          }
          float mx = sx[0][0];
#pragma unroll
          for (int i = 0; i < 16; ++i) { mx = fmaxf(mx, sx[0][i]); mx = fmaxf(mx, sx[1][i]); }
          mx = xor32_max(mx);
          const float mnew = fmaxf(mrun, mx), alpha = __builtin_amdgcn_exp2f(mrun - mnew);
          float rs = 0.f;
#pragma unroll
          for (int kb = 0; kb < 2; ++kb)
#pragma unroll
            for (int i = 0; i < 16; ++i) { const float pv = __builtin_amdgcn_exp2f(sx[kb][i] - mnew); sx[kb][i] = pv; rs += pv; }
          rs = xor32_sum(rs);
          lrun = lrun * alpha + rs; mrun = mnew;
          if (__any(alpha != 1.f)) {
#pragma unroll
            for (int db = 0; db < 4; ++db) o[db] *= alpha;
          }
#pragma unroll
          for (int kb = 0; kb < 2; ++kb)
#pragma unroll
            for (int s2 = 0; s2 < 2; ++s2) {
              uint4 xp;
              xp.x = pk2(sx[kb][8 * s2 + 0], sx[kb][8 * s2 + 1]); xp.y = pk2(sx[kb][8 * s2 + 2], sx[kb][8 * s2 + 3]);
              xp.z = pk2(sx[kb][8 * s2 + 4], sx[kb][8 * s2 + 5]); xp.w = pk2(sx[kb][8 * s2 + 6], sx[kb][8 * s2 + 7]);
              const bf16x8 xs = __builtin_bit_cast(bf16x8, xp);
#pragma unroll
              for (int db = 0; db < 4; ++db) {
                const bf16x8 pa = *(const bf16x8*)(sV + (32 * db + r) * 128 + (((4 * kb + 2 * s2 + hh) ^ rsw) * 16));
                o[db] = __builtin_amdgcn_mfma_f32_32x32x16_bf16(pa, xs, o[db], 0, 0, 0);
              }
            }
        }
#undef ATT_ISSUE
        bf16_t* Od = OA + (size_t)mp * M * 768 + (size_t)(rq0 + 32 * w + r) * 768 + h * 128;
        const float inv = 1.f / lrun;
#pragma unroll
        for (int db = 0; db < 4; ++db)
#pragma unroll
          for (int g = 0; g < 4; ++g) {
            uint2 ov; ov.x = pk2(o[db][4 * g] * inv, o[db][4 * g + 1] * inv); ov.y = pk2(o[db][4 * g + 2] * inv, o[db][4 * g + 3] * inv);
            *(uint2*)(Od + 32 * db + 8 * g + 4 * hh) = ov;
          }
      }
    } break;
    case 14: {
      const bf16_t* OA = (const bf16_t*)(AR + A1_OA); const bf16_t* GL = (const bf16_t*)(AR + A1_GLU);
      const float lam_init = 0.8f - 0.6f * 0.7408182206817179f;
      {
        float l1 = p.lam_p[lane] * p.lam_p[64 + lane], l2 = p.lam_p[128 + lane] * p.lam_p[192 + lane];
        l1 = wsum(l1); l2 = wsum(l2);
        const float lam = __expf(l1) - __expf(l2) + lam_init;
        const int gw = blockIdx.x * 4 + w, ngw = gridDim.x * 4;
        const int l16 = lane & 15, g4 = lane >> 4;
        const f32x4 gs0 = *(const f32x4*)(p.g_sub + 8 * l16), gs1 = *(const f32x4*)(p.g_sub + 8 * l16 + 4);
        for (int it = gw; it < NB * SEQ * 6 / 4; it += ngw) {
          const int item = it * 4 + g4, rl = item / 6, h = item - rl * 6;
          const int b = rl / SEQ, tpos = rl % SEQ, row = b * S_ + CTX + tpos;
          const uint4 u0 = *(const uint4*)(OA + (size_t)row * 768 + h * 128 + 8 * l16);
          const uint4 u1 = *(const uint4*)(OA + (size_t)M * 768 + (size_t)row * 768 + h * 128 + 8 * l16);
          float o[8];
          o[0] = bflo(u0.x) - lam * bflo(u1.x); o[1] = bfhi(u0.x) - lam * bfhi(u1.x); o[2] = bflo(u0.y) - lam * bflo(u1.y); o[3] = bfhi(u0.y) - lam * bfhi(u1.y);
          o[4] = bflo(u0.z) - lam * bflo(u1.z); o[5] = bfhi(u0.z) - lam * bfhi(u1.z); o[6] = bflo(u0.w) - lam * bflo(u1.w); o[7] = bfhi(u0.w) - lam * bfhi(u1.w);
          float ss = 0.f;
#pragma unroll
          for (int e = 0; e < 8; ++e) ss += o[e] * o[e];
          ss += __shfl_xor(ss, 1); ss += __shfl_xor(ss, 2); ss += __shfl_xor(ss, 4); ss += __shfl_xor(ss, 8);
          const float rstd = rsqrtf(ss * (1.f / 128.f) + EPS) * (1.f - lam_init);
          uint4 ov;
          ov.x = pk2(o[0] * rstd * gs0[0], o[1] * rstd * gs0[1]); ov.y = pk2(o[2] * rstd * gs0[2], o[3] * rstd * gs0[3]);
          ov.z = pk2(o[4] * rstd * gs1[0], o[5] * rstd * gs1[1]); ov.w = pk2(o[6] * rstd * gs1[2], o[7] * rstd * gs1[3]);
          *(uint4*)(Hb + (size_t)row * LDH + h * 128 + 8 * l16) = ov;
        }
      }
      {
        float* su = (float*)smem;
        for (int t = blockIdx.x; t < NB * SEQ / 32; t += gridDim.x) {
          const int b = t / (SEQ / 32), t0 = (t % (SEQ / 32)) * 32;
          __syncthreads();
          for (int i = tid; i < 62 * 64; i += 256) {
            const int rr = i >> 6, c4 = (i & 63) * 4, tp = t0 + rr - 15;
            f32x4 u = {0.f, 0.f, 0.f, 0.f};
            if (tp >= 0 && tp < SEQ) {
              const size_t ro = (size_t)(b * S_ + CTX + tp) * 512;
              const uint2 av = *(const uint2*)(GL + ro + c4), gv = *(const uint2*)(GL + ro + 256 + c4);
              u[0] = bflo(av.x) * sigmoidf_(bflo(gv.x)); u[1] = bfhi(av.x) * sigmoidf_(bfhi(gv.x));
              u[2] = bflo(av.y) * sigmoidf_(bflo(gv.y)); u[3] = bfhi(av.y) * sigmoidf_(bfhi(gv.y));
            }
            *(f32x4*)(su + rr * 256 + c4) = u;
          }
          __syncthreads();
          float z[32], wj[31];
#pragma unroll
          for (int tt = 0; tt < 32; ++tt) z[tt] = 0.f;
#pragma unroll
          for (int j = 0; j < 31; ++j) wj[j] = p.w_dw[j * 256 + tid];
#pragma unroll
          for (int rr = 0; rr < 62; ++rr) {
            const float u = su[rr * 256 + tid];
#pragma unroll
            for (int tt = 0; tt < 32; ++tt) { const int j = rr - tt; if (j >= 0 && j < 31) z[tt] += wj[j] * u; }
          }
          __syncthreads();
#pragma unroll
          for (int tt = 0; tt < 32; ++tt) su[tt * 256 + tid] = z[tt];
          __syncthreads();
          for (int tt = w; tt < 32; tt += 4) {
            f32x4 v = *(const f32x4*)(su + tt * 256 + 4 * lane);
            const float mu = wsum(v[0] + v[1] + v[2] + v[3]) * (1.f / 256.f);
            v -= mu;
            const float rstd = rsqrtf(wsum(v[0] * v[0] + v[1] * v[1] + v[2] * v[2] + v[3] * v[3]) * (1.f / 256.f) + EPS);
            const f32x4 gl = *(const f32x4*)(p.g_cln + 4 * lane), bl = *(const f32x4*)(p.b_cln + 4 * lane);
            float y[4];
#pragma unroll
            for (int e = 0; e < 4; ++e) y[e] = siluf_(v[e] * rstd * gl[e] + bl[e]);
            uint2 o; o.x = pk2(y[0], y[1]); o.y = pk2(y[2], y[3]);
            *(uint2*)(Hb + (size_t)(b * S_ + CTX + t0 + tt) * LDH + 768 + 4 * lane) = o;
          }
        }
      }
    } break;
    case 16: norm_phase(p, 1, 1, false, true); break;
    case 19: {
      const int gw = blockIdx.x * 4 + w, ngw = gridDim.x * 4;
      for (int r = gw; r < NB * SEQ; r += ngw) {
        f32x4* xr = (f32x4*)(p.out + (size_t)r * D) + lane;
        f32x4 v[4]; float ss = 0.f;
#pragma unroll
        for (int j = 0; j < 4; ++j) { v[j] = xr[64 * j]; ss += v[j][0] * v[j][0] + v[j][1] * v[j][1] + v[j][2] * v[j][2] + v[j][3] * v[j][3]; }
        const float rstd = rsqrtf(wsum(ss) * (1.f / D) + EPS);
#pragma unroll
        for (int j = 0; j < 4; ++j) { const f32x4 gg = *(const f32x4*)(p.g_final + 4 * lane + 256 * j); xr[64 * j] = v[j] * rstd * gg; }
      }
    } break;
    default: break;
    }
}

__global__ void __launch_bounds__(256, LB2) mega(Params p) {
  extern __shared__ __attribute__((aligned(16))) unsigned char smem[];
  {
    volatile LAS unsigned* st = (volatile LAS unsigned*)(smem + LDS_BYTES - 16);
    if (threadIdx.x == 0) { st[0] = 0u; st[1] = 0u; }
    __syncthreads();
  }
  if (p.ph_hi == 7777) cg::this_grid().sync();
  const XcdBarrier xb = xcd_barrier_post((unsigned*)(p.ws + OFF_BAR), (volatile LAS unsigned*)(smem + LDS_BYTES - 16));
#ifndef REP_PH
#define REP_PH -1
#endif
#define RUN(k) if (p.ph_lo <= k && k < p.ph_hi) { if (k > p.ph_lo) { xcd_barrier(xb); } run_phase<k>(p, smem); \
    if (k == REP_PH) { xcd_barrier(xb); run_phase<k>(p, smem); } }
  RUN(0) RUN(1) RUN(2) RUN(3) RUN(4) RUN(5) RUN(6) RUN(7) RUN(8) RUN(9) RUN(10) RUN(11) RUN(12) RUN(13) RUN(14) RUN(15) RUN(16) RUN(17) RUN(18) RUN(19)
#undef RUN
  if (p.ph_lo == 20) {
    const bf16_t* src = (const bf16_t*)(p.ws + DUMP_OFF);
    for (size_t i = (size_t)blockIdx.x * 256 + threadIdx.x; i < (size_t)NB * SEQ * D; i += (size_t)gridDim.x * 256) p.out[i] = bf2f(src[i]) + bf2f(((const bf16_t*)(p.ws + OFF_H))[i]);
  }
}

extern "C" void kernel_launch(void* const* d_in, const int* in_sizes, int n_in, void* d_out, int out_size, void* d_ws, size_t ws_size, hipStream_t stream) {
  static int grid_blocks = 0;
  if (!grid_blocks) {
    if (ws_size < WS_NEED) { fprintf(stderr, "kernel_launch: workspace too small: %zu < %zu\n", ws_size, (size_t)WS_NEED); grid_blocks = -1; return; }
    int dev = 0, cus = 0, per_cu = 0;
    hipGetDevice(&dev);
    hipDeviceGetAttribute(&cus, hipDeviceAttributeMultiprocessorCount, dev);
    hipFuncSetAttribute((const void*)mega, hipFuncAttributeMaxDynamicSharedMemorySize, LDS_BYTES);
    hipOccupancyMaxActiveBlocksPerMultiprocessor(&per_cu, (const void*)mega, 256, LDS_BYTES);
    if (per_cu < 1) per_cu = 1;
    if (per_cu > 2) per_cu = 2;
    grid_blocks = cus * per_cu;
    fprintf(stderr, "kernel_launch: cus %d per_cu %d grid %d ws %zu\n", cus, per_cu, grid_blocks, ws_size);
  }
  if (grid_blocks < 0) return;
  Params p{};
  const float** pp = (const float**)&p;
  for (int i = 0; i < 22; ++i) pp[i] = (const float*)d_in[i];
  p.out = (float*)d_out; p.ws = (unsigned char*)d_ws;
#if MULTI_LAUNCH
  for (int ph = 0; ph < NPH_RUN; ++ph) {
    p.ph_lo = ph; p.ph_hi = ph + 1;
    hipLaunchKernelGGL(mega, dim3(grid_blocks), dim3(256), LDS_BYTES, stream, p);
  }
#if NPH_RUN < 20
  p.ph_lo = 20; p.ph_hi = 21;
  hipLaunchKernelGGL(mega, dim3(grid_blocks), dim3(256), LDS_BYTES, stream, p);
#endif
#else
  hipMemsetAsync((unsigned char*)d_ws + OFF_BAR, 0, XCD_BAR_WORDS * 4, stream);
  p.ph_lo = 0; p.ph_hi = NPH;
  void* args[] = {&p};
  hipError_t e = hipLaunchCooperativeKernel((void*)mega, dim3(grid_blocks), dim3(256), args, LDS_BYTES, stream);
  if (e != hipSuccess) fprintf(stderr, "cooperative launch failed: %s (grid %d)\n", hipGetErrorString(e), grid_blocks);
#endif
}
```

```cpp
#include <hip/hip_runtime.h>
#include <hip/hip_cooperative_groups.h>
#include <cstdio>
#include <cstdint>
namespace cg = cooperative_groups;

#ifndef LB2
#define LB2 2
#endif
#ifndef NPH_RUN
#define NPH_RUN 20
#endif
#ifndef DUMP_OFF
#define DUMP_OFF (OFF_AR + A0_QK)
#endif
#ifndef MULTI_LAUNCH
#define MULTI_LAUNCH 0
#endif

typedef unsigned short bf16_t;
typedef short bf16x8 __attribute__((ext_vector_type(8)));
typedef float f32x4 __attribute__((ext_vector_type(4)));
typedef float f32x16 __attribute__((ext_vector_type(16)));
#define DEV __device__ __forceinline__

constexpr int D = 1024, NB = 2, SEQ = 8192, CTX = 256, S_ = SEQ + CTX, M = NB * S_, DFF = 4096;
constexpr int LDH = D + 64, LDHID = DFF + 64;
constexpr int NCH = S_ / 128;
constexpr int NPH = 20;
constexpr float EPS = 1e-6f;

constexpr size_t OFF_MOD = 0;
constexpr size_t MOD_BYTES = 2 * 3 * 6144 * 4;
constexpr size_t OFF_ROPE = 0x40000;
constexpr size_t OFF_XC = 0x240000;
constexpr size_t OFF_G = 0x440000;
constexpr size_t OFF_CS = 0x5D0000;
constexpr size_t OFF_MS = 0x5D8000;
constexpr size_t OFF_NV = 0x5DA000;
constexpr size_t OFF_WT = 0x700000;
constexpr size_t WT_IN = 0, WT_OUT = 0x770000, WT_FF1 = 0x990000, WT_FF2 = 0x1210000;
constexpr size_t OFF_H = 0x2200000;
constexpr size_t OFF_AR = 0x4510000;
constexpr size_t A0_QK = 0, A0_ST = 0, A0_VT = 0x3180000, A0_O = 0x4A40000, A0_QC = 0x6300000, A0_KC = 0x7BC0000;
constexpr size_t DO_KCT = 0, DO_ZT = 0x18C0000, DO_F = 0x2940000;
constexpr size_t A1_Q = 0, A1_K = 0x18C0000, A1_VT = 0x3180000, A1_GLU = 0x4A40000, A1_OA = 0x5AC0000;
constexpr size_t OFF_WT2 = OFF_AR + 0x9480000;
constexpr size_t WS_NEED = OFF_WT2 + 0x1A30000;

struct Params {
  const float *x, *c, *ctx, *c_ctx, *w_mod, *b_mod, *g_norm, *w_in_even, *b_gate, *w_qk_conv, *g_head, *w_out_even,
      *w_in_odd, *lam_p, *g_sub, *w_dw, *g_cln, *b_cln, *w_out_odd, *w_ff1, *w_ff2, *g_final;
  float* out;
  unsigned char* ws;
  int ph_lo, ph_hi;
};

typedef float f32x2 __attribute__((ext_vector_type(2)));
typedef __bf16 bf16x2_t __attribute__((ext_vector_type(2)));
DEV unsigned pk2(float lo, float hi) { f32x2 v = {lo, hi}; bf16x2_t b = __builtin_convertvector(v, bf16x2_t); return __builtin_bit_cast(unsigned, b); }
DEV bf16_t f2bf(float f) { return (bf16_t)(pk2(f, 0.f) & 0xffff); }
DEV float bf2f(unsigned h) { return __uint_as_float(h << 16); }
DEV float bflo(unsigned u) { return __uint_as_float(u << 16); }
DEV float bfhi(unsigned u) { return __uint_as_float(u & 0xffff0000u); }
DEV float wsum(float v) { for (int o = 32; o; o >>= 1) v += __shfl_xor(v, o); return v; }
DEV float xor32_max(float v) { auto r = __builtin_amdgcn_permlane32_swap(__float_as_uint(v), __float_as_uint(v), false, false); return fmaxf(__uint_as_float(r[0]), __uint_as_float(r[1])); }
DEV float xor32_sum(float v) { auto r = __builtin_amdgcn_permlane32_swap(__float_as_uint(v), __float_as_uint(v), false, false); return __uint_as_float(r[0]) + __uint_as_float(r[1]); }
DEV float sigmoidf_(float x) { return __builtin_amdgcn_rcpf(1.f + __expf(-x)); }
DEV float siluf_(float x) { return x * __builtin_amdgcn_rcpf(1.f + __expf(-x)); }
DEV float logsigf_(float x) { return fminf(x, 0.f) - log1pf(__expf(-fabsf(x))); }

constexpr int LDT = 72;
constexpr int LDP = 136;
constexpr int LDS_A = 0, LDS_B = 18432, LDS_P = 36864, LDS_F = 71680, LDS_BYTES = 79872;

template <bool A_LDS, class LA, class LB>
DEV void block_gemm(f32x4 (&acc)[2][8], int nk, LA la, LB lb, unsigned char* smem, const bf16_t* pA, int ldp) {
  bf16_t* sA = (bf16_t*)(smem + LDS_A);
  bf16_t* sB = (bf16_t*)(smem + LDS_B);
  const int tid = threadIdx.x, lane = tid & 63, w = tid >> 6;
  const int srow = tid >> 3, scol = (tid & 7) * 8;
  const int fr = lane & 15, fq = lane >> 4;
  uint4 ra[4], rb[4];
#pragma unroll
  for (int i = 0; i < 4; ++i) { if (!A_LDS) ra[i] = la(srow + 32 * i, scol); rb[i] = lb(srow + 32 * i, scol); }
  for (int kt = 0; kt < nk; ++kt) {
    __syncthreads();
#pragma unroll
    for (int i = 0; i < 4; ++i) {
      if (!A_LDS) *(uint4*)&sA[(srow + 32 * i) * LDT + scol] = ra[i];
      *(uint4*)&sB[(srow + 32 * i) * LDT + scol] = rb[i];
    }
    __syncthreads();
    if (kt + 1 < nk) {
#pragma unroll
      for (int i = 0; i < 4; ++i) { if (!A_LDS) ra[i] = la(srow + 32 * i, (kt + 1) * 64 + scol); rb[i] = lb(srow + 32 * i, (kt + 1) * 64 + scol); }
    }
#pragma unroll
    for (int kk = 0; kk < 2; ++kk) {
      bf16x8 af[2], bfr[8];
#pragma unroll
      for (int mi = 0; mi < 2; ++mi) {
        if (A_LDS) af[mi] = *(const bf16x8*)&pA[(32 * w + 16 * mi + fr) * ldp + kt * 64 + kk * 32 + 8 * fq];
        else af[mi] = *(const bf16x8*)&sA[(32 * w + 16 * mi + fr) * LDT + kk * 32 + 8 * fq];
      }
#pragma unroll
      for (int ni = 0; ni < 8; ++ni) bfr[ni] = *(const bf16x8*)&sB[(16 * ni + fr) * LDT + kk * 32 + 8 * fq];
#pragma unroll
      for (int mi = 0; mi < 2; ++mi)
#pragma unroll
        for (int ni = 0; ni < 8; ++ni) acc[mi][ni] = __builtin_amdgcn_mfma_f32_16x16x32_bf16(bfr[ni], af[mi], acc[mi][ni], 0, 0, 0);
    }
  }
}

DEV void zero_acc(f32x4 (&acc)[2][8]) {
#pragma unroll
  for (int mi = 0; mi < 2; ++mi)
#pragma unroll
    for (int ni = 0; ni < 8; ++ni) acc[mi][ni] = (f32x4){0.f, 0.f, 0.f, 0.f};
}

#define LASG __attribute__((address_space(3)))
DEV void block_gemm_glds(f32x4 (&acc)[2][8], int nk, const bf16_t* Ag, size_t lda, const bf16_t* Bg, size_t ldb, unsigned char* smem) {
  const int tid = threadIdx.x, lane = tid & 63, w = tid >> 6;
  const int srow = tid >> 3, sc = ((tid & 7) ^ (srow & 7)) * 8;
  const int fr = lane & 15, fq = lane >> 4;
  const bf16_t* ag = Ag + (size_t)srow * lda + sc;
  const bf16_t* bg = Bg + (size_t)(8 * ((srow >> 2) & 3) + 4 * (srow >> 4) + (srow & 3)) * ldb + sc;
  LASG unsigned char* lbase = (LASG unsigned char*)smem;
#define GLDS_ISSUE(st_, k0_) do { \
    _Pragma("unroll") for (int i = 0; i < 4; ++i) { \
      __builtin_amdgcn_global_load_lds((const unsigned*)(ag + (size_t)(32 * i) * lda + (k0_)), (LASG unsigned*)(lbase + (st_) * 32768 + (tid + 256 * i) * 16), 16, 0, 0); \
      __builtin_amdgcn_global_load_lds((const unsigned*)(bg + (size_t)(32 * i) * ldb + (k0_)), (LASG unsigned*)(lbase + (st_) * 32768 + 16384 + (tid + 256 * i) * 16), 16, 0, 0); } } while (0)
  __syncthreads();
  GLDS_ISSUE(0, 0);
  for (int kt = 0; kt < nk; ++kt) {
    __syncthreads();
    if (kt + 1 < nk) GLDS_ISSUE((kt + 1) & 1, (kt + 1) * 64);
    const unsigned char* sA = smem + (kt & 1) * 32768;
    const unsigned char* sB = sA + 16384;
#pragma unroll
    for (int kk = 0; kk < 2; ++kk) {
      const int swz = ((kk * 4 + fq) ^ (fr & 7)) * 16;
      bf16x8 af[2], bfr[8];
#pragma unroll
      for (int mi = 0; mi < 2; ++mi) af[mi] = *(const bf16x8*)(sA + (32 * w + 16 * mi + fr) * 128 + swz);
#pragma unroll
      for (int ni = 0; ni < 8; ++ni) bfr[ni] = *(const bf16x8*)(sB + (16 * ni + fr) * 128 + swz);
#pragma unroll
      for (int mi = 0; mi < 2; ++mi)
#pragma unroll
        for (int ni = 0; ni < 8; ++ni) acc[mi][ni] = __builtin_amdgcn_mfma_f32_16x16x32_bf16(bfr[ni], af[mi], acc[mi][ni], 0, 0, 0);
    }
  }
#undef GLDS_ISSUE
}

DEV void block_gemm_glds2(f32x4 (&acc0)[2][8], f32x4 (&acc1)[2][8], int nk, const bf16_t* Ag, size_t lda, const bf16_t* Bg, size_t ldb, unsigned char* smem) {
  const int tid = threadIdx.x, lane = tid & 63, w = tid >> 6;
  const int fr = lane & 15, fq = lane >> 4;
  const int lr = lane >> 2, lp = lane & 3;
  const int sc = (lp ^ ((0x78 >> (2 * ((lr >> 2) & 3))) & 3)) * 8;
  const bf16_t* ag = Ag + (size_t)(32 * w + lr) * lda + sc;
  const bf16_t* bg = Bg + (size_t)(64 * w + lr) * ldb + sc;
  LASG unsigned char* lbase = (LASG unsigned char*)smem;
#define G2_ISSUE(st_, k0_) do { \
    _Pragma("unroll") for (int i = 0; i < 2; ++i) \
      __builtin_amdgcn_global_load_lds((const unsigned*)(ag + (size_t)(16 * i) * lda + (k0_)), (LASG unsigned*)(lbase + (st_) * 24576 + (32 * w + 16 * i) * 64 + lane * 16), 16, 0, 0); \
    _Pragma("unroll") for (int i = 0; i < 4; ++i) \
      __builtin_amdgcn_global_load_lds((const unsigned*)(bg + (size_t)(16 * i) * ldb + (k0_)), (LASG unsigned*)(lbase + (st_) * 24576 + 8192 + (64 * w + 16 * i) * 64 + lane * 16), 16, 0, 0); } while (0)
  __syncthreads();
  G2_ISSUE(0, 0);
  if (nk > 1) G2_ISSUE(1, 32);
  const int roff = (fq ^ ((0x78 >> (2 * ((fr >> 2) & 3))) & 3)) * 16 + fr * 64;
  int st = 0;
  for (int kt = 0; kt < nk; ++kt) {
    if (kt + 1 < nk) asm volatile("s_waitcnt vmcnt(6)" ::: "memory"); else asm volatile("s_waitcnt vmcnt(0)" ::: "memory");
    __builtin_amdgcn_s_barrier();
    asm volatile("" ::: "memory");
    if (kt + 2 < nk) { const int st2 = st >= 1 ? st - 1 : 2; G2_ISSUE(st2, (kt + 2) * 32); }
    const unsigned char* sA = smem + st * 24576;
    const unsigned char* sB = sA + 8192;
    bf16x8 af[2];
#pragma unroll
    for (int mi = 0; mi < 2; ++mi) af[mi] = *(const bf16x8*)(sA + (32 * w + 16 * mi) * 64 + roff);
    {
      bf16x8 bfr[8];
#pragma unroll
      for (int ni = 0; ni < 8; ++ni) bfr[ni] = *(const bf16x8*)(sB + (16 * ni) * 64 + roff);
#pragma unroll
      for (int mi = 0; mi < 2; ++mi)
#pragma unroll
        for (int ni = 0; ni < 8; ++ni) acc0[mi][ni] = __builtin_amdgcn_mfma_f32_16x16x32_bf16(bfr[ni], af[mi], acc0[mi][ni], 0, 0, 0);
    }
    {
      bf16x8 bfr[8];
#pragma unroll
      for (int ni = 0; ni < 8; ++ni) bfr[ni] = *(const bf16x8*)(sB + (128 + 16 * ni) * 64 + roff);
#pragma unroll
      for (int mi = 0; mi < 2; ++mi)
#pragma unroll
        for (int ni = 0; ni < 8; ++ni) acc1[mi][ni] = __builtin_amdgcn_mfma_f32_16x16x32_bf16(bfr[ni], af[mi], acc1[mi][ni], 0, 0, 0);
    }
    st = st == 2 ? 0 : st + 1;
  }
#undef G2_ISSUE
}

constexpr size_t OFF_BAR = 0x28000;
#define XB_TMO      128
#define XB_XCNT(j)  (256  + 64 * (j))
#define XB_XSUB(j)  (1280 + 64 * (j))
#define XB_XGEN(j)  (2304 + 64 * (j))
#define XB_TOP      3328
#define XB_TOPGEN   3392
#define XCD_BAR_WORDS 3456
#define XB_SPIN_CAP (1u << 18)
#define LAS __attribute__((address_space(3)))

__device__ __forceinline__ unsigned xb_ld(unsigned* p)              { return __hip_atomic_load(p, __ATOMIC_RELAXED, __HIP_MEMORY_SCOPE_AGENT); }
__device__ __forceinline__ unsigned xb_add(unsigned* p, unsigned v) { return __hip_atomic_fetch_add(p, v, __ATOMIC_RELAXED, __HIP_MEMORY_SCOPE_AGENT); }
__device__ __forceinline__ unsigned xb_xcc_id() { return (unsigned)__builtin_amdgcn_s_getreg((3 << 11) | 20) & 0xFu; }
#define XB_SPIN(cond, bar) do { unsigned _sp = 0; while (cond) { __builtin_amdgcn_s_sleep(1); \
    if ((++_sp & 255u) == 0u) { if (xb_ld(&(bar)[XB_TMO])) break; if (_sp > XB_SPIN_CAP) { atomicAdd(&(bar)[XB_TMO], 1u); break; } } } } while (0)

struct XcdBarrier {
    unsigned* bar; unsigned x;
    volatile LAS unsigned* st;
};

__device__ __forceinline__ XcdBarrier xcd_barrier_post(unsigned* bar, volatile LAS unsigned* st) {
    XcdBarrier b; b.bar = bar; b.x = xb_xcc_id(); b.st = st;
    if (threadIdx.x == 0) (void)xb_add(&bar[XB_XCNT(b.x)], 1u);
    return b;
}
__device__ __forceinline__ void xcd_barrier_complete(unsigned* bar, unsigned x, unsigned& nloc, unsigned& nx) {
    const unsigned G = gridDim.x * gridDim.y * gridDim.z;
    unsigned sum, cnt, mine, sp = 0u;
    for (;;) {
        sum = 0u; cnt = 0u; mine = 0u;
#pragma unroll
        for (unsigned j = 0; j < 16; ++j) { const unsigned c = xb_ld(&bar[XB_XCNT(j)]); sum += c; cnt += (c > 0u) ? 1u : 0u; mine = (j == x) ? c : mine; }
        if (sum == G) break;
        __builtin_amdgcn_s_sleep(1);
        if ((++sp & 255u) == 0u) { if (xb_ld(&bar[XB_TMO])) break; if (sp > XB_SPIN_CAP) { atomicAdd(&bar[XB_TMO], 1u); break; } }
    }
    nloc = mine > 0u ? mine : 1u; nx = cnt > 0u ? cnt : 1u;
}

__device__ __forceinline__ void xcd_barrier(const XcdBarrier& b) {
    asm volatile("s_waitcnt vmcnt(0)" ::: "memory");
    __syncthreads();
    if (threadIdx.x == 0) {
        unsigned* bar = b.bar;
        __builtin_amdgcn_s_waitcnt(0);
        unsigned nloc = b.st[0], nx = b.st[1];
        if (nloc == 0u) { xcd_barrier_complete(bar, b.x, nloc, nx); b.st[0] = nloc; b.st[1] = nx; }
        const unsigned old = xb_add(&bar[XB_XSUB(b.x)], 1u);
        const unsigned gen = old / nloc;
        if (old + 1u == (gen + 1u) * nloc) {
            __builtin_amdgcn_fence(__ATOMIC_RELEASE, "agent");
            asm volatile("s_waitcnt vmcnt(0)" ::: "memory");
            const unsigned og = xb_add(&bar[XB_TOP], 1u);
            const unsigned tg = og / nx;
            if (og + 1u == (tg + 1u) * nx) xb_add(&bar[XB_TOPGEN], 1u);
            else XB_SPIN(xb_ld(&bar[XB_TOPGEN]) == tg, bar);
            __builtin_amdgcn_fence(__ATOMIC_ACQUIRE, "agent");
            xb_add(&bar[XB_XGEN(b.x)], 1u);
            asm volatile("s_waitcnt vmcnt(0)" ::: "memory");
        } else {
            XB_SPIN(xb_ld(&bar[XB_XGEN(b.x)]) == gen, bar);
            __builtin_amdgcn_fence(__ATOMIC_ACQUIRE, "agent");
            asm volatile("s_waitcnt vmcnt(0)" ::: "memory");
        }
    }
    __syncthreads();
}

DEV const float* xsrc_row(const Params& p, bool from_input, int r) {
  const int b = r / S_, s = r - b * S_;
  if (from_input) return s < CTX ? p.ctx + (size_t)(b * CTX + s) * D : p.x + (size_t)(b * SEQ + s - CTX) * D;
  return s < CTX ? (const float*)(p.ws + OFF_XC) + (size_t)(b * CTX + s) * D : p.out + (size_t)(b * SEQ + s - CTX) * D;
}
DEV float* xdst_row(const Params& p, int r) {
  const int b = r / S_, s = r - b * S_;
  return s < CTX ? (float*)(p.ws + OFF_XC) + (size_t)(b * CTX + s) * D : p.out + (size_t)(b * SEQ + s - CTX) * D;
}
DEV const float* mod_row(const Params& p, int layer, int r) {
  const int b = r / S_, s = r - b * S_;
  return (const float*)(p.ws + OFF_MOD) + (size_t)(layer * 3 + (s < CTX ? 2 : b)) * 6144;
}

DEV void transpose_tile(const float* W, int K, int N, bf16_t* WT, int remap, int kt, int nt, unsigned char* smem) {
  float* tile = (float*)smem;
  const int tid = threadIdx.x;
  __syncthreads();
#pragma unroll
  for (int i = 0; i < 4; ++i) {
    const int kk = (tid >> 4) + 16 * i, c4 = (tid & 15) * 4;
    const int n = nt * 64 + c4;
    int src = n;
    if (remap) src = n < 3072 ? n : (n < 3328 ? n + 24 : (n < 3352 ? n - 256 : -1));
    else if (n >= N) src = -1;
    f32x4 v = (f32x4){0.f, 0.f, 0.f, 0.f};
    if (src >= 0) v = *(const f32x4*)(W + (size_t)(kt * 64 + kk) * N + src);
    tile[kk * 65 + c4 + 0] = v[0]; tile[kk * 65 + c4 + 1] = v[1]; tile[kk * 65 + c4 + 2] = v[2]; tile[kk * 65 + c4 + 3] = v[3];
  }
  __syncthreads();
  const int n = tid >> 2, kc = (tid & 3) * 16;
  uint4 o0, o1;
  const float* t = tile + kc * 65 + n;
  o0.x = pk2(t[0 * 65], t[1 * 65]); o0.y = pk2(t[2 * 65], t[3 * 65]); o0.z = pk2(t[4 * 65], t[5 * 65]); o0.w = pk2(t[6 * 65], t[7 * 65]);
  o1.x = pk2(t[8 * 65], t[9 * 65]); o1.y = pk2(t[10 * 65], t[11 * 65]); o1.z = pk2(t[12 * 65], t[13 * 65]); o1.w = pk2(t[14 * 65], t[15 * 65]);
  bf16_t* dst = WT + (size_t)(nt * 64 + n) * (K + 64) + kt * 64 + kc;
  *(uint4*)dst = o0; *(uint4*)(dst + 8) = o1;
}
DEV void transpose_mat(const float* Wm, int K, int N, int Npad, bf16_t* dst, int remap, unsigned char* smem, int b0, int nb) {
  const int nkt = K / 64, nnt = Npad / 64;
  if ((int)blockIdx.x < b0) return;
  for (int t = blockIdx.x - b0; t < nkt * nnt; t += nb) transpose_tile(Wm, K, N, dst, remap, t / nnt, t % nnt, smem);
}
DEV void convert_weights(const Params& p, int part, unsigned char* smem, int b0, int nb) {
  unsigned char* wt = p.ws + OFF_WT; unsigned char* wt2 = p.ws + OFF_WT2;
  if (part == 0) { transpose_mat(p.w_in_even, 1024, 3352, 3584, (bf16_t*)(wt + WT_IN), 1, smem, b0, nb); return; }
  transpose_mat(p.w_out_even, 1024, 1024, 1024, (bf16_t*)(wt + WT_OUT), 0, smem, b0, nb);
  transpose_mat(p.w_ff1, 1024, 4096, 4096, (bf16_t*)(wt + WT_FF1), 0, smem, b0, nb);
  transpose_mat(p.w_ff2, 4096, 1024, 1024, (bf16_t*)(wt + WT_FF2), 0, smem, b0, nb);
  transpose_mat(p.w_in_odd, 1024, 2816, 2816, (bf16_t*)(wt2 + WT_IN), 0, smem, b0, nb);
  transpose_mat(p.w_out_odd, 1024, 1024, 1024, (bf16_t*)(wt2 + WT_OUT), 0, smem, b0, nb);
  transpose_mat(p.w_ff1 + (size_t)1024 * 4096, 1024, 4096, 4096, (bf16_t*)(wt2 + WT_FF1), 0, smem, b0, nb);
  transpose_mat(p.w_ff2 + (size_t)1024 * 4096, 4096, 1024, 1024, (bf16_t*)(wt2 + WT_FF2), 0, smem, b0, nb);
}

DEV void mod_phase(const Params& p, unsigned char* smem) {
  float* MOD = (float*)(p.ws + OFF_MOD);
  float* sS = (float*)smem;
  float* red = sS + 3072;
  const int tid = threadIdx.x, cl = tid & 31, kg = tid >> 5;
  if ((int)blockIdx.x >= 2 * 192) return;
  __syncthreads();
  for (int i = tid; i < 3072; i += 256) { const int v = i >> 10, k = i & 1023; sS[i] = siluf_(v == 0 ? p.c[k] : (v == 1 ? p.c[1024 + k] : p.c_ctx[k])); }
  __syncthreads();
  for (int it = blockIdx.x; it < 2 * 192; it += gridDim.x) {
    const int l = it / 192, n = (it % 192) * 32 + cl;
    const float* W = p.w_mod + (size_t)l * 1024 * 6144 + n;
    float a0 = 0.f, a1 = 0.f, a2 = 0.f;
#pragma unroll 16
    for (int k = kg * 128; k < kg * 128 + 128; ++k) {
      const float wv = W[(size_t)k * 6144];
      a0 += sS[k] * wv; a1 += sS[1024 + k] * wv; a2 += sS[2048 + k] * wv;
    }
    __syncthreads();
    red[(kg * 32 + cl) * 3 + 0] = a0; red[(kg * 32 + cl) * 3 + 1] = a1; red[(kg * 32 + cl) * 3 + 2] = a2;
    __syncthreads();
    if (kg == 0) {
      const float bv = p.b_mod[l * 6144 + n];
#pragma unroll
      for (int v = 0; v < 3; ++v) {
        float sacc = 0.f;
#pragma unroll
        for (int g2 = 0; g2 < 8; ++g2) sacc += red[(g2 * 32 + cl) * 3 + v];
        MOD[(l * 3 + v) * 6144 + n] = sacc + bv;
      }
    }
  }
}
DEV void rope_phase(const Params& p) {
  float* ct = (float*)(p.ws + OFF_ROPE);
  float* st = ct + 8192 * 32;
  for (int i = blockIdx.x * 256 + threadIdx.x; i < 8192 * 32; i += gridDim.x * 256) {
    const int t = i >> 5, d = i & 31;
    const float pos = (d < 16) ? (float)(t >> 6) : (float)(t & 63);
    const float inv = powf(10000.f, -(float)(d & 15) / 16.f);
    const float ang = pos * inv;
    ct[i] = cosf(ang); st[i] = sinf(ang);
  }
}

constexpr size_t A_PART = 0x8700000;
DEV void norm_phase(const Params& p, int layer, int which, bool from_input, bool skip_ctx, int ctx_fix = 0) {
  const int lane = threadIdx.x & 63;
  const int gw = blockIdx.x * 4 + (threadIdx.x >> 6), ngw = gridDim.x * 4;
  const float* g = p.g_norm + (layer * 2 + which) * D;
  bf16_t* H = (bf16_t*)(p.ws + OFF_H);
  for (int r = gw; r < M; r += ngw) {
    const int s = r % S_;
    if (skip_ctx && s < CTX) continue;
    const bool fix = ctx_fix && s < CTX;
    const f32x4* xr = (const f32x4*)xsrc_row(p, fix ? (ctx_fix == 1) : from_input, r) + lane;
    const float* mv = mod_row(p, layer, r) + which * 3 * 1024;
    f32x4 v[4]; float ss = 0.f;
#pragma unroll
    for (int j = 0; j < 4; ++j) v[j] = xr[64 * j];
    if (fix) {
      const int rc = (r / S_) * CTX + s;
      const f32x4* pp = (const f32x4*)(p.ws + OFF_AR + A_PART) + (size_t)rc * 256 + lane;
      f32x4* xw = (f32x4*)xdst_row(p, r) + lane;
#pragma unroll
      for (int j = 0; j < 4; ++j) {
        v[j] += (pp[64 * j] + pp[(size_t)512 * 256 + 64 * j]) + (pp[(size_t)2 * 512 * 256 + 64 * j] + pp[(size_t)3 * 512 * 256 + 64 * j]);
        xw[64 * j] = v[j];
      }
    }
#pragma unroll
    for (int j = 0; j < 4; ++j) ss += v[j][0] * v[j][0] + v[j][1] * v[j][1] + v[j][2] * v[j][2] + v[j][3] * v[j][3];
    const float rstd = rsqrtf(wsum(ss) * (1.f / D) + EPS);
    uint2* o = (uint2*)(H + (size_t)r * LDH) + lane;
#pragma unroll
    for (int j = 0; j < 4; ++j) {
      const int c = 4 * lane + 256 * j;
      const f32x4 gg = *(const f32x4*)(g + c), sh = *(const f32x4*)(mv + c), sc = *(const f32x4*)(mv + 1024 + c);
      float y[4];
#pragma unroll
      for (int e = 0; e < 4; ++e) y[e] = v[j][e] * rstd * gg[e] * (1.f + sc[e]) + sh[e];
      uint2 w2; w2.x = pk2(y[0], y[1]); w2.y = pk2(y[2], y[3]);
      o[64 * j] = w2;
    }
  }
}

template <class Epi>
DEV void gemm_phase(const bf16_t* A, int lda, const bf16_t* Bt, int K, int MT, int NT, bool skip_ctx, Epi epi, unsigned char* smem) {
  const int ldb = K + 64;
  const int MTv = skip_ctx ? MT - 2 * NB : MT;
  const int nwg = MTv * NT;
  for (int t = blockIdx.x; t < nwg; t += gridDim.x) {
    int wgid = t;
    { const int q = nwg / 8, r8 = nwg % 8, xcd = wgid % 8, off = wgid / 8; wgid = (xcd < r8 ? xcd * (q + 1) : r8 * (q + 1) + (xcd - r8) * q) + off; }
    const int nig = 8 * NT, gid = wgid / nig, fm = gid * 8, gsz = (MTv - fm) < 8 ? (MTv - fm) : 8;
    int mt = fm + (wgid % nig) % gsz; const int nt = (wgid % nig) / gsz;
    if (skip_ctx) mt = (mt / (NCH - 2)) * NCH + 2 + (mt % (NCH - 2));
    f32x4 acc[2][8]; zero_acc(acc);
    const bf16_t* Ab = A + (size_t)mt * 128 * lda;
    const bf16_t* Bb = Bt + (size_t)nt * 128 * ldb;
    block_gemm_glds(acc, K / 64, Ab, (size_t)lda, Bb, (size_t)ldb, smem);
    epi(acc, mt, nt);
  }
}

template <class Epi>
DEV void gemm_phase2(const bf16_t* A, int lda, const bf16_t* Bt, int K, int MT, int NP, bool skip_ctx, Epi epi, unsigned char* smem) {
  const int ldb = K + 64;
  const int MTv = skip_ctx ? MT - 2 * NB : MT;
  for (int t = blockIdx.x; t < MTv * NP; t += gridDim.x) {
    int mt = t / NP; const int np = t % NP;
    if (skip_ctx) mt = (mt / (NCH - 2)) * NCH + 2 + (mt % (NCH - 2));
    f32x4 acc0[2][8], acc1[2][8]; zero_acc(acc0); zero_acc(acc1);
    block_gemm_glds2(acc0, acc1, K / 32, A + (size_t)mt * 128 * lda, (size_t)lda, Bt + (size_t)np * 256 * ldb, (size_t)ldb, smem);
    epi(acc0, mt, 2 * np);
    epi(acc1, mt, 2 * np + 1);
  }
}

#define ECOL(ni_) (32 * ((ni_) >> 1) + 8 * fq + 4 * ((ni_) & 1))
#define EPI_COORDS const int lane = threadIdx.x & 63, w = threadIdx.x >> 6, fr = lane & 15, fq = lane >> 4; (void)w; (void)fr; (void)fq;

DEV void store_bf16_row(bf16_t* base, size_t ld, int row, int col, const f32x4& v) {
  uint2 o; o.x = pk2(v[0], v[1]); o.y = pk2(v[2], v[3]);
  *(uint2*)(base + (size_t)row * ld + col) = o;
}
DEV void store_bf16_T(bf16_t* base, int col, int s, const f32x4& v) {
#pragma unroll
  for (int j = 0; j < 4; ++j) base[(size_t)(col + j) * S_ + s] = f2bf(v[j]);
}

struct GateScan { float a0, a1, b0, b1, pm0, pm1, F, amax; int pos0, pos1; };
DEV GateScan gate_scan(const float* G, const int r0, const int dir, const int h, const int lane) {
  GateScan g;
  const int j0 = 2 * lane, j1 = j0 + 1;
  g.pos0 = dir ? 127 - j0 : j0; g.pos1 = dir ? 127 - j1 : j1;
  const float i0 = G[(size_t)(r0 + g.pos0) * 24 + (dir * 2) * 6 + h], f0 = G[(size_t)(r0 + g.pos0) * 24 + (dir * 2 + 1) * 6 + h];
  const float i1 = G[(size_t)(r0 + g.pos1) * 24 + (dir * 2) * 6 + h], f1 = G[(size_t)(r0 + g.pos1) * 24 + (dir * 2 + 1) * 6 + h];
  const float lf0 = logsigf_(f0), lf1 = logsigf_(f1);
  const float s0 = lf0, s1 = lf0 + lf1;
  float tot = s1;
#pragma unroll
  for (int d = 1; d < 64; d <<= 1) { const float y = __shfl_up(tot, d); if (lane >= d) tot += y; }
  const float excl = tot - s1;
  g.b0 = s0 + excl; g.b1 = s1 + excl;
  g.F = __shfl(tot, 63);
  g.a0 = i0 - g.b0; g.a1 = i1 - g.b1;
  const float q0 = g.a0, q1 = fmaxf(g.a0, g.a1);
  float t = q1;
#pragma unroll
  for (int d = 1; d < 64; d <<= 1) { const float y = __shfl_up(t, d); if (lane >= d) t = fmaxf(t, y); }
  float ex = __shfl_up(t, 1); if (lane == 0) ex = -INFINITY;
  g.pm0 = fmaxf(q0, ex); g.pm1 = fmaxf(q1, ex);
  g.amax = __shfl(t, 63);
  return g;
}
DEV int chunk_ord(int dir, int i) { return dir == 0 ? i : (i < 2 ? 1 - i : 67 - i); }

template <int ph>
DEV void run_phase(const Params& p, unsigned char* smem) {
  const int tid = threadIdx.x, lane = tid & 63, w = tid >> 6, fr = lane & 15, fq = lane >> 4;
  unsigned char* ws = p.ws;
  bf16_t* const WT = (bf16_t*)(ws + (ph >= 11 ? OFF_WT2 : OFF_WT));
  bf16_t* const Hb = (bf16_t*)(ws + OFF_H);
  float* const Gt = (float*)(ws + OFF_G);
  float* const CS = (float*)(ws + OFF_CS);
  float* const MS = (float*)(ws + OFF_MS);
  float* const NV = (float*)(ws + OFF_NV);
  unsigned char* const AR = ws + OFF_AR;
  unsigned char* const DO = (unsigned char*)p.out;
  float* const sF = (float*)(smem + LDS_F);
  bf16_t* const sP = (bf16_t*)(smem + LDS_P);

    switch (ph) {
    case 0: {
      convert_weights(p, 0, smem, 0, gridDim.x);
      mod_phase(p, smem);
      rope_phase(p);
    } break;
    case 1: norm_phase(p, 0, 0, true, false); break;
    case 2: {
      bf16_t* QK = (bf16_t*)(AR + A0_QK); bf16_t* Vt = (bf16_t*)(AR + A0_VT); bf16_t* Ob = (bf16_t*)(AR + A0_O); bf16_t* Fb = (bf16_t*)(DO + DO_F);
      const float* bg = p.b_gate;
      auto epi = [&](f32x4 (&acc)[2][8], int mt, int nt) {
        const int b = mt / NCH;
        const int row0 = mt * 128 + 32 * w + fr, col0 = nt * 128 + 8 * fq;
        if (nt < 12 || (nt >= 18 && nt < 26)) {
          bf16_t* tb; int ld;
          if (nt < 12) { tb = QK + (size_t)row0 * 1536 + col0; ld = 1536; }
          else if (nt < 24) { tb = Ob + (size_t)row0 * 768 + (col0 - 2304); ld = 768; }
          else { tb = Fb + (size_t)row0 * 256 + (col0 - 3072); ld = 256; }
#pragma unroll
          for (int mi = 0; mi < 2; ++mi)
#pragma unroll
            for (int pq = 0; pq < 4; ++pq) {
              uint4 o; o.x = pk2(acc[mi][2 * pq][0], acc[mi][2 * pq][1]); o.y = pk2(acc[mi][2 * pq][2], acc[mi][2 * pq][3]);
              o.z = pk2(acc[mi][2 * pq + 1][0], acc[mi][2 * pq + 1][1]); o.w = pk2(acc[mi][2 * pq + 1][2], acc[mi][2 * pq + 1][3]);
              *(uint4*)(tb + (size_t)(16 * mi) * ld + 32 * pq) = o;
            }
        } else if (nt < 18) {
          bf16_t* tb = Vt + (size_t)b * 768 * S_ + (size_t)(col0 - 1536) * S_ + (row0 - b * S_);
#pragma unroll
          for (int mi = 0; mi < 2; ++mi)
#pragma unroll
            for (int ni = 0; ni < 8; ++ni)
#pragma unroll
              for (int j = 0; j < 4; ++j) tb[(size_t)(32 * (ni >> 1) + 4 * (ni & 1) + j) * S_ + 16 * mi] = f2bf(acc[mi][ni][j]);
        } else if (nt == 26) {
#pragma unroll
          for (int mi = 0; mi < 2; ++mi)
#pragma unroll
            for (int ni = 0; ni < 2; ++ni) {
              const int gc = ECOL(ni);
              if (gc < 24) { f32x4 o = acc[mi][ni]; o += *(const f32x4*)(bg + gc); *(f32x4*)(Gt + (size_t)(row0 + 16 * mi) * 24 + gc) = o; }
            }
        }
      };
      gemm_phase(Hb, LDH, (const bf16_t*)((unsigned char*)WT + WT_IN), D, M / 128, 27, false, epi, smem);
    } break;
    case 3: {
      const bf16_t* QK = (const bf16_t*)(AR + A0_QK);
      bf16_t* Qc = (bf16_t*)(AR + A0_QC); bf16_t* Kc = (bf16_t*)(AR + A0_KC); bf16_t* KcT = (bf16_t*)(DO + DO_KCT);
      bf16_t* ZT = (bf16_t*)(DO + DO_ZT); const bf16_t* Fb = (const bf16_t*)(DO + DO_F);
      for (int t = blockIdx.x; t < (M / 128) * 4; t += gridDim.x) {
        const int mt = t >> 2, g = t & 3;
        f32x4 acc[2][8]; zero_acc(acc);
        block_gemm<false>(acc, 1,
            [&](int row, int k) {
              const int cp = row & 63, im = row >> 6; float vv[8];
#pragma unroll
              for (int j = 0; j < 8; ++j) { const int mm = (cp * (k + j)) & 63; const float xx = (float)mm * (1.f / 64.f); vv[j] = im ? -__builtin_amdgcn_sinf(xx) : __builtin_amdgcn_cosf(xx); }
              uint4 o; o.x = pk2(vv[0], vv[1]); o.y = pk2(vv[2], vv[3]); o.z = pk2(vv[4], vv[5]); o.w = pk2(vv[6], vv[7]); return o;
            },
            [&](int row, int k) { return *(const uint4*)(Fb + (size_t)(mt * 128 + row) * 256 + g * 64 + k); },
            smem, nullptr, 0);
        const int b = mt / NCH;
#pragma unroll
        for (int mi = 0; mi < 2; ++mi) {
          const int n = 32 * w + 16 * mi + fr, cp = n & 63, im = n >> 6;
          bf16_t* zrow = ZT + (size_t)((b * 256 + g * 64 + cp) * 2 + im) * S_ + (mt * 128 - b * S_);
#pragma unroll
          for (int ni = 0; ni < 8; ++ni) {
            uint2 o; o.x = pk2(acc[mi][ni][0], acc[mi][ni][1]); o.y = pk2(acc[mi][ni][2], acc[mi][ni][3]);
            *(uint2*)(zrow + 16 * ni + 4 * fq) = o;
          }
        }
      }
      bf16_t* tl = (bf16_t*)smem;
      for (int t = blockIdx.x; t < (M / 64) * 12; t += gridDim.x) {
        const int rt = t / 12, ct = t % 12;
        const int r0 = rt * 64, b = r0 / S_, s0 = r0 - b * S_;
        const int lo = (s0 < CTX) ? 0 : CTX, hi = (s0 < CTX) ? CTX - 1 : S_ - 1;
        __syncthreads();
#pragma unroll
        for (int i = 0; i < 4; ++i) {
          const int id = tid + 256 * i, rr = id >> 4, cc = (id & 15) * 8;
          const int s = s0 + rr, c = ct * 128 + cc;
          const size_t base = (size_t)(r0 + rr) * 1536 + c;
          uint4 z = {0u, 0u, 0u, 0u};
          const uint4 u1 = *(const uint4*)(QK + base);
          const uint4 u0 = (s - 1 >= lo) ? *(const uint4*)(QK + base - 1536) : z;
          const uint4 u2 = (s + 1 <= hi) ? *(const uint4*)(QK + base + 1536) : z;
          const unsigned a0[4] = {u0.x, u0.y, u0.z, u0.w}, a1[4] = {u1.x, u1.y, u1.z, u1.w}, a2[4] = {u2.x, u2.y, u2.z, u2.w};
          float o[8];
          {
            const f32x4 wa0 = *(const f32x4*)(p.w_qk_conv + c), wa1 = *(const f32x4*)(p.w_qk_conv + c + 4);
            const f32x4 wb0 = *(const f32x4*)(p.w_qk_conv + 1536 + c), wb1 = *(const f32x4*)(p.w_qk_conv + 1536 + c + 4);
            const f32x4 wc0 = *(const f32x4*)(p.w_qk_conv + 3072 + c), wc1 = *(const f32x4*)(p.w_qk_conv + 3072 + c + 4);
            const float wA[8] = {wa0[0], wa0[1], wa0[2], wa0[3], wa1[0], wa1[1], wa1[2], wa1[3]};
            const float wB[8] = {wb0[0], wb0[1], wb0[2], wb0[3], wb1[0], wb1[1], wb1[2], wb1[3]};
            const float wC[8] = {wc0[0], wc0[1], wc0[2], wc0[3], wc1[0], wc1[1], wc1[2], wc1[3]};
#pragma unroll
            for (int e = 0; e < 4; ++e) {
              o[2 * e] = siluf_(wA[2 * e] * bflo(a0[e]) + wB[2 * e] * bflo(a1[e]) + wC[2 * e] * bflo(a2[e]));
              o[2 * e + 1] = siluf_(wA[2 * e + 1] * bfhi(a0[e]) + wB[2 * e + 1] * bfhi(a1[e]) + wC[2 * e + 1] * bfhi(a2[e]));
            }
          }
          if (ct < 6) {
            const float sc = 0.08838834764831845f;
            uint4 q; q.x = pk2(o[0] * sc, o[1] * sc); q.y = pk2(o[2] * sc, o[3] * sc); q.z = pk2(o[4] * sc, o[5] * sc); q.w = pk2(o[6] * sc, o[7] * sc);
            *(uint4*)(Qc + (size_t)(r0 + rr) * 768 + c) = q;
          } else {
            uint4 q; q.x = pk2(o[0], o[1]); q.y = pk2(o[2], o[3]); q.z = pk2(o[4], o[5]); q.w = pk2(o[6], o[7]);
            *(uint4*)(Kc + (size_t)(r0 + rr) * 768 + c - 768) = q;
#pragma unroll
            for (int e = 0; e < 8; ++e) tl[(cc + e) * LDT + rr] = f2bf(o[e]);
          }
        }
        __syncthreads();
        if (ct >= 6) {
#pragma unroll
          for (int i = 0; i < 4; ++i) {
            const int id = tid + 256 * i, cc = id >> 3, sc8 = (id & 7) * 8;
            const uint4 v = *(const uint4*)&tl[cc * LDT + sc8];
            *(uint4*)(KcT + (size_t)(b * 768 + (ct - 6) * 128 + cc) * S_ + s0 + sc8) = v;
          }
        }
      }
    } break;
    case 4: {
      const bf16_t* ZT = (const bf16_t*)(DO + DO_ZT);
      const int NF = 512 + 8;
      bf16_t* ApT = (bf16_t*)(DO + DO_F);
      const bf16_t* Vt = (const bf16_t*)(AR + A0_VT); const bf16_t* KcT = (const bf16_t*)(DO + DO_KCT); const bf16_t* Kc = (const bf16_t*)(AR + A0_KC);
      bf16_t* ST = (bf16_t*)(AR + A0_ST);
      for (int t = blockIdx.x; t < NF + 24 * NCH; t += gridDim.x) {
        if (t < 512) {
          const int mt = t & 1, ct = t >> 1;
          f32x4 acc[2][8]; zero_acc(acc);
          block_gemm<false>(acc, 4,
              [&](int row, int k) {
                const int p1 = mt * 64 + (row >> 1), op = row & 1, part = k >> 7, t1 = k & 127; float vv[8];
#pragma unroll
                for (int j = 0; j < 8; ++j) {
                  const float xx = (float)((p1 * (t1 + j)) & 127) * (1.f / 128.f);
                  const float cv = __builtin_amdgcn_cosf(xx), sv = __builtin_amdgcn_sinf(xx);
                  vv[j] = op == 0 ? (part == 0 ? cv : sv) : (part == 0 ? -sv : cv);
                }
                uint4 o; o.x = pk2(vv[0], vv[1]); o.y = pk2(vv[2], vv[3]); o.z = pk2(vv[4], vv[5]); o.w = pk2(vv[6], vv[7]); return o;
              },
              [&](int row, int k) {
                const int n = 2 * ct + (row >> 6), t2 = row & 63, part = k >> 7, t1 = k & 127;
                const bf16_t* src = ZT + (size_t)(n * 2 + part) * S_ + CTX + 64 * t1 + t2;
                unsigned e[8];
#pragma unroll
                for (int j = 0; j < 8; ++j) e[j] = src[64 * j];
                uint4 o; o.x = e[0] | (e[1] << 16); o.y = e[2] | (e[3] << 16); o.z = e[4] | (e[5] << 16); o.w = e[6] | (e[7] << 16); return o;
              }, smem, nullptr, 0);
#pragma unroll
          for (int mi = 0; mi < 2; ++mi) {
            const int row = 32 * w + 16 * mi + fr, p1 = mt * 64 + (row >> 1), op = row & 1;
#pragma unroll
            for (int ni = 0; ni < 8; ++ni) {
              const int col = 16 * ni + 4 * fq, n = 2 * ct + (col >> 6), t2 = col & 63;
              f32x4 v = acc[mi][ni], o;
#pragma unroll
              for (int j = 0; j < 4; ++j) {
                const float other = __shfl_xor(v[j], 1);
                const float xx = (float)((p1 * (t2 + j)) & 8191) * (1.f / 8192.f);
                const float cv = __builtin_amdgcn_cosf(xx), sv = __builtin_amdgcn_sinf(xx);
                o[j] = op == 0 ? (v[j] * cv + other * sv) : (v[j] * cv - other * sv);
              }
              store_bf16_row(ApT, 128, p1 * 512 + n, op * 64 + t2, o);
            }
          }
        } else if (t < NF) {
          const int tt = t - 512, mt = tt >> 2, nt = tt & 3;
          const int T = 256, tmask = T - 1;
          const float invT = 1.f / (float)T;
          f32x4 acc[2][8]; zero_acc(acc);
          block_gemm<false>(acc, 2 * T / 64,
              [&](int row, int k) {
                const int pp = mt * 128 + row, part = k >= T, t0 = k & tmask; float vv[8];
#pragma unroll
                for (int j = 0; j < 8; ++j) { const int mm = (pp * (t0 + j)) & tmask; const float xx = (float)mm * invT; vv[j] = part ? __builtin_amdgcn_sinf(xx) : __builtin_amdgcn_cosf(xx); }
                uint4 o; o.x = pk2(vv[0], vv[1]); o.y = pk2(vv[2], vv[3]); o.z = pk2(vv[4], vv[5]); o.w = pk2(vv[6], vv[7]); return o;
              },
              [&](int row, int k) { const int part = k >= T, t0 = k & tmask; return *(const uint4*)(ZT + (size_t)((nt * 128 + row) * 2 + part) * S_ + t0); },
              smem, nullptr, 0);
#pragma unroll
          for (int mi = 0; mi < 2; ++mi)
#pragma unroll
            for (int ni = 0; ni < 8; ++ni) {
              const int pp = mt * 128 + 32 * w + 16 * mi + fr, n = nt * 128 + 16 * ni + 4 * fq, b = n >> 8;
              f32x4 v = acc[mi][ni]; v *= (1.f / 128.f);
              store_bf16_row(Hb, LDH, b * S_ + pp, 768 + (n & 255), v);
            }
        } else {
          const int ta = t - NF, sd = ta / NCH, n = ta % NCH;
          const int dir = sd / 12, b = (sd / 6) & 1, h = sd % 6;
          const int r0 = b * S_ + n * 128;
          float* sW = sF;
          __syncthreads();
          if (w == 0) {
            const GateScan g = gate_scan(Gt, r0, dir, h, lane);
            sW[g.pos0] = __expf(g.a0 - g.amax); sW[g.pos1] = __expf(g.a1 - g.amax);
            if (lane == 0) { CS[(sd * NCH + n) * 4 + 0] = g.amax; CS[(sd * NCH + n) * 4 + 1] = g.F; }
          }
          __syncthreads();
          f32x4 acc[2][8]; zero_acc(acc);
          const bf16_t* Ab = Vt + (size_t)(b * 768 + h * 128) * S_ + n * 128;
          const bf16_t* Bb = KcT + (size_t)(b * 768 + h * 128) * S_ + n * 128;
          block_gemm<false>(acc, 2,
              [&](int row, int k) { return *(const uint4*)(Ab + (size_t)row * S_ + k); },
              [&](int row, int k) {
                const uint4 u = *(const uint4*)(Bb + (size_t)row * S_ + k);
                uint4 o;
                o.x = pk2(bflo(u.x) * sW[k], bfhi(u.x) * sW[k + 1]); o.y = pk2(bflo(u.y) * sW[k + 2], bfhi(u.y) * sW[k + 3]);
                o.z = pk2(bflo(u.z) * sW[k + 4], bfhi(u.z) * sW[k + 5]); o.w = pk2(bflo(u.w) * sW[k + 6], bfhi(u.w) * sW[k + 7]);
                return o;
              }, smem, nullptr, 0);
          bf16_t* Sd = ST + (size_t)(sd * NCH + n) * 16384;
#pragma unroll
          for (int mi = 0; mi < 2; ++mi)
#pragma unroll
            for (int ni = 0; ni < 8; ++ni) store_bf16_row(Sd, 128, 32 * w + 16 * mi + fr, 16 * ni + 4 * fq, acc[mi][ni]);
          if (tid < 128) {
            int tix = tid; asm volatile("" : "+v"(tix));
            const uint4* krow = (const uint4*)(KcT + (size_t)(b * 768 + h * 128 + tix) * S_ + n * 128);
            float a = 0.f;
#pragma unroll
            for (int c = 0; c < 16; ++c) {
              const uint4 u = krow[c]; const float* ww = sW + 8 * c;
              a += bflo(u.x) * ww[0] + bfhi(u.x) * ww[1] + bflo(u.y) * ww[2] + bfhi(u.y) * ww[3] + bflo(u.z) * ww[4] + bfhi(u.z) * ww[5] + bflo(u.w) * ww[6] + bfhi(u.w) * ww[7];
            }
            NV[(size_t)(sd * NCH + n) * 128 + tix] = a;
          }
        }
      }
    } break;
    case 5: {
      {
        const bf16_t* ApT = (const bf16_t*)(DO + DO_F);
        for (int t = blockIdx.x; t < 512; t += gridDim.x) {
          const int p1 = t >> 2, n0 = (t & 3) * 128;
          f32x4 acc[2][8]; zero_acc(acc);
          block_gemm<false>(acc, 2,
              [&](int row, int k) { return *(const uint4*)(ApT + (size_t)(t * 128 + row) * 128 + k); },
              [&](int row, int k) {
                uint4 o = {0u, 0u, 0u, 0u};
                if (row < 64) {
                  const int part = k >> 6, t2 = k & 63; float vv[8];
#pragma unroll
                  for (int j = 0; j < 8; ++j) { const float xx = (float)((row * (t2 + j)) & 63) * (1.f / 64.f); vv[j] = part ? __builtin_amdgcn_sinf(xx) : __builtin_amdgcn_cosf(xx); }
                  o.x = pk2(vv[0], vv[1]); o.y = pk2(vv[2], vv[3]); o.z = pk2(vv[4], vv[5]); o.w = pk2(vv[6], vv[7]);
                }
                return o;
              }, smem, nullptr, 0);
#pragma unroll
          for (int mi = 0; mi < 2; ++mi) {
            const int n = n0 + 32 * w + 16 * mi + fr, b = n >> 8;
#pragma unroll
            for (int ni = 0; ni < 4; ++ni)
#pragma unroll
              for (int j = 0; j < 4; ++j) {
                const int p2 = 16 * ni + 4 * fq + j;
                Hb[(size_t)(b * S_ + CTX + p1 + 128 * p2) * LDH + 768 + (n & 255)] = f2bf(acc[mi][ni][j] * 0.0013810679320049757f);
              }
          }
        }
      }
      if (gridDim.x >= 400) convert_weights(p, 1, smem, 200, gridDim.x - 200); else convert_weights(p, 1, smem, 0, gridDim.x);
      bf16_t* ST = (bf16_t*)(AR + A0_ST);
      for (int e = blockIdx.x * 256 + tid; e < 24 * 2064; e += gridDim.x * 256) {
        const int sd = e / 2064, idx = e % 2064, dir = sd / 12;
        float cst[8];
#pragma unroll
        for (int j = 0; j < 8; ++j) cst[j] = 0.f;
        float m = 0.f;
        uint4 ring0[4], ring1[4]; float ra[4], rf[4];
#define SC_FETCH(i_, u_) do { const int n_ = chunk_ord(dir, (i_)); ra[u_] = CS[(sd * NCH + n_) * 4 + 0]; rf[u_] = CS[(sd * NCH + n_) * 4 + 1]; \
          if (idx < 2048) ring0[u_] = *(const uint4*)(ST + (size_t)(sd * NCH + n_) * 16384 + idx * 8); \
          else { const uint4* q_ = (const uint4*)(NV + (size_t)(sd * NCH + n_) * 128 + (idx - 2048) * 8); ring0[u_] = q_[0]; ring1[u_] = q_[1]; } } while (0)
#pragma unroll
        for (int u = 0; u < 4; ++u) { ring1[u] = uint4{0u, 0u, 0u, 0u}; SC_FETCH(u, u); }
        for (int i0 = 0; i0 < NCH; i0 += 4) {
#pragma unroll
          for (int u = 0; u < 4; ++u) {
            const int i = i0 + u;
            if (i < NCH) {
              const int n = chunk_ord(dir, i);
              const float amax = ra[u], F = rf[u];
              const uint4 c0 = ring0[u], c1 = ring1[u];
              if (i + 4 < NCH) SC_FETCH(i + 4, u);
              const float Mx = fmaxf(m, amax), dcy = __expf(m - Mx), scl = __expf(amax - Mx);
              if (idx < 2048) {
                uint4* ptr = (uint4*)(ST + (size_t)(sd * NCH + n) * 16384 + idx * 8);
                uint4 o; o.x = pk2(cst[0], cst[1]); o.y = pk2(cst[2], cst[3]); o.z = pk2(cst[4], cst[5]); o.w = pk2(cst[6], cst[7]);
                *ptr = o;
                cst[0] = dcy * cst[0] + scl * bflo(c0.x); cst[1] = dcy * cst[1] + scl * bfhi(c0.x);
                cst[2] = dcy * cst[2] + scl * bflo(c0.y); cst[3] = dcy * cst[3] + scl * bfhi(c0.y);
                cst[4] = dcy * cst[4] + scl * bflo(c0.z); cst[5] = dcy * cst[5] + scl * bfhi(c0.z);
                cst[6] = dcy * cst[6] + scl * bflo(c0.w); cst[7] = dcy * cst[7] + scl * bfhi(c0.w);
              } else {
                uint4* ptr = (uint4*)(NV + (size_t)(sd * NCH + n) * 128 + (idx - 2048) * 8);
                uint4 o0, o1;
                o0.x = __float_as_uint(cst[0]); o0.y = __float_as_uint(cst[1]); o0.z = __float_as_uint(cst[2]); o0.w = __float_as_uint(cst[3]);
                o1.x = __float_as_uint(cst[4]); o1.y = __float_as_uint(cst[5]); o1.z = __float_as_uint(cst[6]); o1.w = __float_as_uint(cst[7]);
                ptr[0] = o0; ptr[1] = o1;
                cst[0] = dcy * cst[0] + scl * __uint_as_float(c0.x); cst[1] = dcy * cst[1] + scl * __uint_as_float(c0.y);
                cst[2] = dcy * cst[2] + scl * __uint_as_float(c0.z); cst[3] = dcy * cst[3] + scl * __uint_as_float(c0.w);
                cst[4] = dcy * cst[4] + scl * __uint_as_float(c1.x); cst[5] = dcy * cst[5] + scl * __uint_as_float(c1.y);
                cst[6] = dcy * cst[6] + scl * __uint_as_float(c1.z); cst[7] = dcy * cst[7] + scl * __uint_as_float(c1.w);
              }
              if (idx == 0) MS[sd * NCH + n] = m;
              m = F + Mx;
            }
          }
        }
#undef SC_FETCH
      }
    } break;
    case 6: {
      const bf16_t* Vt = (const bf16_t*)(AR + A0_VT); const bf16_t* Qc = (const bf16_t*)(AR + A0_QC); const bf16_t* Kc = (const bf16_t*)(AR + A0_KC);
      const bf16_t* ST = (const bf16_t*)(AR + A0_ST); const bf16_t* Ob = (const bf16_t*)(AR + A0_O);
      float* aA = sF; float* aM = sF + 256; float* aI = sF + 512; float* aE = sF + 768; float* sN = sF + 1024; float* sQN = sF + 1280; float* sSC = sF + 1536;
      for (int t = blockIdx.x; t < 12 * NCH; t += gridDim.x) {
        const int bh = t / NCH, n = t % NCH, b = bh / 6, h = bh % 6;
        const int r0 = b * S_ + n * 128;
        __syncthreads();
        if (w < 2) {
          const int dir = w, sd = (dir * 2 + b) * 6 + h;
          const GateScan g = gate_scan(Gt, r0, dir, h, lane);
          const float mp = MS[sd * NCH + n];
          const float M0 = fmaxf(mp, g.pm0), M1 = fmaxf(mp, g.pm1);
          aA[dir * 128 + g.pos0] = __expf(g.a0 - g.amax); aA[dir * 128 + g.pos1] = __expf(g.a1 - g.amax);
          aM[dir * 128 + g.pos0] = __expf(g.amax - M0); aM[dir * 128 + g.pos1] = __expf(g.amax - M1);
          aI[dir * 128 + g.pos0] = __expf(mp - M0); aI[dir * 128 + g.pos1] = __expf(mp - M1);
          aE[dir * 128 + g.pos0] = __expf(-(g.b0 + M0)); aE[dir * 128 + g.pos1] = __expf(-(g.b1 + M1));
        } else {
          const int dir = w - 2, sd = (dir * 2 + b) * 6 + h;
          sN[dir * 128 + lane] = NV[(size_t)(sd * NCH + n) * 128 + lane];
          sN[dir * 128 + 64 + lane] = NV[(size_t)(sd * NCH + n) * 128 + 64 + lane];
        }
        __syncthreads();
        const bf16_t* Qb = Qc + (size_t)r0 * 768 + h * 128;
        const bf16_t* Kb = Kc + (size_t)r0 * 768 + h * 128;
        {
          const int qr = tid >> 1, k0 = (tid & 1) * 64;
          float sf = 0.f, sb = 0.f;
#pragma unroll
          for (int c8 = 0; c8 < 8; ++c8) {
            const uint4 u = *(const uint4*)(Qb + (size_t)qr * 768 + k0 + c8 * 8);
            const float* nf = sN + k0 + c8 * 8; const float* nb = sN + 128 + k0 + c8 * 8;
            sf += bflo(u.x) * nf[0] + bfhi(u.x) * nf[1] + bflo(u.y) * nf[2] + bfhi(u.y) * nf[3] + bflo(u.z) * nf[4] + bfhi(u.z) * nf[5] + bflo(u.w) * nf[6] + bfhi(u.w) * nf[7];
            sb += bflo(u.x) * nb[0] + bfhi(u.x) * nb[1] + bflo(u.y) * nb[2] + bfhi(u.y) * nb[3] + bflo(u.z) * nb[4] + bfhi(u.z) * nb[5] + bflo(u.w) * nb[6] + bfhi(u.w) * nb[7];
          }
          sf += __shfl_xor(sf, 1); sb += __shfl_xor(sb, 1);
          if ((tid & 1) == 0) { sQN[qr] = sf; sQN[128 + qr] = sb; }
        }
        f32x4 acc[2][8]; zero_acc(acc);
        block_gemm<false>(acc, 2,
            [&](int row, int k) { return *(const uint4*)(Qb + (size_t)row * 768 + k); },
            [&](int row, int k) { return *(const uint4*)(Kb + (size_t)row * 768 + k); }, smem, nullptr, 0);
        __syncthreads();
        {
          float rsf[2] = {0.f, 0.f}, rsb[2] = {0.f, 0.f};
#pragma unroll
          for (int ni = 0; ni < 8; ++ni) {
            const int s0 = 16 * ni + 4 * fq;
            const f32x4 ef = *(const f32x4*)(aA + s0), eb = *(const f32x4*)(aA + 128 + s0);
#pragma unroll
            for (int mi = 0; mi < 2; ++mi) {
              const int tr = 32 * w + 16 * mi + fr;
#pragma unroll
              for (int j = 0; j < 4; ++j) {
                const float sv = acc[mi][ni][j];
                rsf[mi] += (s0 + j <= tr) ? sv * ef[j] : 0.f;
                rsb[mi] += (s0 + j >= tr) ? sv * eb[j] : 0.f;
              }
            }
          }
          float cf[2], cb[2];
#pragma unroll
          for (int mi = 0; mi < 2; ++mi) {
            const int tr = 32 * w + 16 * mi + fr;
            float a = rsf[mi], c2 = rsb[mi];
            a += __shfl_xor(a, 16); a += __shfl_xor(a, 32); c2 += __shfl_xor(c2, 16); c2 += __shfl_xor(c2, 32);
            const float denf = a * aM[tr] + aI[tr] * sQN[tr], denb = c2 * aM[128 + tr] + aI[128 + tr] * sQN[128 + tr];
            const float ddf = 1.f / fmaxf(fabsf(denf), aE[tr]), ddb = 1.f / fmaxf(fabsf(denb), aE[128 + tr]);
            if (fq == 0) { sSC[tr] = aI[tr] * ddf; sSC[128 + tr] = aI[128 + tr] * ddb; }
            cf[mi] = aM[tr] * ddf; cb[mi] = aM[128 + tr] * ddb;
          }
#pragma unroll
          for (int ni = 0; ni < 8; ++ni) {
            const int s0 = 16 * ni + 4 * fq;
            const f32x4 ef = *(const f32x4*)(aA + s0), eb = *(const f32x4*)(aA + 128 + s0);
#pragma unroll
            for (int mi = 0; mi < 2; ++mi) {
              const int tr = 32 * w + 16 * mi + fr;
              f32x4 pv;
#pragma unroll
              for (int j = 0; j < 4; ++j) {
                const float df = (s0 + j <= tr) ? ef[j] * cf[mi] : 0.f;
                const float db = (s0 + j >= tr) ? eb[j] * cb[mi] : 0.f;
                pv[j] = acc[mi][ni][j] * (df + db);
              }
              uint2 o; o.x = pk2(pv[0], pv[1]); o.y = pk2(pv[2], pv[3]);
              *(uint2*)&sP[tr * LDP + s0] = o;
            }
          }
        }
        __syncthreads();
        zero_acc(acc);
        {
          const bf16_t* Vb = Vt + (size_t)(b * 768 + h * 128) * S_ + n * 128;
          block_gemm<true>(acc, 2, [&](int, int) { return uint4{0u, 0u, 0u, 0u}; },
              [&](int row, int k) { return *(const uint4*)(Vb + (size_t)row * S_ + k); }, smem, sP, LDP);
        }
#pragma unroll
        for (int dir = 0; dir < 2; ++dir) {
          const int sd = (dir * 2 + b) * 6 + h;
          const bf16_t* Cb = ST + (size_t)(sd * NCH + n) * 16384;
          block_gemm<false>(acc, 2,
              [&](int row, int k) {
                const uint4 u = *(const uint4*)(Qb + (size_t)row * 768 + k);
                const float sc = sSC[dir * 128 + row];
                uint4 o; o.x = pk2(bflo(u.x) * sc, bfhi(u.x) * sc); o.y = pk2(bflo(u.y) * sc, bfhi(u.y) * sc);
                o.z = pk2(bflo(u.z) * sc, bfhi(u.z) * sc); o.w = pk2(bflo(u.w) * sc, bfhi(u.w) * sc); return o;
              },
              [&](int row, int k) { return *(const uint4*)(Cb + (size_t)row * 128 + k); }, smem, nullptr, 0);
        }
#pragma unroll
        for (int mi = 0; mi < 2; ++mi) {
          const int tr = 32 * w + 16 * mi + fr, row = r0 + tr;
          float ss = 0.f;
#pragma unroll
          for (int ni = 0; ni < 8; ++ni)
#pragma unroll
            for (int j = 0; j < 4; ++j) ss += acc[mi][ni][j] * acc[mi][ni][j];
          ss += __shfl_xor(ss, 16); ss += __shfl_xor(ss, 32);
          const float rstd = rsqrtf(ss * (1.f / 128.f) + EPS);
#pragma unroll
          for (int ni = 0; ni < 8; ++ni) {
            const int col = h * 128 + 16 * ni + 4 * fq;
            const f32x4 gg = *(const f32x4*)(p.g_head + col);
            const uint2 ou = *(const uint2*)(Ob + (size_t)row * 768 + col);
            f32x4 v;
            v[0] = acc[mi][ni][0] * rstd * gg[0] * sigmoidf_(bflo(ou.x)); v[1] = acc[mi][ni][1] * rstd * gg[1] * sigmoidf_(bfhi(ou.x));
            v[2] = acc[mi][ni][2] * rstd * gg[2] * sigmoidf_(bflo(ou.y)); v[3] = acc[mi][ni][3] * rstd * gg[3] * sigmoidf_(bfhi(ou.y));
            store_bf16_row(Hb, LDH, row, col, v);
          }
        }
      }
    } break;
    case 7: case 10: case 15: case 18: {
      const bool is_ff2 = (ph == 10 || ph == 18);
      const int layer = ph >= 15 ? 1 : 0;
      const bool from_input = (ph == 7);
      const bf16_t* A = is_ff2 ? (const bf16_t*)AR : Hb;
      const int K = is_ff2 ? DFF : D;
      const bf16_t* Bt = (const bf16_t*)((unsigned char*)WT + (is_ff2 ? WT_FF2 : WT_OUT));
      const int gidx = is_ff2 ? 5 : 2;
      auto epi = [&](f32x4 (&acc)[2][8], int mt, int nt) {
#pragma unroll
        for (int mi = 0; mi < 2; ++mi) {
          const int row = mt * 128 + 32 * w + 16 * mi + fr;
          const float* xs = xsrc_row(p, from_input, row);
          float* xd = xdst_row(p, row);
          const float* gate = mod_row(p, layer, row) + gidx * 1024;
#pragma unroll
          for (int ni = 0; ni < 8; ++ni) {
            const int col = nt * 128 + ECOL(ni);
            const f32x4 xv = *(const f32x4*)(xs + col), gv = *(const f32x4*)(gate + col);
            f32x4 o = xv + gv * acc[mi][ni];
            *(f32x4*)(xd + col) = o;
          }
        }
      };
      const int lda = is_ff2 ? LDHID : LDH;
      gemm_phase(A, lda, Bt, K, M / 128, 8, true, epi, smem);
      if (layer == 0) {
        const int ldb = K + 64, kper = K / 4;
        float* PART = (float*)(AR + A_PART);
        for (int u = blockIdx.x; u < 32 * 4; u += gridDim.x) {
          const int tile = u >> 2, ks = u & 3, mc = tile >> 3, nt = tile & 7, mt = (mc >> 1) * NCH + (mc & 1);
          f32x4 acc[2][8]; zero_acc(acc);
          block_gemm_glds(acc, kper / 64, A + (size_t)mt * 128 * lda + ks * kper, (size_t)lda, Bt + (size_t)nt * 128 * ldb + ks * kper, (size_t)ldb, smem);
#pragma unroll
          for (int mi = 0; mi < 2; ++mi) {
            const int row = mt * 128 + 32 * w + 16 * mi + fr, rc = (row / S_) * CTX + (row % S_);
            const float* gate = mod_row(p, layer, row) + gidx * 1024;
            float* pd = PART + ((size_t)ks * 512 + rc) * 1024;
#pragma unroll
            for (int ni = 0; ni < 8; ++ni) {
              const int col = nt * 128 + ECOL(ni);
              const f32x4 gv = *(const f32x4*)(gate + col);
              *(f32x4*)(pd + col) = gv * acc[mi][ni];
            }
          }
        }
      }
    } break;
    case 8: norm_phase(p, 0, 1, false, false, 1); break;
    case 9: case 17: {
      bf16_t* Hid = (bf16_t*)AR;
      auto epi = [&](f32x4 (&acc)[2][8], int mt, int nt) {
#pragma unroll
        for (int mi = 0; mi < 2; ++mi) {
          bf16_t* hr = Hid + (size_t)(mt * 128 + 32 * w + 16 * mi + fr) * LDHID + nt * 128 + 8 * fq;
#pragma unroll
          for (int pq = 0; pq < 4; ++pq) {
            float r[8];
#pragma unroll
            for (int j = 0; j < 4; ++j) { const float a = fmaxf(acc[mi][2 * pq][j], 0.f), c2 = fmaxf(acc[mi][2 * pq + 1][j], 0.f); r[j] = a * a; r[4 + j] = c2 * c2; }
            uint4 o; o.x = pk2(r[0], r[1]); o.y = pk2(r[2], r[3]); o.z = pk2(r[4], r[5]); o.w = pk2(r[6], r[7]);
            *(uint4*)(hr + 32 * pq) = o;
          }
        }
      };
      gemm_phase(Hb, LDH, (const bf16_t*)((unsigned char*)WT + WT_FF1), D, M / 128, 32, ph == 17, epi, smem);
    } break;
    case 11: {
      norm_phase(p, 1, 0, false, false, 2);
    } break;
    case 12: {
      bf16_t* Qb = (bf16_t*)(AR + A1_Q); bf16_t* Kb = (bf16_t*)(AR + A1_K); bf16_t* Vt = (bf16_t*)(AR + A1_VT); bf16_t* GL = (bf16_t*)(AR + A1_GLU);
      const float* cT = (const float*)(ws + OFF_ROPE); const float* sT = cT + 8192 * 32;
      auto epi = [&](f32x4 (&acc)[2][8], int mt, int nt) {
        const int b = mt / NCH;
        if (nt < 12) {
#pragma unroll
          for (int mi = 0; mi < 2; ++mi) {
            const int row = mt * 128 + 32 * w + 16 * mi + fr, s = row - b * S_;
            if (s >= CTX) {
              const int tpos = s - CTX;
#pragma unroll
              for (int g2 = 0; g2 < 2; ++g2)
#pragma unroll
                for (int nn = 0; nn < 2; ++nn) {
                  const int ni = g2 * 4 + nn, d0 = 8 * fq + 4 * nn;
                  const f32x4 cc = *(const f32x4*)(cT + tpos * 32 + d0), sn = *(const f32x4*)(sT + tpos * 32 + d0);
                  const f32x4 x1 = acc[mi][ni], x2 = acc[mi][ni + 2];
                  acc[mi][ni] = x1 * cc - x2 * sn; acc[mi][ni + 2] = x2 * cc + x1 * sn;
                }
            }
          }
        }
#pragma unroll
        for (int mi = 0; mi < 2; ++mi)
#pragma unroll
          for (int ni = 0; ni < 8; ++ni) {
            const int row = mt * 128 + 32 * w + 16 * mi + fr, col = nt * 128 + ECOL(ni);
            f32x4 v = acc[mi][ni];
            if (nt < 6) { v *= 0.18033688011112042f; store_bf16_row(Qb, 768, row, col, v); }
            else if (nt < 12) store_bf16_row(Kb, 768, row, col - 768, v);
            else if (nt < 18) store_bf16_T(Vt + (size_t)b * 768 * S_, col - 1536, row - b * S_, v);
            else store_bf16_row(GL, 512, row, col - 2304, v);
          }
      };
      gemm_phase(Hb, LDH, (const bf16_t*)((unsigned char*)WT + WT_IN), D, M / 128, 22, false, epi, smem);
    } break;
    case 13: {
      const bf16_t* Qb = (const bf16_t*)(AR + A1_Q); const bf16_t* Kb = (const bf16_t*)(AR + A1_K); const bf16_t* Vt = (const bf16_t*)(AR + A1_VT);
      bf16_t* OA = (bf16_t*)(AR + A1_OA);
      const int r = lane & 31, hh = lane >> 5;
      constexpr int STAGE = 24576, SV_OFF = 8192, NKT = S_ / 64;
      for (int t = blockIdx.x; t < NB * 6 * 2 * 64; t += gridDim.x) {
        const int qt = t & 63, mp = (t >> 6) & 1, bh = t >> 7, b = bh / 6, h = bh % 6;
        const int rq0 = b * S_ + CTX + qt * 128;
        const bf16_t* Qp = Qb + (size_t)rq0 * 768 + h * 128 + mp * 64;
        const bf16_t* Kp = Kb + (size_t)b * S_ * 768 + h * 128 + mp * 64;
        const bf16_t* Vp = Vt + (size_t)(b * 768 + h * 128) * S_;
        bf16x8 qf[4];
#pragma unroll
        for (int ks = 0; ks < 4; ++ks) qf[ks] = *(const bf16x8*)(Qp + (size_t)(32 * w + r) * 768 + 16 * ks + 8 * hh);
        f32x16 o[4];
#pragma unroll
        for (int db = 0; db < 4; ++db)
#pragma unroll
          for (int i = 0; i < 16; ++i) o[db][i] = 0.f;
        float mrun = 0.f, lrun = 0.f;
        f32x16 negm;
#pragma unroll
        for (int i = 0; i < 16; ++i) negm[i] = 0.f;
        LASG unsigned char* lb = (LASG unsigned char*)smem;
        const int g8 = lane >> 3, gp = lane & 7;
#define ATT_ISSUE(st_, kt_) do { \
          _Pragma("unroll") for (int i = 0; i < 2; ++i) { const int rho = 16 * w + 8 * i + g8, key_ = (rho & ~12) | ((rho & 4) << 1) | ((rho & 8) >> 1); \
            __builtin_amdgcn_global_load_lds((const unsigned*)(Kp + (size_t)((kt_) * 64 + key_) * 768 + ((gp ^ ((rho >> 1) & 7)) * 8)), (LASG unsigned*)(lb + (st_) * STAGE + (16 * w + 8 * i) * 128 + lane * 16), 16, 0, 0); } \
          _Pragma("unroll") for (int i = 0; i < 4; ++i) { const int rho = 32 * w + 8 * i + g8; \
            __builtin_amdgcn_global_load_lds((const unsigned*)(Vp + (size_t)rho * S_ + (kt_) * 64 + ((gp ^ ((rho >> 1) & 7)) * 8)), (LASG unsigned*)(lb + (st_) * STAGE + SV_OFF + (32 * w + 8 * i) * 128 + lane * 16), 16, 0, 0); } } while (0)
        const int rsw = (r >> 1) & 7;
        __syncthreads();
        ATT_ISSUE(0, 0);
        for (int kt = 0; kt < NKT; ++kt) {
          const int st = kt & 1;
          __syncthreads();
          if (kt + 1 < NKT) ATT_ISSUE(st ^ 1, kt + 1);
          const unsigned char* sK = smem + st * STAGE; const unsigned char* sV = sK + SV_OFF;
          f32x16 sx[2];
#pragma unroll
          for (int kb = 0; kb < 2; ++kb) {
            sx[kb] = negm;
#pragma unroll
            for (int ks = 0; ks < 4; ++ks) {
              const bf16x8 kf = *(const bf16x8*)(sK + (32 * kb + r) * 128 + (((2 * ks + hh) ^ rsw) * 16));
              sx[kb] = __builtin_amdgcn_mfma_f32_32x32x16_bf16(kf, qf[ks], sx[kb], 0, 0, 0);
            }
          }
          float mx = sx[0][0];
#pragma unroll
          for (int i = 0; i < 16; ++i) { mx = fmaxf(mx, sx[0][i]); mx = fmaxf(mx, sx[1][i]); }
          mx = xor32_max(mx);
          if (kt == 0 || __any(mx > 0.f)) {
            const float dlt = (kt == 0) ? mx : fmaxf(mx, 0.f);
#pragma unroll
            for (int kb = 0; kb < 2; ++kb)
#pragma unroll
              for (int i = 0; i < 16; ++i) sx[kb][i] -= dlt;
            if (kt != 0) {
              const float alpha = __builtin_amdgcn_exp2f(-dlt);
              lrun *= alpha;
#pragma unroll
              for (int db = 0; db < 4; ++db) o[db] *= alpha;
            }
            mrun += dlt;
#pragma unroll
            for (int i = 0; i < 16; ++i) negm[i] = -mrun;
          }
          f32x2 rs2 = {0.f, 0.f};
#pragma unroll
          for (int kb = 0; kb < 2; ++kb)
#pragma unroll
            for (int i = 0; i < 16; i += 2) {
              f32x2 pv; pv.x = __builtin_amdgcn_exp2f(sx[kb][i]); pv.y = __builtin_amdgcn_exp2f(sx[kb][i + 1]);
              sx[kb][i] = pv.x; sx[kb][i + 1] = pv.y; rs2 += pv;
            }
          lrun += xor32_sum(rs2.x + rs2.y);
#pragma unroll
          for (int kb = 0; kb < 2; ++kb)
#pragma unroll
            for (int s2 = 0; s2 < 2; ++s2) {
              uint4 xp;
              xp.x = pk2(sx[kb][8 * s2 + 0], sx[kb][8 * s2 + 1]); xp.y = pk2(sx[kb][8 * s2 + 2], sx[kb][8 * s2 + 3]);
              xp.z = pk2(sx[kb][8 * s2 + 4], sx[kb][8 * s2 + 5]); xp.w = pk2(sx[kb][8 * s2 + 6], sx[kb][8 * s2 + 7]);
              const bf16x8 xs = __builtin_bit_cast(bf16x8, xp);
#pragma unroll
              for (int db = 0; db < 4; ++db) {
                const bf16x8 pa = *(const bf16x8*)(sV + (32 * db + r) * 128 + (((4 * kb + 2 * s2 + hh) ^ rsw) * 16));
                o[db] = __builtin_amdgcn_mfma_f32_32x32x16_bf16(pa, xs, o[db], 0, 0, 0);
              }
            }
        }
#undef ATT_ISSUE
        bf16_t* Od = OA + (size_t)mp * M * 768 + (size_t)(rq0 + 32 * w + r) * 768 + h * 128;
        const float inv = 1.f / lrun;
#pragma unroll
        for (int db = 0; db < 4; ++db)
#pragma unroll
          for (int g = 0; g < 4; ++g) {
            uint2 ov; ov.x = pk2(o[db][4 * g] * inv, o[db][4 * g + 1] * inv); ov.y = pk2(o[db][4 * g + 2] * inv, o[db][4 * g + 3] * inv);
            *(uint2*)(Od + 32 * db + 8 * g + 4 * hh) = ov;
          }
      }
    } break;
    case 14: {
      const bf16_t* OA = (const bf16_t*)(AR + A1_OA); const bf16_t* GL = (const bf16_t*)(AR + A1_GLU);
      const float lam_init = 0.8f - 0.6f * 0.7408182206817179f;
      {
        float l1 = p.lam_p[lane] * p.lam_p[64 + lane], l2 = p.lam_p[128 + lane] * p.lam_p[192 + lane];
        l1 = wsum(l1); l2 = wsum(l2);
        const float lam = __expf(l1) - __expf(l2) + lam_init;
        const int gw = blockIdx.x * 4 + w, ngw = gridDim.x * 4;
        const int l16 = lane & 15, g4 = lane >> 4;
        const f32x4 gs0 = *(const f32x4*)(p.g_sub + 8 * l16), gs1 = *(const f32x4*)(p.g_sub + 8 * l16 + 4);
        for (int it = gw; it < NB * SEQ * 6 / 4; it += ngw) {
          const int item = it * 4 + g4, rl = item / 6, h = item - rl * 6;
          const int b = rl / SEQ, tpos = rl % SEQ, row = b * S_ + CTX + tpos;
          const uint4 u0 = *(const uint4*)(OA + (size_t)row * 768 + h * 128 + 8 * l16);
          const uint4 u1 = *(const uint4*)(OA + (size_t)M * 768 + (size_t)row * 768 + h * 128 + 8 * l16);
          float o[8];
          o[0] = bflo(u0.x) - lam * bflo(u1.x); o[1] = bfhi(u0.x) - lam * bfhi(u1.x); o[2] = bflo(u0.y) - lam * bflo(u1.y); o[3] = bfhi(u0.y) - lam * bfhi(u1.y);
          o[4] = bflo(u0.z) - lam * bflo(u1.z); o[5] = bfhi(u0.z) - lam * bfhi(u1.z); o[6] = bflo(u0.w) - lam * bflo(u1.w); o[7] = bfhi(u0.w) - lam * bfhi(u1.w);
          float ss = 0.f;
#pragma unroll
          for (int e = 0; e < 8; ++e) ss += o[e] * o[e];
          ss += __shfl_xor(ss, 1); ss += __shfl_xor(ss, 2); ss += __shfl_xor(ss, 4); ss += __shfl_xor(ss, 8);
          const float rstd = rsqrtf(ss * (1.f / 128.f) + EPS) * (1.f - lam_init);
          uint4 ov;
          ov.x = pk2(o[0] * rstd * gs0[0], o[1] * rstd * gs0[1]); ov.y = pk2(o[2] * rstd * gs0[2], o[3] * rstd * gs0[3]);
          ov.z = pk2(o[4] * rstd * gs1[0], o[5] * rstd * gs1[1]); ov.w = pk2(o[6] * rstd * gs1[2], o[7] * rstd * gs1[3]);
          *(uint4*)(Hb + (size_t)row * LDH + h * 128 + 8 * l16) = ov;
        }
      }
      {
        float* su = (float*)smem;
        for (int t = blockIdx.x; t < NB * SEQ / 32; t += gridDim.x) {
          const int b = t / (SEQ / 32), t0 = (t % (SEQ / 32)) * 32;
          __syncthreads();
          for (int i = tid; i < 62 * 64; i += 256) {
            const int rr = i >> 6, c4 = (i & 63) * 4, tp = t0 + rr - 15;
            f32x4 u = {0.f, 0.f, 0.f, 0.f};
            if (tp >= 0 && tp < SEQ) {
              const size_t ro = (size_t)(b * S_ + CTX + tp) * 512;
              const uint2 av = *(const uint2*)(GL + ro + c4), gv = *(const uint2*)(GL + ro + 256 + c4);
              u[0] = bflo(av.x) * sigmoidf_(bflo(gv.x)); u[1] = bfhi(av.x) * sigmoidf_(bfhi(gv.x));
              u[2] = bflo(av.y) * sigmoidf_(bflo(gv.y)); u[3] = bfhi(av.y) * sigmoidf_(bfhi(gv.y));
            }
            *(f32x4*)(su + rr * 256 + c4) = u;
          }
          __syncthreads();
          float z[32], wj[31];
#pragma unroll
          for (int tt = 0; tt < 32; ++tt) z[tt] = 0.f;
#pragma unroll
          for (int j = 0; j < 31; ++j) wj[j] = p.w_dw[j * 256 + tid];
#pragma unroll
          for (int rr = 0; rr < 62; ++rr) {
            const float u = su[rr * 256 + tid];
#pragma unroll
            for (int tt = 0; tt < 32; ++tt) { const int j = rr - tt; if (j >= 0 && j < 31) z[tt] += wj[j] * u; }
          }
          __syncthreads();
#pragma unroll
          for (int tt = 0; tt < 32; ++tt) su[tt * 256 + tid] = z[tt];
          __syncthreads();
          for (int tt = w; tt < 32; tt += 4) {
            f32x4 v = *(const f32x4*)(su + tt * 256 + 4 * lane);
            const float mu = wsum(v[0] + v[1] + v[2] + v[3]) * (1.f / 256.f);
            v -= mu;
            const float rstd = rsqrtf(wsum(v[0] * v[0] + v[1] * v[1] + v[2] * v[2] + v[3] * v[3]) * (1.f / 256.f) + EPS);
            const f32x4 gl = *(const f32x4*)(p.g_cln + 4 * lane), bl = *(const f32x4*)(p.b_cln + 4 * lane);
            float y[4];
#pragma unroll
            for (int e = 0; e < 4; ++e) y[e] = siluf_(v[e] * rstd * gl[e] + bl[e]);
            uint2 o; o.x = pk2(y[0], y[1]); o.y = pk2(y[2], y[3]);
            *(uint2*)(Hb + (size_t)(b * S_ + CTX + t0 + tt) * LDH + 768 + 4 * lane) = o;
          }
        }
      }
    } break;
    case 16: norm_phase(p, 1, 1, false, true); break;
    case 19: {
      const int gw = blockIdx.x * 4 + w, ngw = gridDim.x * 4;
      for (int r = gw; r < NB * SEQ; r += ngw) {
        f32x4* xr = (f32x4*)(p.out + (size_t)r * D) + lane;
        f32x4 v[4]; float ss = 0.f;
#pragma unroll
        for (int j = 0; j < 4; ++j) { v[j] = xr[64 * j]; ss += v[j][0] * v[j][0] + v[j][1] * v[j][1] + v[j][2] * v[j][2] + v[j][3] * v[j][3]; }
        const float rstd = rsqrtf(wsum(ss) * (1.f / D) + EPS);
#pragma unroll
        for (int j = 0; j < 4; ++j) { const f32x4 gg = *(const f32x4*)(p.g_final + 4 * lane + 256 * j); xr[64 * j] = v[j] * rstd * gg; }
      }
    } break;
    default: break;
    }
}

__global__ void __launch_bounds__(256, LB2) mega(Params p) {
  extern __shared__ __attribute__((aligned(16))) unsigned char smem[];
  {
    volatile LAS unsigned* st = (volatile LAS unsigned*)(smem + LDS_BYTES - 16);
    if (threadIdx.x == 0) { st[0] = 0u; st[1] = 0u; }
    __syncthreads();
  }
  if (p.ph_hi == 7777) cg::this_grid().sync();
  const XcdBarrier xb = xcd_barrier_post((unsigned*)(p.ws + OFF_BAR), (volatile LAS unsigned*)(smem + LDS_BYTES - 16));
#ifndef REP_PH
#define REP_PH -1
#endif
#define RUN(k) if (p.ph_lo <= k && k < p.ph_hi) { if (k > p.ph_lo) { xcd_barrier(xb); } run_phase<k>(p, smem); \
    if (k == REP_PH) { xcd_barrier(xb); run_phase<k>(p, smem); } }
  RUN(0) RUN(1) RUN(2) RUN(3) RUN(4) RUN(5) RUN(6) RUN(7) RUN(8) RUN(9) RUN(10) RUN(11) RUN(12) RUN(13) RUN(14) RUN(15) RUN(16) RUN(17) RUN(18) RUN(19)
#undef RUN
  if (p.ph_lo == 20) {
    const bf16_t* src = (const bf16_t*)(p.ws + DUMP_OFF);
    for (size_t i = (size_t)blockIdx.x * 256 + threadIdx.x; i < (size_t)NB * SEQ * D; i += (size_t)gridDim.x * 256) p.out[i] = bf2f(src[i]) + bf2f(((const bf16_t*)(p.ws + OFF_H))[i]);
  }
}

extern "C" void kernel_launch(void* const* d_in, const int* in_sizes, int n_in, void* d_out, int out_size, void* d_ws, size_t ws_size, hipStream_t stream) {
  static int grid_blocks = 0;
  if (!grid_blocks) {
    if (ws_size < WS_NEED) { fprintf(stderr, "kernel_launch: workspace too small: %zu < %zu\n", ws_size, (size_t)WS_NEED); grid_blocks = -1; return; }
    int dev = 0, cus = 0, per_cu = 0;
    hipGetDevice(&dev);
    hipDeviceGetAttribute(&cus, hipDeviceAttributeMultiprocessorCount, dev);
    hipFuncSetAttribute((const void*)mega, hipFuncAttributeMaxDynamicSharedMemorySize, LDS_BYTES);
    hipOccupancyMaxActiveBlocksPerMultiprocessor(&per_cu, (const void*)mega, 256, LDS_BYTES);
    if (per_cu < 1) per_cu = 1;
    if (per_cu > 2) per_cu = 2;
    grid_blocks = cus * per_cu;
    fprintf(stderr, "kernel_launch: cus %d per_cu %d grid %d ws %zu\n", cus, per_cu, grid_blocks, ws_size);
  }
  if (grid_blocks < 0) return;
  Params p{};
  const float** pp = (const float**)&p;
  for (int i = 0; i < 22; ++i) pp[i] = (const float*)d_in[i];
  p.out = (float*)d_out; p.ws = (unsigned char*)d_ws;
#if MULTI_LAUNCH
  for (int ph = 0; ph < NPH_RUN; ++ph) {
    p.ph_lo = ph; p.ph_hi = ph + 1;
    hipLaunchKernelGGL(mega, dim3(grid_blocks), dim3(256), LDS_BYTES, stream, p);
  }
#if NPH_RUN < 20
  p.ph_lo = 20; p.ph_hi = 21;
  hipLaunchKernelGGL(mega, dim3(grid_blocks), dim3(256), LDS_BYTES, stream, p);
#endif
#else
  hipMemsetAsync((unsigned char*)d_ws + OFF_BAR, 0, XCD_BAR_WORDS * 4, stream);
  p.ph_lo = 0; p.ph_hi = NPH;
  void* args[] = {&p};
  hipError_t e = hipLaunchCooperativeKernel((void*)mega, dim3(grid_blocks), dim3(256), args, LDS_BYTES, stream);
  if (e != hipSuccess) fprintf(stderr, "cooperative launch failed: %s (grid %d)\n", hipGetErrorString(e), grid_blocks);
#endif
}
```

```cpp
#include <hip/hip_runtime.h>
#include <hip/hip_cooperative_groups.h>
#include <cstdio>
#include <cstdint>
namespace cg = cooperative_groups;

#ifndef LB2
#define LB2 2
#endif
#ifndef NPH_RUN
#define NPH_RUN 20
#endif
#ifndef DUMP_OFF
#define DUMP_OFF (OFF_AR + A0_QK)
#endif
#ifndef MULTI_LAUNCH
#define MULTI_LAUNCH 0
#endif

typedef unsigned short bf16_t;
typedef short bf16x8 __attribute__((ext_vector_type(8)));
typedef float f32x4 __attribute__((ext_vector_type(4)));
typedef float f32x16 __attribute__((ext_vector_type(16)));
#define DEV __device__ __forceinline__

constexpr int D = 1024, NB = 2, SEQ = 8192, CTX = 256, S_ = SEQ + CTX, M = NB * S_, DFF = 4096;
constexpr int LDH = D + 64, LDHID = DFF + 64;
constexpr int NCH = S_ / 128;
constexpr int NPH = 20;
constexpr float EPS = 1e-6f;

constexpr size_t OFF_MOD = 0;
constexpr size_t MOD_BYTES = 2 * 3 * 6144 * 4;
constexpr size_t OFF_ROPE = 0x40000;
constexpr size_t OFF_XC = 0x240000;
constexpr size_t OFF_G = 0x440000;
constexpr size_t OFF_CS = 0x5D0000;
constexpr size_t OFF_MS = 0x5D8000;
constexpr size_t OFF_NV = 0x5DA000;
constexpr size_t OFF_WT = 0x700000;
constexpr size_t WT_IN = 0, WT_OUT = 0x770000, WT_FF1 = 0x990000, WT_FF2 = 0x1210000;
constexpr size_t OFF_H = 0x2200000;
constexpr size_t OFF_AR = 0x4510000;
constexpr size_t A0_QK = 0, A0_ST = 0, A0_VT = 0x3180000, A0_O = 0x4A40000, A0_QC = 0x6300000, A0_KC = 0x7BC0000;
constexpr size_t DO_KCT = 0, DO_ZT = 0x18C0000, DO_F = 0x2940000;
constexpr size_t A1_Q = 0, A1_K = 0x18C0000, A1_VT = 0x3180000, A1_GLU = 0x4A40000, A1_OA = 0x5AC0000;
constexpr size_t OFF_WT2 = OFF_AR + 0x9480000;
constexpr size_t WS_NEED = OFF_WT2 + 0x1A30000;

struct Params {
  const float *x, *c, *ctx, *c_ctx, *w_mod, *b_mod, *g_norm, *w_in_even, *b_gate, *w_qk_conv, *g_head, *w_out_even,
      *w_in_odd, *lam_p, *g_sub, *w_dw, *g_cln, *b_cln, *w_out_odd, *w_ff1, *w_ff2, *g_final;
  float* out;
  unsigned char* ws;
  int ph_lo, ph_hi;
};

typedef float f32x2 __attribute__((ext_vector_type(2)));
typedef __bf16 bf16x2_t __attribute__((ext_vector_type(2)));
DEV unsigned pk2(float lo, float hi) { f32x2 v = {lo, hi}; bf16x2_t b = __builtin_convertvector(v, bf16x2_t); return __builtin_bit_cast(unsigned, b); }
DEV bf16_t f2bf(float f) { return (bf16_t)(pk2(f, 0.f) & 0xffff); }
DEV float bf2f(unsigned h) { return __uint_as_float(h << 16); }
DEV float bflo(unsigned u) { return __uint_as_float(u << 16); }
DEV float bfhi(unsigned u) { return __uint_as_float(u & 0xffff0000u); }
DEV float wsum(float v) { for (int o = 32; o; o >>= 1) v += __shfl_xor(v, o); return v; }
DEV float xor32_max(float v) { auto r = __builtin_amdgcn_permlane32_swap(__float_as_uint(v), __float_as_uint(v), false, false); return fmaxf(__uint_as_float(r[0]), __uint_as_float(r[1])); }
DEV float xor32_sum(float v) { auto r = __builtin_amdgcn_permlane32_swap(__float_as_uint(v), __float_as_uint(v), false, false); return __uint_as_float(r[0]) + __uint_as_float(r[1]); }
DEV float sigmoidf_(float x) { return __builtin_amdgcn_rcpf(1.f + __expf(-x)); }
DEV float siluf_(float x) { return x * __builtin_amdgcn_rcpf(1.f + __expf(-x)); }
DEV float logsigf_(float x) { return fminf(x, 0.f) - log1pf(__expf(-fabsf(x))); }

constexpr int LDT = 72;
constexpr int LDP = 136;
constexpr int LDS_A = 0, LDS_B = 18432, LDS_P = 36864, LDS_F = 71680, LDS_BYTES = 79872;

template <bool A_LDS, class LA, class LB>
DEV void block_gemm(f32x4 (&acc)[2][8], int nk, LA la, LB lb, unsigned char* smem, const bf16_t* pA, int ldp) {
  bf16_t* sA = (bf16_t*)(smem + LDS_A);
  bf16_t* sB = (bf16_t*)(smem + LDS_B);
  const int tid = threadIdx.x, lane = tid & 63, w = tid >> 6;
  const int srow = tid >> 3, scol = (tid & 7) * 8;
  const int fr = lane & 15, fq = lane >> 4;
  uint4 ra[4], rb[4];
#pragma unroll
  for (int i = 0; i < 4; ++i) { if (!A_LDS) ra[i] = la(srow + 32 * i, scol); rb[i] = lb(srow + 32 * i, scol); }
  for (int kt = 0; kt < nk; ++kt) {
    __syncthreads();
#pragma unroll
    for (int i = 0; i < 4; ++i) {
      if (!A_LDS) *(uint4*)&sA[(srow + 32 * i) * LDT + scol] = ra[i];
      *(uint4*)&sB[(srow + 32 * i) * LDT + scol] = rb[i];
    }
    __syncthreads();
    if (kt + 1 < nk) {
#pragma unroll
      for (int i = 0; i < 4; ++i) { if (!A_LDS) ra[i] = la(srow + 32 * i, (kt + 1) * 64 + scol); rb[i] = lb(srow + 32 * i, (kt + 1) * 64 + scol); }
    }
#pragma unroll
    for (int kk = 0; kk < 2; ++kk) {
      bf16x8 af[2], bfr[8];
#pragma unroll
      for (int mi = 0; mi < 2; ++mi) {
        if (A_LDS) af[mi] = *(const bf16x8*)&pA[(32 * w + 16 * mi + fr) * ldp + kt * 64 + kk * 32 + 8 * fq];
        else af[mi] = *(const bf16x8*)&sA[(32 * w + 16 * mi + fr) * LDT + kk * 32 + 8 * fq];
      }
#pragma unroll
      for (int ni = 0; ni < 8; ++ni) bfr[ni] = *(const bf16x8*)&sB[(16 * ni + fr) * LDT + kk * 32 + 8 * fq];
#pragma unroll
      for (int mi = 0; mi < 2; ++mi)
#pragma unroll
        for (int ni = 0; ni < 8; ++ni) acc[mi][ni] = __builtin_amdgcn_mfma_f32_16x16x32_bf16(bfr[ni], af[mi], acc[mi][ni], 0, 0, 0);
    }
  }
}

DEV void zero_acc(f32x4 (&acc)[2][8]) {
#pragma unroll
  for (int mi = 0; mi < 2; ++mi)
#pragma unroll
    for (int ni = 0; ni < 8; ++ni) acc[mi][ni] = (f32x4){0.f, 0.f, 0.f, 0.f};
}

#define LASG __attribute__((address_space(3)))
DEV void block_gemm_glds(f32x4 (&acc)[2][8], int nk, const bf16_t* Ag, size_t lda, const bf16_t* Bg, size_t ldb, unsigned char* smem) {
  const int tid = threadIdx.x, lane = tid & 63, w = tid >> 6;
  const int srow = tid >> 3, sc = ((tid & 7) ^ (srow & 7)) * 8;
  const int fr = lane & 15, fq = lane >> 4;
  const bf16_t* ag = Ag + (size_t)srow * lda + sc;
  const bf16_t* bg = Bg + (size_t)(8 * ((srow >> 2) & 3) + 4 * (srow >> 4) + (srow & 3)) * ldb + sc;
  LASG unsigned char* lbase = (LASG unsigned char*)smem;
#define GLDS_ISSUE(st_, k0_) do { \
    _Pragma("unroll") for (int i = 0; i < 4; ++i) { \
      __builtin_amdgcn_global_load_lds((const unsigned*)(ag + (size_t)(32 * i) * lda + (k0_)), (LASG unsigned*)(lbase + (st_) * 32768 + (tid + 256 * i) * 16), 16, 0, 0); \
      __builtin_amdgcn_global_load_lds((const unsigned*)(bg + (size_t)(32 * i) * ldb + (k0_)), (LASG unsigned*)(lbase + (st_) * 32768 + 16384 + (tid + 256 * i) * 16), 16, 0, 0); } } while (0)
  __syncthreads();
  GLDS_ISSUE(0, 0);
  for (int kt = 0; kt < nk; ++kt) {
    __syncthreads();
    if (kt + 1 < nk) GLDS_ISSUE((kt + 1) & 1, (kt + 1) * 64);
    const unsigned char* sA = smem + (kt & 1) * 32768;
    const unsigned char* sB = sA + 16384;
#pragma unroll
    for (int kk = 0; kk < 2; ++kk) {
      const int swz = ((kk * 4 + fq) ^ (fr & 7)) * 16;
      bf16x8 af[2], bfr[8];
#pragma unroll
      for (int mi = 0; mi < 2; ++mi) af[mi] = *(const bf16x8*)(sA + (32 * w + 16 * mi + fr) * 128 + swz);
#pragma unroll
      for (int ni = 0; ni < 8; ++ni) bfr[ni] = *(const bf16x8*)(sB + (16 * ni + fr) * 128 + swz);
#pragma unroll
      for (int mi = 0; mi < 2; ++mi)
#pragma unroll
        for (int ni = 0; ni < 8; ++ni) acc[mi][ni] = __builtin_amdgcn_mfma_f32_16x16x32_bf16(bfr[ni], af[mi], acc[mi][ni], 0, 0, 0);
    }
  }
#undef GLDS_ISSUE
}

DEV void block_gemm_glds2(f32x4 (&acc0)[2][8], f32x4 (&acc1)[2][8], int nk, const bf16_t* Ag, size_t lda, const bf16_t* Bg, size_t ldb, unsigned char* smem) {
  const int tid = threadIdx.x, lane = tid & 63, w = tid >> 6;
  const int fr = lane & 15, fq = lane >> 4;
  const int lr = lane >> 2, lp = lane & 3;
  const int sc = (lp ^ ((0x78 >> (2 * ((lr >> 2) & 3))) & 3)) * 8;
  const bf16_t* ag = Ag + (size_t)(32 * w + lr) * lda + sc;
  const bf16_t* bg = Bg + (size_t)(64 * w + lr) * ldb + sc;
  LASG unsigned char* lbase = (LASG unsigned char*)smem;
#define G2_ISSUE(st_, k0_) do { \
    _Pragma("unroll") for (int i = 0; i < 2; ++i) \
      __builtin_amdgcn_global_load_lds((const unsigned*)(ag + (size_t)(16 * i) * lda + (k0_)), (LASG unsigned*)(lbase + (st_) * 24576 + (32 * w + 16 * i) * 64 + lane * 16), 16, 0, 0); \
    _Pragma("unroll") for (int i = 0; i < 4; ++i) \
      __builtin_amdgcn_global_load_lds((const unsigned*)(bg + (size_t)(16 * i) * ldb + (k0_)), (LASG unsigned*)(lbase + (st_) * 24576 + 8192 + (64 * w + 16 * i) * 64 + lane * 16), 16, 0, 0); } while (0)
  __syncthreads();
  G2_ISSUE(0, 0);
  if (nk > 1) G2_ISSUE(1, 32);
  const int roff = (fq ^ ((0x78 >> (2 * ((fr >> 2) & 3))) & 3)) * 16 + fr * 64;
  int st = 0;
  for (int kt = 0; kt < nk; ++kt) {
    if (kt + 1 < nk) asm volatile("s_waitcnt vmcnt(6)" ::: "memory"); else asm volatile("s_waitcnt vmcnt(0)" ::: "memory");
    __builtin_amdgcn_s_barrier();
    asm volatile("" ::: "memory");
    if (kt + 2 < nk) { const int st2 = st >= 1 ? st - 1 : 2; G2_ISSUE(st2, (kt + 2) * 32); }
    const unsigned char* sA = smem + st * 24576;
    const unsigned char* sB = sA + 8192;
    bf16x8 af[2];
#pragma unroll
    for (int mi = 0; mi < 2; ++mi) af[mi] = *(const bf16x8*)(sA + (32 * w + 16 * mi) * 64 + roff);
    {
      bf16x8 bfr[8];
#pragma unroll
      for (int ni = 0; ni < 8; ++ni) bfr[ni] = *(const bf16x8*)(sB + (16 * ni) * 64 + roff);
#pragma unroll
      for (int mi = 0; mi < 2; ++mi)
#pragma unroll
        for (int ni = 0; ni < 8; ++ni) acc0[mi][ni] = __builtin_amdgcn_mfma_f32_16x16x32_bf16(bfr[ni], af[mi], acc0[mi][ni], 0, 0, 0);
    }
    {
      bf16x8 bfr[8];
#pragma unroll
      for (int ni = 0; ni < 8; ++ni) bfr[ni] = *(const bf16x8*)(sB + (128 + 16 * ni) * 64 + roff);
#pragma unroll
      for (int mi = 0; mi < 2; ++mi)
#pragma unroll
        for (int ni = 0; ni < 8; ++ni) acc1[mi][ni] = __builtin_amdgcn_mfma_f32_16x16x32_bf16(bfr[ni], af[mi], acc1[mi][ni], 0, 0, 0);
    }
    st = st == 2 ? 0 : st + 1;
  }
#undef G2_ISSUE
}

constexpr size_t OFF_BAR = 0x28000;
#define XB_TMO      128
#define XB_XCNT(j)  (256  + 64 * (j))
#define XB_XSUB(j)  (1280 + 64 * (j))
#define XB_XGEN(j)  (2304 + 64 * (j))
#define XB_TOP      3328
#define XB_TOPGEN   3392
#define XCD_BAR_WORDS 3456
#define XB_SPIN_CAP (1u << 18)
#define LAS __attribute__((address_space(3)))

__device__ __forceinline__ unsigned xb_ld(unsigned* p)              { return __hip_atomic_load(p, __ATOMIC_RELAXED, __HIP_MEMORY_SCOPE_AGENT); }
__device__ __forceinline__ unsigned xb_add(unsigned* p, unsigned v) { return __hip_atomic_fetch_add(p, v, __ATOMIC_RELAXED, __HIP_MEMORY_SCOPE_AGENT); }
__device__ __forceinline__ unsigned xb_xcc_id() { return (unsigned)__builtin_amdgcn_s_getreg((3 << 11) | 20) & 0xFu; }
#define XB_SPIN(cond, bar) do { unsigned _sp = 0; while (cond) { __builtin_amdgcn_s_sleep(1); \
    if ((++_sp & 255u) == 0u) { if (xb_ld(&(bar)[XB_TMO])) break; if (_sp > XB_SPIN_CAP) { atomicAdd(&(bar)[XB_TMO], 1u); break; } } } } while (0)

struct XcdBarrier {
    unsigned* bar; unsigned x;
    volatile LAS unsigned* st;
};

__device__ __forceinline__ XcdBarrier xcd_barrier_post(unsigned* bar, volatile LAS unsigned* st) {
    XcdBarrier b; b.bar = bar; b.x = xb_xcc_id(); b.st = st;
    if (threadIdx.x == 0) (void)xb_add(&bar[XB_XCNT(b.x)], 1u);
    return b;
}
__device__ __forceinline__ void xcd_barrier_complete(unsigned* bar, unsigned x, unsigned& nloc, unsigned& nx) {
    const unsigned G = gridDim.x * gridDim.y * gridDim.z;
    unsigned sum, cnt, mine, sp = 0u;
    for (;;) {
        sum = 0u; cnt = 0u; mine = 0u;
#pragma unroll
        for (unsigned j = 0; j < 16; ++j) { const unsigned c = xb_ld(&bar[XB_XCNT(j)]); sum += c; cnt += (c > 0u) ? 1u : 0u; mine = (j == x) ? c : mine; }
        if (sum == G) break;
        __builtin_amdgcn_s_sleep(1);
        if ((++sp & 255u) == 0u) { if (xb_ld(&bar[XB_TMO])) break; if (sp > XB_SPIN_CAP) { atomicAdd(&bar[XB_TMO], 1u); break; } }
    }
    nloc = mine > 0u ? mine : 1u; nx = cnt > 0u ? cnt : 1u;
}

__device__ __forceinline__ void xcd_barrier(const XcdBarrier& b) {
    asm volatile("s_waitcnt vmcnt(0)" ::: "memory");
    __syncthreads();
    if (threadIdx.x == 0) {
        unsigned* bar = b.bar;
        __builtin_amdgcn_s_waitcnt(0);
        unsigned nloc = b.st[0], nx = b.st[1];
        if (nloc == 0u) { xcd_barrier_complete(bar, b.x, nloc, nx); b.st[0] = nloc; b.st[1] = nx; }
        const unsigned old = xb_add(&bar[XB_XSUB(b.x)], 1u);
        const unsigned gen = old / nloc;
        if (old + 1u == (gen + 1u) * nloc) {
            __builtin_amdgcn_fence(__ATOMIC_RELEASE, "agent");
            asm volatile("s_waitcnt vmcnt(0)" ::: "memory");
            const unsigned og = xb_add(&bar[XB_TOP], 1u);
            const unsigned tg = og / nx;
            if (og + 1u == (tg + 1u) * nx) xb_add(&bar[XB_TOPGEN], 1u);
            else XB_SPIN(xb_ld(&bar[XB_TOPGEN]) == tg, bar);
            __builtin_amdgcn_fence(__ATOMIC_ACQUIRE, "agent");
            xb_add(&bar[XB_XGEN(b.x)], 1u);
            asm volatile("s_waitcnt vmcnt(0)" ::: "memory");
        } else {
            XB_SPIN(xb_ld(&bar[XB_XGEN(b.x)]) == gen, bar);
            __builtin_amdgcn_fence(__ATOMIC_ACQUIRE, "agent");
            asm volatile("s_waitcnt vmcnt(0)" ::: "memory");
        }
    }
    __syncthreads();
}

DEV const float* xsrc_row(const Params& p, bool from_input, int r) {
  const int b = r / S_, s = r - b * S_;
  if (from_input) return s < CTX ? p.ctx + (size_t)(b * CTX + s) * D : p.x + (size_t)(b * SEQ + s - CTX) * D;
  return s < CTX ? (const float*)(p.ws + OFF_XC) + (size_t)(b * CTX + s) * D : p.out + (size_t)(b * SEQ + s - CTX) * D;
}
DEV float* xdst_row(const Params& p, int r) {
  const int b = r / S_, s = r - b * S_;
  return s < CTX ? (float*)(p.ws + OFF_XC) + (size_t)(b * CTX + s) * D : p.out + (size_t)(b * SEQ + s - CTX) * D;
}
DEV const float* mod_row(const Params& p, int layer, int r) {
  const int b = r / S_, s = r - b * S_;
  return (const float*)(p.ws + OFF_MOD) + (size_t)(layer * 3 + (s < CTX ? 2 : b)) * 6144;
}

DEV void transpose_tile(const float* W, int K, int N, bf16_t* WT, int remap, int kt, int nt, unsigned char* smem) {
  float* tile = (float*)smem;
  const int tid = threadIdx.x;
  __syncthreads();
#pragma unroll
  for (int i = 0; i < 4; ++i) {
    const int kk = (tid >> 4) + 16 * i, c4 = (tid & 15) * 4;
    const int n = nt * 64 + c4;
    int src = n;
    if (remap) src = n < 3072 ? n : (n < 3328 ? n + 24 : (n < 3352 ? n - 256 : -1));
    else if (n >= N) src = -1;
    f32x4 v = (f32x4){0.f, 0.f, 0.f, 0.f};
    if (src >= 0) v = *(const f32x4*)(W + (size_t)(kt * 64 + kk) * N + src);
    tile[kk * 65 + c4 + 0] = v[0]; tile[kk * 65 + c4 + 1] = v[1]; tile[kk * 65 + c4 + 2] = v[2]; tile[kk * 65 + c4 + 3] = v[3];
  }
  __syncthreads();
  const int n = tid >> 2, kc = (tid & 3) * 16;
  uint4 o0, o1;
  const float* t = tile + kc * 65 + n;
  o0.x = pk2(t[0 * 65], t[1 * 65]); o0.y = pk2(t[2 * 65], t[3 * 65]); o0.z = pk2(t[4 * 65], t[5 * 65]); o0.w = pk2(t[6 * 65], t[7 * 65]);
  o1.x = pk2(t[8 * 65], t[9 * 65]); o1.y = pk2(t[10 * 65], t[11 * 65]); o1.z = pk2(t[12 * 65], t[13 * 65]); o1.w = pk2(t[14 * 65], t[15 * 65]);
  bf16_t* dst = WT + (size_t)(nt * 64 + n) * (K + 64) + kt * 64 + kc;
  *(uint4*)dst = o0; *(uint4*)(dst + 8) = o1;
}
DEV void transpose_mat(const float* Wm, int K, int N, int Npad, bf16_t* dst, int remap, unsigned char* smem, int b0, int nb) {
  const int nkt = K / 64, nnt = Npad / 64;
  if ((int)blockIdx.x < b0) return;
  for (int t = blockIdx.x - b0; t < nkt * nnt; t += nb) transpose_tile(Wm, K, N, dst, remap, t / nnt, t % nnt, smem);
}
DEV void convert_weights(const Params& p, int part, unsigned char* smem, int b0, int nb) {
  unsigned char* wt = p.ws + OFF_WT; unsigned char* wt2 = p.ws + OFF_WT2;
  if (part == 0) { transpose_mat(p.w_in_even, 1024, 3352, 3584, (bf16_t*)(wt + WT_IN), 1, smem, b0, nb); return; }
  transpose_mat(p.w_out_even, 1024, 1024, 1024, (bf16_t*)(wt + WT_OUT), 0, smem, b0, nb);
  transpose_mat(p.w_ff1, 1024, 4096, 4096, (bf16_t*)(wt + WT_FF1), 0, smem, b0, nb);
  transpose_mat(p.w_ff2, 4096, 1024, 1024, (bf16_t*)(wt + WT_FF2), 0, smem, b0, nb);
  transpose_mat(p.w_in_odd, 1024, 2816, 2816, (bf16_t*)(wt2 + WT_IN), 0, smem, b0, nb);
  transpose_mat(p.w_out_odd, 1024, 1024, 1024, (bf16_t*)(wt2 + WT_OUT), 0, smem, b0, nb);
  transpose_mat(p.w_ff1 + (size_t)1024 * 4096, 1024, 4096, 4096, (bf16_t*)(wt2 + WT_FF1), 0, smem, b0, nb);
  transpose_mat(p.w_ff2 + (size_t)1024 * 4096, 4096, 1024, 1024, (bf16_t*)(wt2 + WT_FF2), 0, smem, b0, nb);
}

DEV void mod_phase(const Params& p, unsigned char* smem) {
  float* MOD = (float*)(p.ws + OFF_MOD);
  float* sS = (float*)smem;
  float* red = sS + 3072;
  const int tid = threadIdx.x, cl = tid & 31, kg = tid >> 5;
  if ((int)blockIdx.x >= 2 * 192) return;
  __syncthreads();
  for (int i = tid; i < 3072; i += 256) { const int v = i >> 10, k = i & 1023; sS[i] = siluf_(v == 0 ? p.c[k] : (v == 1 ? p.c[1024 + k] : p.c_ctx[k])); }
  __syncthreads();
  for (int it = blockIdx.x; it < 2 * 192; it += gridDim.x) {
    const int l = it / 192, n = (it % 192) * 32 + cl;
    const float* W = p.w_mod + (size_t)l * 1024 * 6144 + n;
    float a0 = 0.f, a1 = 0.f, a2 = 0.f;
#pragma unroll 16
    for (int k = kg * 128; k < kg * 128 + 128; ++k) {
      const float wv = W[(size_t)k * 6144];
      a0 += sS[k] * wv; a1 += sS[1024 + k] * wv; a2 += sS[2048 + k] * wv;
    }
    __syncthreads();
    red[(kg * 32 + cl) * 3 + 0] = a0; red[(kg * 32 + cl) * 3 + 1] = a1; red[(kg * 32 + cl) * 3 + 2] = a2;
    __syncthreads();
    if (kg == 0) {
      const float bv = p.b_mod[l * 6144 + n];
#pragma unroll
      for (int v = 0; v < 3; ++v) {
        float sacc = 0.f;
#pragma unroll
        for (int g2 = 0; g2 < 8; ++g2) sacc += red[(g2 * 32 + cl) * 3 + v];
        MOD[(l * 3 + v) * 6144 + n] = sacc + bv;
      }
    }
  }
}
DEV void rope_phase(const Params& p) {
  float* ct = (float*)(p.ws + OFF_ROPE);
  float* st = ct + 8192 * 32;
  for (int i = blockIdx.x * 256 + threadIdx.x; i < 8192 * 32; i += gridDim.x * 256) {
    const int t = i >> 5, d = i & 31;
    const float pos = (d < 16) ? (float)(t >> 6) : (float)(t & 63);
    const float inv = powf(10000.f, -(float)(d & 15) / 16.f);
    const float ang = pos * inv;
    ct[i] = cosf(ang); st[i] = sinf(ang);
  }
}

constexpr size_t A_PART = 0x8700000;
DEV void norm_phase(const Params& p, int layer, int which, bool from_input, bool skip_ctx, int ctx_fix = 0) {
  const int lane = threadIdx.x & 63;
  const int gw = blockIdx.x * 4 + (threadIdx.x >> 6), ngw = gridDim.x * 4;
  const float* g = p.g_norm + (layer * 2 + which) * D;
  bf16_t* H = (bf16_t*)(p.ws + OFF_H);
  for (int r = gw; r < M; r += ngw) {
    const int s = r % S_;
    if (skip_ctx && s < CTX) continue;
    const bool fix = ctx_fix && s < CTX;
    const f32x4* xr = (const f32x4*)xsrc_row(p, fix ? (ctx_fix == 1) : from_input, r) + lane;
    const float* mv = mod_row(p, layer, r) + which * 3 * 1024;
    f32x4 v[4]; float ss = 0.f;
#pragma unroll
    for (int j = 0; j < 4; ++j) v[j] = xr[64 * j];
    if (fix) {
      const int rc = (r / S_) * CTX + s;
      const f32x4* pp = (const f32x4*)(p.ws + OFF_AR + A_PART) + (size_t)rc * 256 + lane;
      f32x4* xw = (f32x4*)xdst_row(p, r) + lane;
#pragma unroll
      for (int j = 0; j < 4; ++j) {
        v[j] += (pp[64 * j] + pp[(size_t)512 * 256 + 64 * j]) + (pp[(size_t)2 * 512 * 256 + 64 * j] + pp[(size_t)3 * 512 * 256 + 64 * j]);
        xw[64 * j] = v[j];
      }
    }
#pragma unroll
    for (int j = 0; j < 4; ++j) ss += v[j][0] * v[j][0] + v[j][1] * v[j][1] + v[j][2] * v[j][2] + v[j][3] * v[j][3];
    const float rstd = rsqrtf(wsum(ss) * (1.f / D) + EPS);
    uint2* o = (uint2*)(H + (size_t)r * LDH) + lane;
#pragma unroll
    for (int j = 0; j < 4; ++j) {
      const int c = 4 * lane + 256 * j;
      const f32x4 gg = *(const f32x4*)(g + c), sh = *(const f32x4*)(mv + c), sc = *(const f32x4*)(mv + 1024 + c);
      float y[4];
#pragma unroll
      for (int e = 0; e < 4; ++e) y[e] = v[j][e] * rstd * gg[e] * (1.f + sc[e]) + sh[e];
      uint2 w2; w2.x = pk2(y[0], y[1]); w2.y = pk2(y[2], y[3]);
      o[64 * j] = w2;
    }
  }
}

template <class Epi>
DEV void gemm_phase(const bf16_t* A, int lda, const bf16_t* Bt, int K, int MT, int NT, bool skip_ctx, Epi epi, unsigned char* smem) {
  const int ldb = K + 64;
  const int MTv = skip_ctx ? MT - 2 * NB : MT;
  const int nwg = MTv * NT;
  for (int t = blockIdx.x; t < nwg; t += gridDim.x) {
    int wgid = t;
    { const int q = nwg / 8, r8 = nwg % 8, xcd = wgid % 8, off = wgid / 8; wgid = (xcd < r8 ? xcd * (q + 1) : r8 * (q + 1) + (xcd - r8) * q) + off; }
    const int nig = 8 * NT, gid = wgid / nig, fm = gid * 8, gsz = (MTv - fm) < 8 ? (MTv - fm) : 8;
    int mt = fm + (wgid % nig) % gsz; const int nt = (wgid % nig) / gsz;
    if (skip_ctx) mt = (mt / (NCH - 2)) * NCH + 2 + (mt % (NCH - 2));
    f32x4 acc[2][8]; zero_acc(acc);
    const bf16_t* Ab = A + (size_t)mt * 128 * lda;
    const bf16_t* Bb = Bt + (size_t)nt * 128 * ldb;
    block_gemm_glds(acc, K / 64, Ab, (size_t)lda, Bb, (size_t)ldb, smem);
    epi(acc, mt, nt);
  }
}

template <class Epi>
DEV void gemm_phase2(const bf16_t* A, int lda, const bf16_t* Bt, int K, int MT, int NP, bool skip_ctx, Epi epi, unsigned char* smem) {
  const int ldb = K + 64;
  const int MTv = skip_ctx ? MT - 2 * NB : MT;
  for (int t = blockIdx.x; t < MTv * NP; t += gridDim.x) {
    int mt = t / NP; const int np = t % NP;
    if (skip_ctx) mt = (mt / (NCH - 2)) * NCH + 2 + (mt % (NCH - 2));
    f32x4 acc0[2][8], acc1[2][8]; zero_acc(acc0); zero_acc(acc1);
    block_gemm_glds2(acc0, acc1, K / 32, A + (size_t)mt * 128 * lda, (size_t)lda, Bt + (size_t)np * 256 * ldb, (size_t)ldb, smem);
    epi(acc0, mt, 2 * np);
    epi(acc1, mt, 2 * np + 1);
  }
}

#define PERMROW(r_) (32 * ((r_) >> 5) + 8 * (((r_) >> 2) & 3) + 4 * (((r_) >> 4) & 1) + ((r_) & 3))
#define ECOL(ni_) (32 * ((ni_) >> 1) + 8 * fq + 4 * ((ni_) & 1))
#define EPI_COORDS const int lane = threadIdx.x & 63, w = threadIdx.x >> 6, fr = lane & 15, fq = lane >> 4; (void)w; (void)fr; (void)fq;

DEV void store_bf16_row(bf16_t* base, size_t ld, int row, int col, const f32x4& v) {
  uint2 o; o.x = pk2(v[0], v[1]); o.y = pk2(v[2], v[3]);
  *(uint2*)(base + (size_t)row * ld + col) = o;
}
DEV void store_bf16_T(bf16_t* base, int col, int s, const f32x4& v) {
#pragma unroll
  for (int j = 0; j < 4; ++j) base[(size_t)(col + j) * S_ + s] = f2bf(v[j]);
}

struct GateScan { float a0, a1, b0, b1, pm0, pm1, F, amax; int pos0, pos1; };
DEV GateScan gate_scan(const float* G, const int r0, const int dir, const int h, const int lane) {
  GateScan g;
  const int j0 = 2 * lane, j1 = j0 + 1;
  g.pos0 = dir ? 127 - j0 : j0; g.pos1 = dir ? 127 - j1 : j1;
  const float i0 = G[(size_t)(r0 + g.pos0) * 24 + (dir * 2) * 6 + h], f0 = G[(size_t)(r0 + g.pos0) * 24 + (dir * 2 + 1) * 6 + h];
  const float i1 = G[(size_t)(r0 + g.pos1) * 24 + (dir * 2) * 6 + h], f1 = G[(size_t)(r0 + g.pos1) * 24 + (dir * 2 + 1) * 6 + h];
  const float lf0 = logsigf_(f0), lf1 = logsigf_(f1);
  const float s0 = lf0, s1 = lf0 + lf1;
  float tot = s1;
#pragma unroll
  for (int d = 1; d < 64; d <<= 1) { const float y = __shfl_up(tot, d); if (lane >= d) tot += y; }
  const float excl = tot - s1;
  g.b0 = s0 + excl; g.b1 = s1 + excl;
  g.F = __shfl(tot, 63);
  g.a0 = i0 - g.b0; g.a1 = i1 - g.b1;
  const float q0 = g.a0, q1 = fmaxf(g.a0, g.a1);
  float t = q1;
#pragma unroll
  for (int d = 1; d < 64; d <<= 1) { const float y = __shfl_up(t, d); if (lane >= d) t = fmaxf(t, y); }
  float ex = __shfl_up(t, 1); if (lane == 0) ex = -INFINITY;
  g.pm0 = fmaxf(q0, ex); g.pm1 = fmaxf(q1, ex);
  g.amax = __shfl(t, 63);
  return g;
}
DEV int chunk_ord(int dir, int i) { return dir == 0 ? i : (i < 2 ? 1 - i : 67 - i); }

template <int ph>
DEV void run_phase(const Params& p, unsigned char* smem) {
  const int tid = threadIdx.x, lane = tid & 63, w = tid >> 6, fr = lane & 15, fq = lane >> 4;
  unsigned char* ws = p.ws;
  bf16_t* const WT = (bf16_t*)(ws + (ph >= 11 ? OFF_WT2 : OFF_WT));
  bf16_t* const Hb = (bf16_t*)(ws + OFF_H);
  float* const Gt = (float*)(ws + OFF_G);
  float* const CS = (float*)(ws + OFF_CS);
  float* const MS = (float*)(ws + OFF_MS);
  float* const NV = (float*)(ws + OFF_NV);
  unsigned char* const AR = ws + OFF_AR;
  unsigned char* const DO = (unsigned char*)p.out;
  float* const sF = (float*)(smem + LDS_F);
  bf16_t* const sP = (bf16_t*)(smem + LDS_P);

    switch (ph) {
    case 0: {
      convert_weights(p, 0, smem, 0, gridDim.x);
      mod_phase(p, smem);
      rope_phase(p);
    } break;
    case 1: norm_phase(p, 0, 0, true, false); break;
    case 2: {
      bf16_t* QK = (bf16_t*)(AR + A0_QK); bf16_t* Vt = (bf16_t*)(AR + A0_VT); bf16_t* Ob = (bf16_t*)(AR + A0_O); bf16_t* Fb = (bf16_t*)(DO + DO_F);
      const float* bg = p.b_gate;
      auto epi = [&](f32x4 (&acc)[2][8], int mt, int nt) {
        const int b = mt / NCH;
        const int row0 = mt * 128 + 32 * w + fr, col0 = nt * 128 + 8 * fq;
        if (nt < 12 || (nt >= 18 && nt < 26)) {
          bf16_t* tb; int ld;
          if (nt < 12) { tb = QK + (size_t)row0 * 1536 + col0; ld = 1536; }
          else if (nt < 24) { tb = Ob + (size_t)row0 * 768 + (col0 - 2304); ld = 768; }
          else { tb = Fb + (size_t)row0 * 256 + (col0 - 3072); ld = 256; }
#pragma unroll
          for (int mi = 0; mi < 2; ++mi)
#pragma unroll
            for (int pq = 0; pq < 4; ++pq) {
              uint4 o; o.x = pk2(acc[mi][2 * pq][0], acc[mi][2 * pq][1]); o.y = pk2(acc[mi][2 * pq][2], acc[mi][2 * pq][3]);
              o.z = pk2(acc[mi][2 * pq + 1][0], acc[mi][2 * pq + 1][1]); o.w = pk2(acc[mi][2 * pq + 1][2], acc[mi][2 * pq + 1][3]);
              *(uint4*)(tb + (size_t)(16 * mi) * ld + 32 * pq) = o;
            }
        } else if (nt < 18) {
          bf16_t* tb = Vt + (size_t)b * 768 * S_ + (size_t)(col0 - 1536) * S_ + (row0 - b * S_);
#pragma unroll
          for (int mi = 0; mi < 2; ++mi)
#pragma unroll
            for (int ni = 0; ni < 8; ++ni)
#pragma unroll
              for (int j = 0; j < 4; ++j) tb[(size_t)(32 * (ni >> 1) + 4 * (ni & 1) + j) * S_ + 16 * mi] = f2bf(acc[mi][ni][j]);
        } else if (nt == 26) {
#pragma unroll
          for (int mi = 0; mi < 2; ++mi)
#pragma unroll
            for (int ni = 0; ni < 2; ++ni) {
              const int gc = ECOL(ni);
              if (gc < 24) { f32x4 o = acc[mi][ni]; o += *(const f32x4*)(bg + gc); *(f32x4*)(Gt + (size_t)(row0 + 16 * mi) * 24 + gc) = o; }
            }
        }
      };
      gemm_phase(Hb, LDH, (const bf16_t*)((unsigned char*)WT + WT_IN), D, M / 128, 27, false, epi, smem);
    } break;
    case 3: {
      const bf16_t* QK = (const bf16_t*)(AR + A0_QK);
      bf16_t* Qc = (bf16_t*)(AR + A0_QC); bf16_t* Kc = (bf16_t*)(AR + A0_KC); bf16_t* KcT = (bf16_t*)(DO + DO_KCT);
      bf16_t* ZT = (bf16_t*)(DO + DO_ZT); const bf16_t* Fb = (const bf16_t*)(DO + DO_F);
      for (int t = blockIdx.x; t < (M / 128) * 4; t += gridDim.x) {
        const int mt = t >> 2, g = t & 3;
        f32x4 acc[2][8]; zero_acc(acc);
        block_gemm<false>(acc, 1,
            [&](int row, int k) {
              const int cp = row & 63, im = row >> 6; float vv[8];
#pragma unroll
              for (int j = 0; j < 8; ++j) { const int mm = (cp * (k + j)) & 63; const float xx = (float)mm * (1.f / 64.f); vv[j] = im ? -__builtin_amdgcn_sinf(xx) : __builtin_amdgcn_cosf(xx); }
              uint4 o; o.x = pk2(vv[0], vv[1]); o.y = pk2(vv[2], vv[3]); o.z = pk2(vv[4], vv[5]); o.w = pk2(vv[6], vv[7]); return o;
            },
            [&](int row, int k) { return *(const uint4*)(Fb + (size_t)(mt * 128 + row) * 256 + g * 64 + k); },
            smem, nullptr, 0);
        const int b = mt / NCH;
#pragma unroll
        for (int mi = 0; mi < 2; ++mi) {
          const int n = 32 * w + 16 * mi + fr, cp = n & 63, im = n >> 6;
          bf16_t* zrow = ZT + (size_t)((b * 256 + g * 64 + cp) * 2 + im) * S_ + (mt * 128 - b * S_);
#pragma unroll
          for (int ni = 0; ni < 8; ++ni) {
            uint2 o; o.x = pk2(acc[mi][ni][0], acc[mi][ni][1]); o.y = pk2(acc[mi][ni][2], acc[mi][ni][3]);
            *(uint2*)(zrow + 16 * ni + 4 * fq) = o;
          }
        }
      }
      bf16_t* tl = (bf16_t*)smem;
      for (int t = blockIdx.x; t < (M / 64) * 12; t += gridDim.x) {
        const int rt = t / 12, ct = t % 12;
        const int r0 = rt * 64, b = r0 / S_, s0 = r0 - b * S_;
        const int lo = (s0 < CTX) ? 0 : CTX, hi = (s0 < CTX) ? CTX - 1 : S_ - 1;
        __syncthreads();
#pragma unroll
        for (int i = 0; i < 4; ++i) {
          const int id = tid + 256 * i, rr = id >> 4, cc = (id & 15) * 8;
          const int s = s0 + rr, c = ct * 128 + cc;
          const size_t base = (size_t)(r0 + rr) * 1536 + c;
          uint4 z = {0u, 0u, 0u, 0u};
          const uint4 u1 = *(const uint4*)(QK + base);
          const uint4 u0 = (s - 1 >= lo) ? *(const uint4*)(QK + base - 1536) : z;
          const uint4 u2 = (s + 1 <= hi) ? *(const uint4*)(QK + base + 1536) : z;
          const unsigned a0[4] = {u0.x, u0.y, u0.z, u0.w}, a1[4] = {u1.x, u1.y, u1.z, u1.w}, a2[4] = {u2.x, u2.y, u2.z, u2.w};
          float o[8];
          {
            const f32x4 wa0 = *(const f32x4*)(p.w_qk_conv + c), wa1 = *(const f32x4*)(p.w_qk_conv + c + 4);
            const f32x4 wb0 = *(const f32x4*)(p.w_qk_conv + 1536 + c), wb1 = *(const f32x4*)(p.w_qk_conv + 1536 + c + 4);
            const f32x4 wc0 = *(const f32x4*)(p.w_qk_conv + 3072 + c), wc1 = *(const f32x4*)(p.w_qk_conv + 3072 + c + 4);
            const float wA[8] = {wa0[0], wa0[1], wa0[2], wa0[3], wa1[0], wa1[1], wa1[2], wa1[3]};
            const float wB[8] = {wb0[0], wb0[1], wb0[2], wb0[3], wb1[0], wb1[1], wb1[2], wb1[3]};
            const float wC[8] = {wc0[0], wc0[1], wc0[2], wc0[3], wc1[0], wc1[1], wc1[2], wc1[3]};
#pragma unroll
            for (int e = 0; e < 4; ++e) {
              o[2 * e] = siluf_(wA[2 * e] * bflo(a0[e]) + wB[2 * e] * bflo(a1[e]) + wC[2 * e] * bflo(a2[e]));
              o[2 * e + 1] = siluf_(wA[2 * e + 1] * bfhi(a0[e]) + wB[2 * e + 1] * bfhi(a1[e]) + wC[2 * e + 1] * bfhi(a2[e]));
            }
          }
          if (ct < 6) {
            const float sc = 0.08838834764831845f;
            uint4 q; q.x = pk2(o[0] * sc, o[1] * sc); q.y = pk2(o[2] * sc, o[3] * sc); q.z = pk2(o[4] * sc, o[5] * sc); q.w = pk2(o[6] * sc, o[7] * sc);
            *(uint4*)(Qc + (size_t)(r0 + rr) * 768 + c) = q;
          } else {
            uint4 q; q.x = pk2(o[0], o[1]); q.y = pk2(o[2], o[3]); q.z = pk2(o[4], o[5]); q.w = pk2(o[6], o[7]);
            *(uint4*)(Kc + (size_t)(r0 + rr) * 768 + c - 768) = q;
#pragma unroll
            for (int e = 0; e < 8; ++e) tl[(cc + e) * LDT + rr] = f2bf(o[e]);
          }
        }
        __syncthreads();
        if (ct >= 6) {
#pragma unroll
          for (int i = 0; i < 4; ++i) {
            const int id = tid + 256 * i, cc = id >> 3, sc8 = (id & 7) * 8;
            const uint4 v = *(const uint4*)&tl[cc * LDT + sc8];
            *(uint4*)(KcT + (size_t)(b * 768 + (ct - 6) * 128 + cc) * S_ + s0 + sc8) = v;
          }
        }
      }
    } break;
    case 4: {
      const bf16_t* ZT = (const bf16_t*)(DO + DO_ZT);
      const int NF = 512 + 8;
      bf16_t* ApT = (bf16_t*)(DO + DO_F);
      const bf16_t* Vt = (const bf16_t*)(AR + A0_VT); const bf16_t* KcT = (const bf16_t*)(DO + DO_KCT); const bf16_t* Kc = (const bf16_t*)(AR + A0_KC);
      bf16_t* ST = (bf16_t*)(AR + A0_ST);
      for (int t = blockIdx.x; t < NF + 24 * NCH; t += gridDim.x) {
        if (t < 512) {
          const int mt = t & 1, ct = t >> 1;
          f32x4 acc[2][8]; zero_acc(acc);
          block_gemm<false>(acc, 4,
              [&](int row, int k) {
                const int p1 = mt * 64 + (row >> 1), op = row & 1, part = k >> 7, t1 = k & 127; float vv[8];
#pragma unroll
                for (int j = 0; j < 8; ++j) {
                  const float xx = (float)((p1 * (t1 + j)) & 127) * (1.f / 128.f);
                  const float cv = __builtin_amdgcn_cosf(xx), sv = __builtin_amdgcn_sinf(xx);
                  vv[j] = op == 0 ? (part == 0 ? cv : sv) : (part == 0 ? -sv : cv);
                }
                uint4 o; o.x = pk2(vv[0], vv[1]); o.y = pk2(vv[2], vv[3]); o.z = pk2(vv[4], vv[5]); o.w = pk2(vv[6], vv[7]); return o;
              },
              [&](int row, int k) {
                const int n = 2 * ct + (row >> 6), t2 = row & 63, part = k >> 7, t1 = k & 127;
                const bf16_t* src = ZT + (size_t)(n * 2 + part) * S_ + CTX + 64 * t1 + t2;
                unsigned e[8];
#pragma unroll
                for (int j = 0; j < 8; ++j) e[j] = src[64 * j];
                uint4 o; o.x = e[0] | (e[1] << 16); o.y = e[2] | (e[3] << 16); o.z = e[4] | (e[5] << 16); o.w = e[6] | (e[7] << 16); return o;
              }, smem, nullptr, 0);
#pragma unroll
          for (int mi = 0; mi < 2; ++mi) {
            const int row = 32 * w + 16 * mi + fr, p1 = mt * 64 + (row >> 1), op = row & 1;
#pragma unroll
            for (int ni = 0; ni < 8; ++ni) {
              const int col = 16 * ni + 4 * fq, n = 2 * ct + (col >> 6), t2 = col & 63;
              f32x4 v = acc[mi][ni], o;
#pragma unroll
              for (int j = 0; j < 4; ++j) {
                const float other = __shfl_xor(v[j], 1);
                const float xx = (float)((p1 * (t2 + j)) & 8191) * (1.f / 8192.f);
                const float cv = __builtin_amdgcn_cosf(xx), sv = __builtin_amdgcn_sinf(xx);
                o[j] = op == 0 ? (v[j] * cv + other * sv) : (v[j] * cv - other * sv);
              }
              store_bf16_row(ApT, 128, p1 * 512 + n, op * 64 + t2, o);
            }
          }
        } else if (t < NF) {
          const int tt = t - 512, mt = tt >> 2, nt = tt & 3;
          const int T = 256, tmask = T - 1;
          const float invT = 1.f / (float)T;
          f32x4 acc[2][8]; zero_acc(acc);
          block_gemm<false>(acc, 2 * T / 64,
              [&](int row, int k) {
                const int pp = mt * 128 + row, part = k >= T, t0 = k & tmask; float vv[8];
#pragma unroll
                for (int j = 0; j < 8; ++j) { const int mm = (pp * (t0 + j)) & tmask; const float xx = (float)mm * invT; vv[j] = part ? __builtin_amdgcn_sinf(xx) : __builtin_amdgcn_cosf(xx); }
                uint4 o; o.x = pk2(vv[0], vv[1]); o.y = pk2(vv[2], vv[3]); o.z = pk2(vv[4], vv[5]); o.w = pk2(vv[6], vv[7]); return o;
              },
              [&](int row, int k) { const int part = k >= T, t0 = k & tmask; return *(const uint4*)(ZT + (size_t)((nt * 128 + row) * 2 + part) * S_ + t0); },
              smem, nullptr, 0);
#pragma unroll
          for (int mi = 0; mi < 2; ++mi)
#pragma unroll
            for (int ni = 0; ni < 8; ++ni) {
              const int pp = mt * 128 + 32 * w + 16 * mi + fr, n = nt * 128 + 16 * ni + 4 * fq, b = n >> 8;
              f32x4 v = acc[mi][ni]; v *= (1.f / 128.f);
              store_bf16_row(Hb, LDH, b * S_ + pp, 768 + (n & 255), v);
            }
        } else {
          const int ta = t - NF, sd = ta / NCH, n = ta % NCH;
          const int dir = sd / 12, b = (sd / 6) & 1, h = sd % 6;
          const int r0 = b * S_ + n * 128;
          float* sW = sF;
          __syncthreads();
          if (w == 0) {
            const GateScan g = gate_scan(Gt, r0, dir, h, lane);
            sW[g.pos0] = __expf(g.a0 - g.amax); sW[g.pos1] = __expf(g.a1 - g.amax);
            if (lane == 0) { CS[(sd * NCH + n) * 4 + 0] = g.amax; CS[(sd * NCH + n) * 4 + 1] = g.F; }
          }
          __syncthreads();
          f32x4 acc[2][8]; zero_acc(acc);
          const bf16_t* Ab = Vt + (size_t)(b * 768 + h * 128) * S_ + n * 128;
          const bf16_t* Bb = KcT + (size_t)(b * 768 + h * 128) * S_ + n * 128;
          block_gemm<false>(acc, 2,
              [&](int row, int k) { return *(const uint4*)(Ab + (size_t)row * S_ + k); },
              [&](int row, int k) {
                const uint4 u = *(const uint4*)(Bb + (size_t)PERMROW(row) * S_ + k);
                uint4 o;
                o.x = pk2(bflo(u.x) * sW[k], bfhi(u.x) * sW[k + 1]); o.y = pk2(bflo(u.y) * sW[k + 2], bfhi(u.y) * sW[k + 3]);
                o.z = pk2(bflo(u.z) * sW[k + 4], bfhi(u.z) * sW[k + 5]); o.w = pk2(bflo(u.w) * sW[k + 6], bfhi(u.w) * sW[k + 7]);
                return o;
              }, smem, nullptr, 0);
          bf16_t* Sd = ST + (size_t)(sd * NCH + n) * 16384;
#pragma unroll
          for (int mi = 0; mi < 2; ++mi)
#pragma unroll
            for (int pq = 0; pq < 4; ++pq) {
              uint4 o; o.x = pk2(acc[mi][2 * pq][0], acc[mi][2 * pq][1]); o.y = pk2(acc[mi][2 * pq][2], acc[mi][2 * pq][3]);
              o.z = pk2(acc[mi][2 * pq + 1][0], acc[mi][2 * pq + 1][1]); o.w = pk2(acc[mi][2 * pq + 1][2], acc[mi][2 * pq + 1][3]);
              *(uint4*)(Sd + (size_t)(32 * w + 16 * mi + fr) * 128 + 8 * fq + 32 * pq) = o;
            }
          if (tid < 128) {
            int tix = tid; asm volatile("" : "+v"(tix));
            const uint4* krow = (const uint4*)(KcT + (size_t)(b * 768 + h * 128 + tix) * S_ + n * 128);
            float a = 0.f;
#pragma unroll
            for (int c = 0; c < 16; ++c) {
              const uint4 u = krow[c]; const float* ww = sW + 8 * c;
              a += bflo(u.x) * ww[0] + bfhi(u.x) * ww[1] + bflo(u.y) * ww[2] + bfhi(u.y) * ww[3] + bflo(u.z) * ww[4] + bfhi(u.z) * ww[5] + bflo(u.w) * ww[6] + bfhi(u.w) * ww[7];
            }
            NV[(size_t)(sd * NCH + n) * 128 + tix] = a;
          }
        }
      }
    } break;
    case 5: {
      {
        const bf16_t* ApT = (const bf16_t*)(DO + DO_F);
        for (int t = blockIdx.x; t < 512; t += gridDim.x) {
          const int p1 = t >> 2, n0 = (t & 3) * 128;
          f32x4 acc[2][8]; zero_acc(acc);
          block_gemm<false>(acc, 2,
              [&](int row, int k) { return *(const uint4*)(ApT + (size_t)(t * 128 + row) * 128 + k); },
              [&](int row, int k) {
                uint4 o = {0u, 0u, 0u, 0u};
                if (row < 64) {
                  const int part = k >> 6, t2 = k & 63; float vv[8];
#pragma unroll
                  for (int j = 0; j < 8; ++j) { const float xx = (float)((row * (t2 + j)) & 63) * (1.f / 64.f); vv[j] = part ? __builtin_amdgcn_sinf(xx) : __builtin_amdgcn_cosf(xx); }
                  o.x = pk2(vv[0], vv[1]); o.y = pk2(vv[2], vv[3]); o.z = pk2(vv[4], vv[5]); o.w = pk2(vv[6], vv[7]);
                }
                return o;
              }, smem, nullptr, 0);
#pragma unroll
          for (int mi = 0; mi < 2; ++mi) {
            const int n = n0 + 32 * w + 16 * mi + fr, b = n >> 8;
#pragma unroll
            for (int ni = 0; ni < 4; ++ni)
#pragma unroll
              for (int j = 0; j < 4; ++j) {
                const int p2 = 16 * ni + 4 * fq + j;
                Hb[(size_t)(b * S_ + CTX + p1 + 128 * p2) * LDH + 768 + (n & 255)] = f2bf(acc[mi][ni][j] * 0.0013810679320049757f);
              }
          }
        }
      }
      if (gridDim.x >= 400) convert_weights(p, 1, smem, 200, gridDim.x - 200); else convert_weights(p, 1, smem, 0, gridDim.x);
      bf16_t* ST = (bf16_t*)(AR + A0_ST);
      for (int e = blockIdx.x * 256 + tid; e < 24 * 2064; e += gridDim.x * 256) {
        const int sd = e / 2064, idx = e % 2064, dir = sd / 12;
        float cst[8];
#pragma unroll
        for (int j = 0; j < 8; ++j) cst[j] = 0.f;
        float m = 0.f;
        uint4 ring0[4], ring1[4]; float ra[4], rf[4];
#define SC_FETCH(i_, u_) do { const int n_ = chunk_ord(dir, (i_)); ra[u_] = CS[(sd * NCH + n_) * 4 + 0]; rf[u_] = CS[(sd * NCH + n_) * 4 + 1]; \
          if (idx < 2048) ring0[u_] = *(const uint4*)(ST + (size_t)(sd * NCH + n_) * 16384 + idx * 8); \
          else { const uint4* q_ = (const uint4*)(NV + (size_t)(sd * NCH + n_) * 128 + (idx - 2048) * 8); ring0[u_] = q_[0]; ring1[u_] = q_[1]; } } while (0)
#pragma unroll
        for (int u = 0; u < 4; ++u) { ring1[u] = uint4{0u, 0u, 0u, 0u}; SC_FETCH(u, u); }
        for (int i0 = 0; i0 < NCH; i0 += 4) {
#pragma unroll
          for (int u = 0; u < 4; ++u) {
            const int i = i0 + u;
            if (i < NCH) {
              const int n = chunk_ord(dir, i);
              const float amax = ra[u], F = rf[u];
              const uint4 c0 = ring0[u], c1 = ring1[u];
              if (i + 4 < NCH) SC_FETCH(i + 4, u);
              const float Mx = fmaxf(m, amax), dcy = __expf(m - Mx), scl = __expf(amax - Mx);
              if (idx < 2048) {
                uint4* ptr = (uint4*)(ST + (size_t)(sd * NCH + n) * 16384 + idx * 8);
                uint4 o; o.x = pk2(cst[0], cst[1]); o.y = pk2(cst[2], cst[3]); o.z = pk2(cst[4], cst[5]); o.w = pk2(cst[6], cst[7]);
                *ptr = o;
                cst[0] = dcy * cst[0] + scl * bflo(c0.x); cst[1] = dcy * cst[1] + scl * bfhi(c0.x);
                cst[2] = dcy * cst[2] + scl * bflo(c0.y); cst[3] = dcy * cst[3] + scl * bfhi(c0.y);
                cst[4] = dcy * cst[4] + scl * bflo(c0.z); cst[5] = dcy * cst[5] + scl * bfhi(c0.z);
                cst[6] = dcy * cst[6] + scl * bflo(c0.w); cst[7] = dcy * cst[7] + scl * bfhi(c0.w);
              } else {
                uint4* ptr = (uint4*)(NV + (size_t)(sd * NCH + n) * 128 + (idx - 2048) * 8);
                uint4 o0, o1;
                o0.x = __float_as_uint(cst[0]); o0.y = __float_as_uint(cst[1]); o0.z = __float_as_uint(cst[2]); o0.w = __float_as_uint(cst[3]);
                o1.x = __float_as_uint(cst[4]); o1.y = __float_as_uint(cst[5]); o1.z = __float_as_uint(cst[6]); o1.w = __float_as_uint(cst[7]);
                ptr[0] = o0; ptr[1] = o1;
                cst[0] = dcy * cst[0] + scl * __uint_as_float(c0.x); cst[1] = dcy * cst[1] + scl * __uint_as_float(c0.y);
                cst[2] = dcy * cst[2] + scl * __uint_as_float(c0.z); cst[3] = dcy * cst[3] + scl * __uint_as_float(c0.w);
                cst[4] = dcy * cst[4] + scl * __uint_as_float(c1.x); cst[5] = dcy * cst[5] + scl * __uint_as_float(c1.y);
                cst[6] = dcy * cst[6] + scl * __uint_as_float(c1.z); cst[7] = dcy * cst[7] + scl * __uint_as_float(c1.w);
              }
              if (idx == 0) MS[sd * NCH + n] = m;
              m = F + Mx;
            }
          }
        }
#undef SC_FETCH
      }
    } break;
    case 6: {
      const bf16_t* Vt = (const bf16_t*)(AR + A0_VT); const bf16_t* Qc = (const bf16_t*)(AR + A0_QC); const bf16_t* Kc = (const bf16_t*)(AR + A0_KC);
      const bf16_t* ST = (const bf16_t*)(AR + A0_ST); const bf16_t* Ob = (const bf16_t*)(AR + A0_O);
      float* aA = sF; float* aM = sF + 256; float* aI = sF + 512; float* aE = sF + 768; float* sN = sF + 1024; float* sQN = sF + 1280; float* sSC = sF + 1536;
      for (int t = blockIdx.x; t < 12 * NCH; t += gridDim.x) {
        const int bh = t / NCH, n = t % NCH, b = bh / 6, h = bh % 6;
        const int r0 = b * S_ + n * 128;
        __syncthreads();
        if (w < 2) {
          const int dir = w, sd = (dir * 2 + b) * 6 + h;
          const GateScan g = gate_scan(Gt, r0, dir, h, lane);
          const float mp = MS[sd * NCH + n];
          const float M0 = fmaxf(mp, g.pm0), M1 = fmaxf(mp, g.pm1);
          aA[dir * 128 + g.pos0] = __expf(g.a0 - g.amax); aA[dir * 128 + g.pos1] = __expf(g.a1 - g.amax);
          aM[dir * 128 + g.pos0] = __expf(g.amax - M0); aM[dir * 128 + g.pos1] = __expf(g.amax - M1);
          aI[dir * 128 + g.pos0] = __expf(mp - M0); aI[dir * 128 + g.pos1] = __expf(mp - M1);
          aE[dir * 128 + g.pos0] = __expf(-(g.b0 + M0)); aE[dir * 128 + g.pos1] = __expf(-(g.b1 + M1));
        } else {
          const int dir = w - 2, sd = (dir * 2 + b) * 6 + h;
          sN[dir * 128 + lane] = NV[(size_t)(sd * NCH + n) * 128 + lane];
          sN[dir * 128 + 64 + lane] = NV[(size_t)(sd * NCH + n) * 128 + 64 + lane];
        }
        __syncthreads();
        const bf16_t* Qb = Qc + (size_t)r0 * 768 + h * 128;
        const bf16_t* Kb = Kc + (size_t)r0 * 768 + h * 128;
        {
          const int qr = tid >> 1, k0 = (tid & 1) * 64;
          float sf = 0.f, sb = 0.f;
#pragma unroll
          for (int c8 = 0; c8 < 8; ++c8) {
            const uint4 u = *(const uint4*)(Qb + (size_t)qr * 768 + k0 + c8 * 8);
            const float* nf = sN + k0 + c8 * 8; const float* nb = sN + 128 + k0 + c8 * 8;
            sf += bflo(u.x) * nf[0] + bfhi(u.x) * nf[1] + bflo(u.y) * nf[2] + bfhi(u.y) * nf[3] + bflo(u.z) * nf[4] + bfhi(u.z) * nf[5] + bflo(u.w) * nf[6] + bfhi(u.w) * nf[7];
            sb += bflo(u.x) * nb[0] + bfhi(u.x) * nb[1] + bflo(u.y) * nb[2] + bfhi(u.y) * nb[3] + bflo(u.z) * nb[4] + bfhi(u.z) * nb[5] + bflo(u.w) * nb[6] + bfhi(u.w) * nb[7];
          }
          sf += __shfl_xor(sf, 1); sb += __shfl_xor(sb, 1);
          if ((tid & 1) == 0) { sQN[qr] = sf; sQN[128 + qr] = sb; }
        }
        f32x4 acc[2][8]; zero_acc(acc);
        block_gemm<false>(acc, 2,
            [&](int row, int k) { return *(const uint4*)(Qb + (size_t)row * 768 + k); },
            [&](int row, int k) { return *(const uint4*)(Kb + (size_t)row * 768 + k); }, smem, nullptr, 0);
        __syncthreads();
        {
          float rsf[2] = {0.f, 0.f}, rsb[2] = {0.f, 0.f};
#pragma unroll
          for (int ni = 0; ni < 8; ++ni) {
            const int s0 = 16 * ni + 4 * fq;
            const f32x4 ef = *(const f32x4*)(aA + s0), eb = *(const f32x4*)(aA + 128 + s0);
#pragma unroll
            for (int mi = 0; mi < 2; ++mi) {
              const int tr = 32 * w + 16 * mi + fr;
#pragma unroll
              for (int j = 0; j < 4; ++j) {
                const float sv = acc[mi][ni][j];
                rsf[mi] += (s0 + j <= tr) ? sv * ef[j] : 0.f;
                rsb[mi] += (s0 + j >= tr) ? sv * eb[j] : 0.f;
              }
            }
          }
          float cf[2], cb[2];
#pragma unroll
          for (int mi = 0; mi < 2; ++mi) {
            const int tr = 32 * w + 16 * mi + fr;
            float a = rsf[mi], c2 = rsb[mi];
            a += __shfl_xor(a, 16); a += __shfl_xor(a, 32); c2 += __shfl_xor(c2, 16); c2 += __shfl_xor(c2, 32);
            const float denf = a * aM[tr] + aI[tr] * sQN[tr], denb = c2 * aM[128 + tr] + aI[128 + tr] * sQN[128 + tr];
            const float ddf = 1.f / fmaxf(fabsf(denf), aE[tr]), ddb = 1.f / fmaxf(fabsf(denb), aE[128 + tr]);
            if (fq == 0) { sSC[tr] = aI[tr] * ddf; sSC[128 + tr] = aI[128 + tr] * ddb; }
            cf[mi] = aM[tr] * ddf; cb[mi] = aM[128 + tr] * ddb;
          }
#pragma unroll
          for (int ni = 0; ni < 8; ++ni) {
            const int s0 = 16 * ni + 4 * fq;
            const f32x4 ef = *(const f32x4*)(aA + s0), eb = *(const f32x4*)(aA + 128 + s0);
#pragma unroll
            for (int mi = 0; mi < 2; ++mi) {
              const int tr = 32 * w + 16 * mi + fr;
              f32x4 pv;
#pragma unroll
              for (int j = 0; j < 4; ++j) {
                const float df = (s0 + j <= tr) ? ef[j] * cf[mi] : 0.f;
                const float db = (s0 + j >= tr) ? eb[j] * cb[mi] : 0.f;
                pv[j] = acc[mi][ni][j] * (df + db);
              }
              uint2 o; o.x = pk2(pv[0], pv[1]); o.y = pk2(pv[2], pv[3]);
              *(uint2*)&sP[tr * LDP + s0] = o;
            }
          }
        }
        __syncthreads();
        zero_acc(acc);
        {
          const bf16_t* Vb = Vt + (size_t)(b * 768 + h * 128) * S_ + n * 128;
          block_gemm<true>(acc, 2, [&](int, int) { return uint4{0u, 0u, 0u, 0u}; },
              [&](int row, int k) { return *(const uint4*)(Vb + (size_t)PERMROW(row) * S_ + k); }, smem, sP, LDP);
        }
#pragma unroll
        for (int dir = 0; dir < 2; ++dir) {
          const int sd = (dir * 2 + b) * 6 + h;
          const bf16_t* Cb = ST + (size_t)(sd * NCH + n) * 16384;
          block_gemm<false>(acc, 2,
              [&](int row, int k) {
                const uint4 u = *(const uint4*)(Qb + (size_t)row * 768 + k);
                const float sc = sSC[dir * 128 + row];
                uint4 o; o.x = pk2(bflo(u.x) * sc, bfhi(u.x) * sc); o.y = pk2(bflo(u.y) * sc, bfhi(u.y) * sc);
                o.z = pk2(bflo(u.z) * sc, bfhi(u.z) * sc); o.w = pk2(bflo(u.w) * sc, bfhi(u.w) * sc); return o;
              },
              [&](int row, int k) { return *(const uint4*)(Cb + (size_t)PERMROW(row) * 128 + k); }, smem, nullptr, 0);
        }
#pragma unroll
        for (int mi = 0; mi < 2; ++mi) {
          const int tr = 32 * w + 16 * mi + fr, row = r0 + tr;
          float ss = 0.f;
#pragma unroll
          for (int ni = 0; ni < 8; ++ni)
#pragma unroll
            for (int j = 0; j < 4; ++j) ss += acc[mi][ni][j] * acc[mi][ni][j];
          ss += __shfl_xor(ss, 16); ss += __shfl_xor(ss, 32);
          const float rstd = rsqrtf(ss * (1.f / 128.f) + EPS);
#pragma unroll
          for (int pq = 0; pq < 4; ++pq) {
            const int col = h * 128 + 8 * fq + 32 * pq;
            const f32x4 g0 = *(const f32x4*)(p.g_head + col), g1 = *(const f32x4*)(p.g_head + col + 4);
            const uint4 ou = *(const uint4*)(Ob + (size_t)row * 768 + col);
            const f32x4 a0 = acc[mi][2 * pq], a1 = acc[mi][2 * pq + 1];
            uint4 o;
            o.x = pk2(a0[0] * rstd * g0[0] * sigmoidf_(bflo(ou.x)), a0[1] * rstd * g0[1] * sigmoidf_(bfhi(ou.x)));
            o.y = pk2(a0[2] * rstd * g0[2] * sigmoidf_(bflo(ou.y)), a0[3] * rstd * g0[3] * sigmoidf_(bfhi(ou.y)));
            o.z = pk2(a1[0] * rstd * g1[0] * sigmoidf_(bflo(ou.z)), a1[1] * rstd * g1[1] * sigmoidf_(bfhi(ou.z)));
            o.w = pk2(a1[2] * rstd * g1[2] * sigmoidf_(bflo(ou.w)), a1[3] * rstd * g1[3] * sigmoidf_(bfhi(ou.w)));
            *(uint4*)(Hb + (size_t)row * LDH + col) = o;
          }
        }
      }
    } break;
    case 7: case 10: case 15: case 18: {
      const bool is_ff2 = (ph == 10 || ph == 18);
      const int layer = ph >= 15 ? 1 : 0;
      const bool from_input = (ph == 7);
      const bf16_t* A = is_ff2 ? (const bf16_t*)AR : Hb;
      const int K = is_ff2 ? DFF : D;
      const bf16_t* Bt = (const bf16_t*)((unsigned char*)WT + (is_ff2 ? WT_FF2 : WT_OUT));
      const int gidx = is_ff2 ? 5 : 2;
      auto epi = [&](f32x4 (&acc)[2][8], int mt, int nt) {
#pragma unroll
        for (int mi = 0; mi < 2; ++mi) {
          const int row = mt * 128 + 32 * w + 16 * mi + fr;
          const float* xs = xsrc_row(p, from_input, row);
          float* xd = xdst_row(p, row);
          const float* gate = mod_row(p, layer, row) + gidx * 1024;
#pragma unroll
          for (int ni = 0; ni < 8; ++ni) {
            const int col = nt * 128 + ECOL(ni);
            const f32x4 xv = *(const f32x4*)(xs + col), gv = *(const f32x4*)(gate + col);
            f32x4 o = xv + gv * acc[mi][ni];
            *(f32x4*)(xd + col) = o;
          }
        }
      };
      const int lda = is_ff2 ? LDHID : LDH;
      gemm_phase(A, lda, Bt, K, M / 128, 8, true, epi, smem);
      if (layer == 0) {
        const int ldb = K + 64, kper = K / 4;
        float* PART = (float*)(AR + A_PART);
        for (int u = blockIdx.x; u < 32 * 4; u += gridDim.x) {
          const int tile = u >> 2, ks = u & 3, mc = tile >> 3, nt = tile & 7, mt = (mc >> 1) * NCH + (mc & 1);
          f32x4 acc[2][8]; zero_acc(acc);
          block_gemm_glds(acc, kper / 64, A + (size_t)mt * 128 * lda + ks * kper, (size_t)lda, Bt + (size_t)nt * 128 * ldb + ks * kper, (size_t)ldb, smem);
#pragma unroll
          for (int mi = 0; mi < 2; ++mi) {
            const int row = mt * 128 + 32 * w + 16 * mi + fr, rc = (row / S_) * CTX + (row % S_);
            const float* gate = mod_row(p, layer, row) + gidx * 1024;
            float* pd = PART + ((size_t)ks * 512 + rc) * 1024;
#pragma unroll
            for (int ni = 0; ni < 8; ++ni) {
              const int col = nt * 128 + ECOL(ni);
              const f32x4 gv = *(const f32x4*)(gate + col);
              *(f32x4*)(pd + col) = gv * acc[mi][ni];
            }
          }
        }
      }
    } break;
    case 8: norm_phase(p, 0, 1, false, false, 1); break;
    case 9: case 17: {
      bf16_t* Hid = (bf16_t*)AR;
      auto epi = [&](f32x4 (&acc)[2][8], int mt, int nt) {
#pragma unroll
        for (int mi = 0; mi < 2; ++mi) {
          bf16_t* hr = Hid + (size_t)(mt * 128 + 32 * w + 16 * mi + fr) * LDHID + nt * 128 + 8 * fq;
#pragma unroll
          for (int pq = 0; pq < 4; ++pq) {
            float r[8];
#pragma unroll
            for (int j = 0; j < 4; ++j) { const float a = fmaxf(acc[mi][2 * pq][j], 0.f), c2 = fmaxf(acc[mi][2 * pq + 1][j], 0.f); r[j] = a * a; r[4 + j] = c2 * c2; }
            uint4 o; o.x = pk2(r[0], r[1]); o.y = pk2(r[2], r[3]); o.z = pk2(r[4], r[5]); o.w = pk2(r[6], r[7]);
            *(uint4*)(hr + 32 * pq) = o;
          }
        }
      };
      gemm_phase(Hb, LDH, (const bf16_t*)((unsigned char*)WT + WT_FF1), D, M / 128, 32, ph == 17, epi, smem);
    } break;
    case 11: {
      norm_phase(p, 1, 0, false, false, 2);
    } break;
    case 12: {
      bf16_t* Qb = (bf16_t*)(AR + A1_Q); bf16_t* Kb = (bf16_t*)(AR + A1_K); bf16_t* Vt = (bf16_t*)(AR + A1_VT); bf16_t* GL = (bf16_t*)(AR + A1_GLU);
      const float* cT = (const float*)(ws + OFF_ROPE); const float* sT = cT + 8192 * 32;
      auto epi = [&](f32x4 (&acc)[2][8], int mt, int nt) {
        const int b = mt / NCH;
        if (nt < 12) {
#pragma unroll
          for (int mi = 0; mi < 2; ++mi) {
            const int row = mt * 128 + 32 * w + 16 * mi + fr, s = row - b * S_;
            if (s >= CTX) {
              const int tpos = s - CTX;
#pragma unroll
              for (int g2 = 0; g2 < 2; ++g2)
#pragma unroll
                for (int nn = 0; nn < 2; ++nn) {
                  const int ni = g2 * 4 + nn, d0 = 8 * fq + 4 * nn;
                  const f32x4 cc = *(const f32x4*)(cT + tpos * 32 + d0), sn = *(const f32x4*)(sT + tpos * 32 + d0);
                  const f32x4 x1 = acc[mi][ni], x2 = acc[mi][ni + 2];
                  acc[mi][ni] = x1 * cc - x2 * sn; acc[mi][ni + 2] = x2 * cc + x1 * sn;
                }
            }
          }
        }
#pragma unroll
        for (int mi = 0; mi < 2; ++mi)
#pragma unroll
          for (int ni = 0; ni < 8; ++ni) {
            const int row = mt * 128 + 32 * w + 16 * mi + fr, col = nt * 128 + ECOL(ni);
            f32x4 v = acc[mi][ni];
            if (nt < 6) { v *= 0.18033688011112042f; store_bf16_row(Qb, 768, row, col, v); }
            else if (nt < 12) store_bf16_row(Kb, 768, row, col - 768, v);
            else if (nt < 18) store_bf16_T(Vt + (size_t)b * 768 * S_, col - 1536, row - b * S_, v);
            else store_bf16_row(GL, 512, row, col - 2304, v);
          }
      };
      gemm_phase(Hb, LDH, (const bf16_t*)((unsigned char*)WT + WT_IN), D, M / 128, 22, false, epi, smem);
    } break;
    case 13: {
      const bf16_t* Qb = (const bf16_t*)(AR + A1_Q); const bf16_t* Kb = (const bf16_t*)(AR + A1_K); const bf16_t* Vt = (const bf16_t*)(AR + A1_VT);
      bf16_t* OA = (bf16_t*)(AR + A1_OA);
      const int r = lane & 31, hh = lane >> 5;
      constexpr int STAGE = 24576, SV_OFF = 8192, NKT = S_ / 64;
      for (int t = blockIdx.x; t < NB * 6 * 2 * 64; t += gridDim.x) {
        const int qt = t & 63, mp = (t >> 6) & 1, bh = t >> 7, b = bh / 6, h = bh % 6;
        const int rq0 = b * S_ + CTX + qt * 128;
        const bf16_t* Qp = Qb + (size_t)rq0 * 768 + h * 128 + mp * 64;
        const bf16_t* Kp = Kb + (size_t)b * S_ * 768 + h * 128 + mp * 64;
        const bf16_t* Vp = Vt + (size_t)(b * 768 + h * 128) * S_;
        bf16x8 qf[4];
#pragma unroll
        for (int ks = 0; ks < 4; ++ks) qf[ks] = *(const bf16x8*)(Qp + (size_t)(32 * w + r) * 768 + 16 * ks + 8 * hh);
        f32x16 o[4];
#pragma unroll
        for (int db = 0; db < 4; ++db)
#pragma unroll
          for (int i = 0; i < 16; ++i) o[db][i] = 0.f;
        float mrun = 0.f, lrun = 0.f;
        f32x16 negm;
#pragma unroll
        for (int i = 0; i < 16; ++i) negm[i] = 0.f;
        LASG unsigned char* lb = (LASG unsigned char*)smem;
        const int g8 = lane >> 3, gp = lane & 7;
#define ATT_ISSUE(st_, kt_) do { \
          _Pragma("unroll") for (int i = 0; i < 2; ++i) { const int rho = 16 * w + 8 * i + g8, key_ = (rho & ~12) | ((rho & 4) << 1) | ((rho & 8) >> 1); \
            __builtin_amdgcn_global_load_lds((const unsigned*)(Kp + (size_t)((kt_) * 64 + key_) * 768 + ((gp ^ ((rho >> 1) & 7)) * 8)), (LASG unsigned*)(lb + (st_) * STAGE + (16 * w + 8 * i) * 128 + lane * 16), 16, 0, 0); } \
          _Pragma("unroll") for (int i = 0; i < 4; ++i) { const int rho = 32 * w + 8 * i + g8; \
            __builtin_amdgcn_global_load_lds((const unsigned*)(Vp + (size_t)rho * S_ + (kt_) * 64 + ((gp ^ ((rho >> 1) & 7)) * 8)), (LASG unsigned*)(lb + (st_) * STAGE + SV_OFF + (32 * w + 8 * i) * 128 + lane * 16), 16, 0, 0); } } while (0)
        const int rsw = (r >> 1) & 7;
        __syncthreads();
        ATT_ISSUE(0, 0);
        for (int kt = 0; kt < NKT; ++kt) {
          const int st = kt & 1;
          __syncthreads();
          if (kt + 1 < NKT) ATT_ISSUE(st ^ 1, kt + 1);
          const unsigned char* sK = smem + st * STAGE; const unsigned char* sV = sK + SV_OFF;
          f32x16 sx[2];
#pragma unroll
          for (int kb = 0; kb < 2; ++kb) {
            sx[kb] = negm;
#pragma unroll
            for (int ks = 0; ks < 4; ++ks) {
              const bf16x8 kf = *(const bf16x8*)(sK + (32 * kb + r) * 128 + (((2 * ks + hh) ^ rsw) * 16));
              sx[kb] = __builtin_amdgcn_mfma_f32_32x32x16_bf16(kf, qf[ks], sx[kb], 0, 0, 0);
            }
          }
          float mx = sx[0][0];
#pragma unroll
          for (int i = 0; i < 16; ++i) { mx = fmaxf(mx, sx[0][i]); mx = fmaxf(mx, sx[1][i]); }
          mx = xor32_max(mx);
          if (kt == 0 || __any(mx > 0.f)) {
            const float dlt = (kt == 0) ? mx : fmaxf(mx, 0.f);
#pragma unroll
            for (int kb = 0; kb < 2; ++kb)
#pragma unroll
              for (int i = 0; i < 16; ++i) sx[kb][i] -= dlt;
            if (kt != 0) {
              const float alpha = __builtin_amdgcn_exp2f(-dlt);
              lrun *= alpha;
#pragma unroll
              for (int db = 0; db < 4; ++db) o[db] *= alpha;
            }
            mrun += dlt;
#pragma unroll
            for (int i = 0; i < 16; ++i) negm[i] = -mrun;
          }
          f32x2 rs2 = {0.f, 0.f};
#pragma unroll
          for (int kb = 0; kb < 2; ++kb)
#pragma unroll
            for (int i = 0; i < 16; i += 2) {
              f32x2 pv; pv.x = __builtin_amdgcn_exp2f(sx[kb][i]); pv.y = __builtin_amdgcn_exp2f(sx[kb][i + 1]);
              sx[kb][i] = pv.x; sx[kb][i + 1] = pv.y; rs2 += pv;
            }
          lrun += xor32_sum(rs2.x + rs2.y);
#pragma unroll
          for (int kb = 0; kb < 2; ++kb)
#pragma unroll
            for (int s2 = 0; s2 < 2; ++s2) {
              uint4 xp;
              xp.x = pk2(sx[kb][8 * s2 + 0], sx[kb][8 * s2 + 1]); xp.y = pk2(sx[kb][8 * s2 + 2], sx[kb][8 * s2 + 3]);
              xp.z = pk2(sx[kb][8 * s2 + 4], sx[kb][8 * s2 + 5]); xp.w = pk2(sx[kb][8 * s2 + 6], sx[kb][8 * s2 + 7]);
              const bf16x8 xs = __builtin_bit_cast(bf16x8, xp);
#pragma unroll
              for (int db = 0; db < 4; ++db) {
                const bf16x8 pa = *(const bf16x8*)(sV + (32 * db + r) * 128 + (((4 * kb + 2 * s2 + hh) ^ rsw) * 16));
                o[db] = __builtin_amdgcn_mfma_f32_32x32x16_bf16(pa, xs, o[db], 0, 0, 0);
              }
            }
        }
#undef ATT_ISSUE
        bf16_t* Od = OA + (size_t)mp * M * 768 + (size_t)(rq0 + 32 * w + r) * 768 + h * 128;
        const float inv = 1.f / lrun;
#pragma unroll
        for (int db = 0; db < 4; ++db)
#pragma unroll
          for (int g = 0; g < 4; ++g) {
            uint2 ov; ov.x = pk2(o[db][4 * g] * inv, o[db][4 * g + 1] * inv); ov.y = pk2(o[db][4 * g + 2] * inv, o[db][4 * g + 3] * inv);
            *(uint2*)(Od + 32 * db + 8 * g + 4 * hh) = ov;
          }
      }
    } break;
    case 14: {
      const bf16_t* OA = (const bf16_t*)(AR + A1_OA); const bf16_t* GL = (const bf16_t*)(AR + A1_GLU);
      const float lam_init = 0.8f - 0.6f * 0.7408182206817179f;
      {
        float l1 = p.lam_p[lane] * p.lam_p[64 + lane], l2 = p.lam_p[128 + lane] * p.lam_p[192 + lane];
        l1 = wsum(l1); l2 = wsum(l2);
        const float lam = __expf(l1) - __expf(l2) + lam_init;
        const int gw = blockIdx.x * 4 + w, ngw = gridDim.x * 4;
        const int l16 = lane & 15, g4 = lane >> 4;
        const f32x4 gs0 = *(const f32x4*)(p.g_sub + 8 * l16), gs1 = *(const f32x4*)(p.g_sub + 8 * l16 + 4);
        for (int it = gw; it < NB * SEQ * 6 / 4; it += ngw) {
          const int item = it * 4 + g4, rl = item / 6, h = item - rl * 6;
          const int b = rl / SEQ, tpos = rl % SEQ, row = b * S_ + CTX + tpos;
          const uint4 u0 = *(const uint4*)(OA + (size_t)row * 768 + h * 128 + 8 * l16);
          const uint4 u1 = *(const uint4*)(OA + (size_t)M * 768 + (size_t)row * 768 + h * 128 + 8 * l16);
          float o[8];
          o[0] = bflo(u0.x) - lam * bflo(u1.x); o[1] = bfhi(u0.x) - lam * bfhi(u1.x); o[2] = bflo(u0.y) - lam * bflo(u1.y); o[3] = bfhi(u0.y) - lam * bfhi(u1.y);
          o[4] = bflo(u0.z) - lam * bflo(u1.z); o[5] = bfhi(u0.z) - lam * bfhi(u1.z); o[6] = bflo(u0.w) - lam * bflo(u1.w); o[7] = bfhi(u0.w) - lam * bfhi(u1.w);
          float ss = 0.f;
#pragma unroll
          for (int e = 0; e < 8; ++e) ss += o[e] * o[e];
          ss += __shfl_xor(ss, 1); ss += __shfl_xor(ss, 2); ss += __shfl_xor(ss, 4); ss += __shfl_xor(ss, 8);
          const float rstd = rsqrtf(ss * (1.f / 128.f) + EPS) * (1.f - lam_init);
          uint4 ov;
          ov.x = pk2(o[0] * rstd * gs0[0], o[1] * rstd * gs0[1]); ov.y = pk2(o[2] * rstd * gs0[2], o[3] * rstd * gs0[3]);
          ov.z = pk2(o[4] * rstd * gs1[0], o[5] * rstd * gs1[1]); ov.w = pk2(o[6] * rstd * gs1[2], o[7] * rstd * gs1[3]);
          *(uint4*)(Hb + (size_t)row * LDH + h * 128 + 8 * l16) = ov;
        }
      }
      {
        float* su = (float*)smem;
        for (int t = blockIdx.x; t < NB * SEQ / 32; t += gridDim.x) {
          const int b = t / (SEQ / 32), t0 = (t % (SEQ / 32)) * 32;
          __syncthreads();
          for (int i = tid; i < 62 * 64; i += 256) {
            const int rr = i >> 6, c4 = (i & 63) * 4, tp = t0 + rr - 15;
            f32x4 u = {0.f, 0.f, 0.f, 0.f};
            if (tp >= 0 && tp < SEQ) {
              const size_t ro = (size_t)(b * S_ + CTX + tp) * 512;
              const uint2 av = *(const uint2*)(GL + ro + c4), gv = *(const uint2*)(GL + ro + 256 + c4);
              u[0] = bflo(av.x) * sigmoidf_(bflo(gv.x)); u[1] = bfhi(av.x) * sigmoidf_(bfhi(gv.x));
              u[2] = bflo(av.y) * sigmoidf_(bflo(gv.y)); u[3] = bfhi(av.y) * sigmoidf_(bfhi(gv.y));
            }
            *(f32x4*)(su + rr * 256 + c4) = u;
          }
          __syncthreads();
          float z[32], wj[31];
#pragma unroll
          for (int tt = 0; tt < 32; ++tt) z[tt] = 0.f;
#pragma unroll
          for (int j = 0; j < 31; ++j) wj[j] = p.w_dw[j * 256 + tid];
#pragma unroll
          for (int rr = 0; rr < 62; ++rr) {
            const float u = su[rr * 256 + tid];
#pragma unroll
            for (int tt = 0; tt < 32; ++tt) { const int j = rr - tt; if (j >= 0 && j < 31) z[tt] += wj[j] * u; }
          }
          __syncthreads();
#pragma unroll
          for (int tt = 0; tt < 32; ++tt) su[tt * 256 + tid] = z[tt];
          __syncthreads();
          for (int tt = w; tt < 32; tt += 4) {
            f32x4 v = *(const f32x4*)(su + tt * 256 + 4 * lane);
            const float mu = wsum(v[0] + v[1] + v[2] + v[3]) * (1.f / 256.f);
            v -= mu;
            const float rstd = rsqrtf(wsum(v[0] * v[0] + v[1] * v[1] + v[2] * v[2] + v[3] * v[3]) * (1.f / 256.f) + EPS);
            const f32x4 gl = *(const f32x4*)(p.g_cln + 4 * lane), bl = *(const f32x4*)(p.b_cln + 4 * lane);
            float y[4];
#pragma unroll
            for (int e = 0; e < 4; ++e) y[e] = siluf_(v[e] * rstd * gl[e] + bl[e]);
            uint2 o; o.x = pk2(y[0], y[1]); o.y = pk2(y[2], y[3]);
            *(uint2*)(Hb + (size_t)(b * S_ + CTX + t0 + tt) * LDH + 768 + 4 * lane) = o;
          }
        }
      }
    } break;
    case 16: norm_phase(p, 1, 1, false, true); break;
    case 19: {
      const int gw = blockIdx.x * 4 + w, ngw = gridDim.x * 4;
      for (int r = gw; r < NB * SEQ; r += ngw) {
        f32x4* xr = (f32x4*)(p.out + (size_t)r * D) + lane;
        f32x4 v[4]; float ss = 0.f;
#pragma unroll
        for (int j = 0; j < 4; ++j) { v[j] = xr[64 * j]; ss += v[j][0] * v[j][0] + v[j][1] * v[j][1] + v[j][2] * v[j][2] + v[j][3] * v[j][3]; }
        const float rstd = rsqrtf(wsum(ss) * (1.f / D) + EPS);
#pragma unroll
        for (int j = 0; j < 4; ++j) { const f32x4 gg = *(const f32x4*)(p.g_final + 4 * lane + 256 * j); xr[64 * j] = v[j] * rstd * gg; }
      }
    } break;
    default: break;
    }
}

__global__ void __launch_bounds__(256, LB2) mega(Params p) {
  extern __shared__ __attribute__((aligned(16))) unsigned char smem[];
  {
    volatile LAS unsigned* st = (volatile LAS unsigned*)(smem + LDS_BYTES - 16);
    if (threadIdx.x == 0) { st[0] = 0u; st[1] = 0u; }
    __syncthreads();
  }
  if (p.ph_hi == 7777) cg::this_grid().sync();
  const XcdBarrier xb = xcd_barrier_post((unsigned*)(p.ws + OFF_BAR), (volatile LAS unsigned*)(smem + LDS_BYTES - 16));
#ifndef REP_PH
#define REP_PH -1
#endif
#define RUN(k) if (p.ph_lo <= k && k < p.ph_hi) { if (k > p.ph_lo) { xcd_barrier(xb); } run_phase<k>(p, smem); \
    if (k == REP_PH) { xcd_barrier(xb); run_phase<k>(p, smem); } }
  RUN(0) RUN(1) RUN(2) RUN(3) RUN(4) RUN(5) RUN(6) RUN(7) RUN(8) RUN(9) RUN(10) RUN(11) RUN(12) RUN(13) RUN(14) RUN(15) RUN(16) RUN(17) RUN(18) RUN(19)
#undef RUN
  if (p.ph_lo == 20) {
    const bf16_t* src = (const bf16_t*)(p.ws + DUMP_OFF);
    for (size_t i = (size_t)blockIdx.x * 256 + threadIdx.x; i < (size_t)NB * SEQ * D; i += (size_t)gridDim.x * 256) p.out[i] = bf2f(src[i]) + bf2f(((const bf16_t*)(p.ws + OFF_H))[i]);
  }
}

extern "C" void kernel_launch(void* const* d_in, const int* in_sizes, int n_in, void* d_out, int out_size, void* d_ws, size_t ws_size, hipStream_t stream) {
  static int grid_blocks = 0;
  if (!grid_blocks) {
    if (ws_size < WS_NEED) { fprintf(stderr, "kernel_launch: workspace too small: %zu < %zu\n", ws_size, (size_t)WS_NEED); grid_blocks = -1; return; }
    int dev = 0, cus = 0, per_cu = 0;
    hipGetDevice(&dev);
    hipDeviceGetAttribute(&cus, hipDeviceAttributeMultiprocessorCount, dev);
    hipFuncSetAttribute((const void*)mega, hipFuncAttributeMaxDynamicSharedMemorySize, LDS_BYTES);
    hipOccupancyMaxActiveBlocksPerMultiprocessor(&per_cu, (const void*)mega, 256, LDS_BYTES);
    if (per_cu < 1) per_cu = 1;
    if (per_cu > 2) per_cu = 2;
    grid_blocks = cus * per_cu;
    fprintf(stderr, "kernel_launch: cus %d per_cu %d grid %d ws %zu\n", cus, per_cu, grid_blocks, ws_size);
  }
  if (grid_blocks < 0) return;
  Params p{};
  const float** pp = (const float**)&p;
  for (int i = 0; i < 22; ++i) pp[i] = (const float*)d_in[i];
  p.out = (float*)d_out; p.ws = (unsigned char*)d_ws;
#if MULTI_LAUNCH
  for (int ph = 0; ph < NPH_RUN; ++ph) {
    p.ph_lo = ph; p.ph_hi = ph + 1;
    hipLaunchKernelGGL(mega, dim3(grid_blocks), dim3(256), LDS_BYTES, stream, p);
  }
#if NPH_RUN < 20
  p.ph_lo = 20; p.ph_hi = 21;
  hipLaunchKernelGGL(mega, dim3(grid_blocks), dim3(256), LDS_BYTES, stream, p);
#endif
#else
  hipMemsetAsync((unsigned char*)d_ws + OFF_BAR, 0, XCD_BAR_WORDS * 4, stream);
  p.ph_lo = 0; p.ph_hi = NPH;
  void* args[] = {&p};
  hipError_t e = hipLaunchCooperativeKernel((void*)mega, dim3(grid_blocks), dim3(256), args, LDS_BYTES, stream);
  if (e != hipSuccess) fprintf(stderr, "cooperative launch failed: %s (grid %d)\n", hipGetErrorString(e), grid_blocks);
#endif
}
```

```cpp
#include <hip/hip_runtime.h>
#include <hip/hip_cooperative_groups.h>
#include <cstdio>
#include <cstdint>
namespace cg = cooperative_groups;

#ifndef LB2
#define LB2 2
#endif
#ifndef NPH_RUN
#define NPH_RUN 20
#endif
#ifndef DUMP_OFF
#define DUMP_OFF (OFF_AR + A0_QK)
#endif
#ifndef MULTI_LAUNCH
#define MULTI_LAUNCH 0
#endif

typedef unsigned short bf16_t;
typedef short bf16x8 __attribute__((ext_vector_type(8)));
typedef float f32x4 __attribute__((ext_vector_type(4)));
typedef float f32x16 __attribute__((ext_vector_type(16)));
#define DEV __device__ __forceinline__

constexpr int D = 1024, NB = 2, SEQ = 8192, CTX = 256, S_ = SEQ + CTX, M = NB * S_, DFF = 4096;
constexpr int LDH = D + 64, LDHID = DFF + 64;
constexpr int NCH = S_ / 128;
constexpr int NPH = 20;
constexpr float EPS = 1e-6f;

constexpr size_t OFF_MOD = 0;
constexpr size_t MOD_BYTES = 2 * 3 * 6144 * 4;
constexpr size_t OFF_ROPE = 0x40000;
constexpr size_t OFF_XC = 0x240000;
constexpr size_t OFF_G = 0x440000;
constexpr size_t OFF_CS = 0x5D0000;
constexpr size_t OFF_MS = 0x5D8000;
constexpr size_t OFF_NV = 0x5DA000;
constexpr size_t OFF_WT = 0x700000;
constexpr size_t WT_IN = 0, WT_OUT = 0x770000, WT_FF1 = 0x990000, WT_FF2 = 0x1210000;
constexpr size_t OFF_H = 0x2200000;
constexpr size_t OFF_AR = 0x4510000;
constexpr size_t A0_QK = 0, A0_ST = 0, A0_VT = 0x3180000, A0_O = 0x4A40000, A0_QC = 0x6300000, A0_KC = 0x7BC0000;
constexpr size_t DO_KCT = 0, DO_ZT = 0x18C0000, DO_F = 0x2940000;
constexpr size_t A1_Q = 0, A1_K = 0x18C0000, A1_VT = 0x3180000, A1_GLU = 0x4A40000, A1_OA = 0x5AC0000;
constexpr size_t OFF_WT2 = OFF_AR + 0x9480000;
constexpr size_t WS_NEED = OFF_WT2 + 0x1A30000;

struct Params {
  const float *x, *c, *ctx, *c_ctx, *w_mod, *b_mod, *g_norm, *w_in_even, *b_gate, *w_qk_conv, *g_head, *w_out_even,
      *w_in_odd, *lam_p, *g_sub, *w_dw, *g_cln, *b_cln, *w_out_odd, *w_ff1, *w_ff2, *g_final;
  float* out;
  unsigned char* ws;
  int ph_lo, ph_hi;
};

typedef float f32x2 __attribute__((ext_vector_type(2)));
typedef __bf16 bf16x2_t __attribute__((ext_vector_type(2)));
DEV unsigned pk2(float lo, float hi) { f32x2 v = {lo, hi}; bf16x2_t b = __builtin_convertvector(v, bf16x2_t); return __builtin_bit_cast(unsigned, b); }
DEV bf16_t f2bf(float f) { return (bf16_t)(pk2(f, 0.f) & 0xffff); }
DEV float bf2f(unsigned h) { return __uint_as_float(h << 16); }
DEV float bflo(unsigned u) { return __uint_as_float(u << 16); }
DEV float bfhi(unsigned u) { return __uint_as_float(u & 0xffff0000u); }
DEV float wsum(float v) { for (int o = 32; o; o >>= 1) v += __shfl_xor(v, o); return v; }
DEV float xor32_max(float v) { auto r = __builtin_amdgcn_permlane32_swap(__float_as_uint(v), __float_as_uint(v), false, false); return fmaxf(__uint_as_float(r[0]), __uint_as_float(r[1])); }
DEV float xor32_sum(float v) { auto r = __builtin_amdgcn_permlane32_swap(__float_as_uint(v), __float_as_uint(v), false, false); return __uint_as_float(r[0]) + __uint_as_float(r[1]); }
DEV float sigmoidf_(float x) { return __builtin_amdgcn_rcpf(1.f + __expf(-x)); }
DEV float siluf_(float x) { return x * __builtin_amdgcn_rcpf(1.f + __expf(-x)); }
DEV float logsigf_(float x) { return fminf(x, 0.f) - log1pf(__expf(-fabsf(x))); }

constexpr int LDT = 72;
constexpr int LDP = 136;
constexpr int LDS_A = 0, LDS_B = 18432, LDS_P = 36864, LDS_F = 71680, LDS_BYTES = 79872;

template <bool A_LDS, class LA, class LB>
DEV void block_gemm(f32x4 (&acc)[2][8], int nk, LA la, LB lb, unsigned char* smem, const bf16_t* pA, int ldp) {
  bf16_t* sA = (bf16_t*)(smem + LDS_A);
  bf16_t* sB = (bf16_t*)(smem + LDS_B);
  const int tid = threadIdx.x, lane = tid & 63, w = tid >> 6;
  const int srow = tid >> 3, scol = (tid & 7) * 8;
  const int fr = lane & 15, fq = lane >> 4;
  uint4 ra[4], rb[4];
#pragma unroll
  for (int i = 0; i < 4; ++i) { if (!A_LDS) ra[i] = la(srow + 32 * i, scol); rb[i] = lb(srow + 32 * i, scol); }
  for (int kt = 0; kt < nk; ++kt) {
    __syncthreads();
#pragma unroll
    for (int i = 0; i < 4; ++i) {
      if (!A_LDS) *(uint4*)&sA[(srow + 32 * i) * LDT + scol] = ra[i];
      *(uint4*)&sB[(srow + 32 * i) * LDT + scol] = rb[i];
    }
    __syncthreads();
    if (kt + 1 < nk) {
#pragma unroll
      for (int i = 0; i < 4; ++i) { if (!A_LDS) ra[i] = la(srow + 32 * i, (kt + 1) * 64 + scol); rb[i] = lb(srow + 32 * i, (kt + 1) * 64 + scol); }
    }
#pragma unroll
    for (int kk = 0; kk < 2; ++kk) {
      bf16x8 af[2], bfr[8];
#pragma unroll
      for (int mi = 0; mi < 2; ++mi) {
        if (A_LDS) af[mi] = *(const bf16x8*)&pA[(32 * w + 16 * mi + fr) * ldp + kt * 64 + kk * 32 + 8 * fq];
        else af[mi] = *(const bf16x8*)&sA[(32 * w + 16 * mi + fr) * LDT + kk * 32 + 8 * fq];
      }
#pragma unroll
      for (int ni = 0; ni < 8; ++ni) bfr[ni] = *(const bf16x8*)&sB[(16 * ni + fr) * LDT + kk * 32 + 8 * fq];
#pragma unroll
      for (int mi = 0; mi < 2; ++mi)
#pragma unroll
        for (int ni = 0; ni < 8; ++ni) acc[mi][ni] = __builtin_amdgcn_mfma_f32_16x16x32_bf16(bfr[ni], af[mi], acc[mi][ni], 0, 0, 0);
    }
  }
}

DEV void zero_acc(f32x4 (&acc)[2][8]) {
#pragma unroll
  for (int mi = 0; mi < 2; ++mi)
#pragma unroll
    for (int ni = 0; ni < 8; ++ni) acc[mi][ni] = (f32x4){0.f, 0.f, 0.f, 0.f};
}

#define LASG __attribute__((address_space(3)))
DEV void block_gemm_glds(f32x4 (&acc)[2][8], int nk, const bf16_t* Ag, size_t lda, const bf16_t* Bg, size_t ldb, unsigned char* smem) {
  const int tid = threadIdx.x, lane = tid & 63, w = tid >> 6;
  const int srow = tid >> 3, sc = ((tid & 7) ^ (srow & 7)) * 8;
  const int fr = lane & 15, fq = lane >> 4;
  const bf16_t* ag = Ag + (size_t)srow * lda + sc;
  const bf16_t* bg = Bg + (size_t)(8 * ((srow >> 2) & 3) + 4 * (srow >> 4) + (srow & 3)) * ldb + sc;
  LASG unsigned char* lbase = (LASG unsigned char*)smem;
#define GLDS_ISSUE(st_, k0_) do { \
    _Pragma("unroll") for (int i = 0; i < 4; ++i) { \
      __builtin_amdgcn_global_load_lds((const unsigned*)(ag + (size_t)(32 * i) * lda + (k0_)), (LASG unsigned*)(lbase + (st_) * 32768 + (tid + 256 * i) * 16), 16, 0, 0); \
      __builtin_amdgcn_global_load_lds((const unsigned*)(bg + (size_t)(32 * i) * ldb + (k0_)), (LASG unsigned*)(lbase + (st_) * 32768 + 16384 + (tid + 256 * i) * 16), 16, 0, 0); } } while (0)
  __syncthreads();
  GLDS_ISSUE(0, 0);
  for (int kt = 0; kt < nk; ++kt) {
    __syncthreads();
    if (kt + 1 < nk) GLDS_ISSUE((kt + 1) & 1, (kt + 1) * 64);
    const unsigned char* sA = smem + (kt & 1) * 32768;
    const unsigned char* sB = sA + 16384;
#pragma unroll
    for (int kk = 0; kk < 2; ++kk) {
      const int swz = ((kk * 4 + fq) ^ (fr & 7)) * 16;
      bf16x8 af[2], bfr[8];
#pragma unroll
      for (int mi = 0; mi < 2; ++mi) af[mi] = *(const bf16x8*)(sA + (32 * w + 16 * mi + fr) * 128 + swz);
#pragma unroll
      for (int ni = 0; ni < 8; ++ni) bfr[ni] = *(const bf16x8*)(sB + (16 * ni + fr) * 128 + swz);
#pragma unroll
      for (int mi = 0; mi < 2; ++mi)
#pragma unroll
        for (int ni = 0; ni < 8; ++ni) acc[mi][ni] = __builtin_amdgcn_mfma_f32_16x16x32_bf16(bfr[ni], af[mi], acc[mi][ni], 0, 0, 0);
    }
  }
#undef GLDS_ISSUE
}

DEV void block_gemm_glds2(f32x4 (&acc0)[2][8], f32x4 (&acc1)[2][8], int nk, const bf16_t* Ag, size_t lda, const bf16_t* Bg, size_t ldb, unsigned char* smem) {
  const int tid = threadIdx.x, lane = tid & 63, w = tid >> 6;
  const int fr = lane & 15, fq = lane >> 4;
  const int lr = lane >> 2, lp = lane & 3;
  const int sc = (lp ^ ((0x78 >> (2 * ((lr >> 2) & 3))) & 3)) * 8;
  const bf16_t* ag = Ag + (size_t)(32 * w + lr) * lda + sc;
  const bf16_t* bg = Bg + (size_t)(64 * w + lr) * ldb + sc;
  LASG unsigned char* lbase = (LASG unsigned char*)smem;
#define G2_ISSUE(st_, k0_) do { \
    _Pragma("unroll") for (int i = 0; i < 2; ++i) \
      __builtin_amdgcn_global_load_lds((const unsigned*)(ag + (size_t)(16 * i) * lda + (k0_)), (LASG unsigned*)(lbase + (st_) * 24576 + (32 * w + 16 * i) * 64 + lane * 16), 16, 0, 0); \
    _Pragma("unroll") for (int i = 0; i < 4; ++i) \
      __builtin_amdgcn_global_load_lds((const unsigned*)(bg + (size_t)(16 * i) * ldb + (k0_)), (LASG unsigned*)(lbase + (st_) * 24576 + 8192 + (64 * w + 16 * i) * 64 + lane * 16), 16, 0, 0); } while (0)
  __syncthreads();
  G2_ISSUE(0, 0);
  if (nk > 1) G2_ISSUE(1, 32);
  const int roff = (fq ^ ((0x78 >> (2 * ((fr >> 2) & 3))) & 3)) * 16 + fr * 64;
  int st = 0;
  for (int kt = 0; kt < nk; ++kt) {
    if (kt + 1 < nk) asm volatile("s_waitcnt vmcnt(6)" ::: "memory"); else asm volatile("s_waitcnt vmcnt(0)" ::: "memory");
    __builtin_amdgcn_s_barrier();
    asm volatile("" ::: "memory");
    if (kt + 2 < nk) { const int st2 = st >= 1 ? st - 1 : 2; G2_ISSUE(st2, (kt + 2) * 32); }
    const unsigned char* sA = smem + st * 24576;
    const unsigned char* sB = sA + 8192;
    bf16x8 af[2];
#pragma unroll
    for (int mi = 0; mi < 2; ++mi) af[mi] = *(const bf16x8*)(sA + (32 * w + 16 * mi) * 64 + roff);
    {
      bf16x8 bfr[8];
#pragma unroll
      for (int ni = 0; ni < 8; ++ni) bfr[ni] = *(const bf16x8*)(sB + (16 * ni) * 64 + roff);
#pragma unroll
      for (int mi = 0; mi < 2; ++mi)
#pragma unroll
        for (int ni = 0; ni < 8; ++ni) acc0[mi][ni] = __builtin_amdgcn_mfma_f32_16x16x32_bf16(bfr[ni], af[mi], acc0[mi][ni], 0, 0, 0);
    }
    {
      bf16x8 bfr[8];
#pragma unroll
      for (int ni = 0; ni < 8; ++ni) bfr[ni] = *(const bf16x8*)(sB + (128 + 16 * ni) * 64 + roff);
#pragma unroll
      for (int mi = 0; mi < 2; ++mi)
#pragma unroll
        for (int ni = 0; ni < 8; ++ni) acc1[mi][ni] = __builtin_amdgcn_mfma_f32_16x16x32_bf16(bfr[ni], af[mi], acc1[mi][ni], 0, 0, 0);
    }
    st = st == 2 ? 0 : st + 1;
  }
#undef G2_ISSUE
}

constexpr size_t OFF_BAR = 0x28000;
#define XB_TMO      128
#define XB_XCNT(j)  (256  + 64 * (j))
#define XB_XSUB(j)  (1280 + 64 * (j))
#define XB_XGEN(j)  (2304 + 64 * (j))
#define XB_TOP      3328
#define XB_TOPGEN   3392
#define XCD_BAR_WORDS 3456
#define XB_SPIN_CAP (1u << 18)
#define LAS __attribute__((address_space(3)))

__device__ __forceinline__ unsigned xb_ld(unsigned* p)              { return __hip_atomic_load(p, __ATOMIC_RELAXED, __HIP_MEMORY_SCOPE_AGENT); }
__device__ __forceinline__ unsigned xb_add(unsigned* p, unsigned v) { return __hip_atomic_fetch_add(p, v, __ATOMIC_RELAXED, __HIP_MEMORY_SCOPE_AGENT); }
__device__ __forceinline__ unsigned xb_xcc_id() { return (unsigned)__builtin_amdgcn_s_getreg((3 << 11) | 20) & 0xFu; }
#define XB_SPIN(cond, bar) do { unsigned _sp = 0; while (cond) { __builtin_amdgcn_s_sleep(1); \
    if ((++_sp & 255u) == 0u) { if (xb_ld(&(bar)[XB_TMO])) break; if (_sp > XB_SPIN_CAP) { atomicAdd(&(bar)[XB_TMO], 1u); break; } } } } while (0)

struct XcdBarrier {
    unsigned* bar; unsigned x;
    volatile LAS unsigned* st;
};

__device__ __forceinline__ XcdBarrier xcd_barrier_post(unsigned* bar, volatile LAS unsigned* st) {
    XcdBarrier b; b.bar = bar; b.x = xb_xcc_id(); b.st = st;
    if (threadIdx.x == 0) (void)xb_add(&bar[XB_XCNT(b.x)], 1u);
    return b;
}
__device__ __forceinline__ void xcd_barrier_complete(unsigned* bar, unsigned x, unsigned& nloc, unsigned& nx) {
    const unsigned G = gridDim.x * gridDim.y * gridDim.z;
    unsigned sum, cnt, mine, sp = 0u;
    for (;;) {
        sum = 0u; cnt = 0u; mine = 0u;
#pragma unroll
        for (unsigned j = 0; j < 16; ++j) { const unsigned c = xb_ld(&bar[XB_XCNT(j)]); sum += c; cnt += (c > 0u) ? 1u : 0u; mine = (j == x) ? c : mine; }
        if (sum == G) break;
        __builtin_amdgcn_s_sleep(1);
        if ((++sp & 255u) == 0u) { if (xb_ld(&bar[XB_TMO])) break; if (sp > XB_SPIN_CAP) { atomicAdd(&bar[XB_TMO], 1u); break; } }
    }
    nloc = mine > 0u ? mine : 1u; nx = cnt > 0u ? cnt : 1u;
}

__device__ __forceinline__ void xcd_barrier(const XcdBarrier& b) {
    asm volatile("s_waitcnt vmcnt(0)" ::: "memory");
    __syncthreads();
    if (threadIdx.x == 0) {
        unsigned* bar = b.bar;
        __builtin_amdgcn_s_waitcnt(0);
        unsigned nloc = b.st[0], nx = b.st[1];
        if (nloc == 0u) { xcd_barrier_complete(bar, b.x, nloc, nx); b.st[0] = nloc; b.st[1] = nx; }
        const unsigned old = xb_add(&bar[XB_XSUB(b.x)], 1u);
        const unsigned gen = old / nloc;
        if (old + 1u == (gen + 1u) * nloc) {
            __builtin_amdgcn_fence(__ATOMIC_RELEASE, "agent");
            asm volatile("s_waitcnt vmcnt(0)" ::: "memory");
            const unsigned og = xb_add(&bar[XB_TOP], 1u);
            const unsigned tg = og / nx;
            if (og + 1u == (tg + 1u) * nx) xb_add(&bar[XB_TOPGEN], 1u);
            else XB_SPIN(xb_ld(&bar[XB_TOPGEN]) == tg, bar);
            __builtin_amdgcn_fence(__ATOMIC_ACQUIRE, "agent");
            xb_add(&bar[XB_XGEN(b.x)], 1u);
            asm volatile("s_waitcnt vmcnt(0)" ::: "memory");
        } else {
            XB_SPIN(xb_ld(&bar[XB_XGEN(b.x)]) == gen, bar);
            __builtin_amdgcn_fence(__ATOMIC_ACQUIRE, "agent");
            asm volatile("s_waitcnt vmcnt(0)" ::: "memory");
        }
    }
    __syncthreads();
}

DEV const float* xsrc_row(const Params& p, bool from_input, int r) {
  const int b = r / S_, s = r - b * S_;
  if (from_input) return s < CTX ? p.ctx + (size_t)(b * CTX + s) * D : p.x + (size_t)(b * SEQ + s - CTX) * D;
  return s < CTX ? (const float*)(p.ws + OFF_XC) + (size_t)(b * CTX + s) * D : p.out + (size_t)(b * SEQ + s - CTX) * D;
}
DEV float* xdst_row(const Params& p, int r) {
  const int b = r / S_, s = r - b * S_;
  return s < CTX ? (float*)(p.ws + OFF_XC) + (size_t)(b * CTX + s) * D : p.out + (size_t)(b * SEQ + s - CTX) * D;
}
DEV const float* mod_row(const Params& p, int layer, int r) {
  const int b = r / S_, s = r - b * S_;
  return (const float*)(p.ws + OFF_MOD) + (size_t)(layer * 3 + (s < CTX ? 2 : b)) * 6144;
}

DEV void transpose_tile(const float* W, int K, int N, bf16_t* WT, int remap, int kt, int nt, unsigned char* smem) {
  float* tile = (float*)smem;
  const int tid = threadIdx.x;
  __syncthreads();
#pragma unroll
  for (int i = 0; i < 4; ++i) {
    const int kk = (tid >> 4) + 16 * i, c4 = (tid & 15) * 4;
    const int n = nt * 64 + c4;
    int src = n;
    if (remap) src = n < 3072 ? n : (n < 3328 ? n + 24 : (n < 3352 ? n - 256 : -1));
    else if (n >= N) src = -1;
    f32x4 v = (f32x4){0.f, 0.f, 0.f, 0.f};
    if (src >= 0) v = *(const f32x4*)(W + (size_t)(kt * 64 + kk) * N + src);
    tile[kk * 65 + c4 + 0] = v[0]; tile[kk * 65 + c4 + 1] = v[1]; tile[kk * 65 + c4 + 2] = v[2]; tile[kk * 65 + c4 + 3] = v[3];
  }
  __syncthreads();
  const int n = tid >> 2, kc = (tid & 3) * 16;
  uint4 o0, o1;
  const float* t = tile + kc * 65 + n;
  o0.x = pk2(t[0 * 65], t[1 * 65]); o0.y = pk2(t[2 * 65], t[3 * 65]); o0.z = pk2(t[4 * 65], t[5 * 65]); o0.w = pk2(t[6 * 65], t[7 * 65]);
  o1.x = pk2(t[8 * 65], t[9 * 65]); o1.y = pk2(t[10 * 65], t[11 * 65]); o1.z = pk2(t[12 * 65], t[13 * 65]); o1.w = pk2(t[14 * 65], t[15 * 65]);
  bf16_t* dst = WT + (size_t)(nt * 64 + n) * (K + 64) + kt * 64 + kc;
  *(uint4*)dst = o0; *(uint4*)(dst + 8) = o1;
}
DEV void transpose_mat(const float* Wm, int K, int N, int Npad, bf16_t* dst, int remap, unsigned char* smem, int b0, int nb) {
  const int nkt = K / 64, nnt = Npad / 64;
  if ((int)blockIdx.x < b0) return;
  for (int t = blockIdx.x - b0; t < nkt * nnt; t += nb) transpose_tile(Wm, K, N, dst, remap, t / nnt, t % nnt, smem);
}
DEV void convert_weights(const Params& p, int part, unsigned char* smem, int b0, int nb) {
  unsigned char* wt = p.ws + OFF_WT; unsigned char* wt2 = p.ws + OFF_WT2;
  if (part == 0) { transpose_mat(p.w_in_even, 1024, 3352, 3584, (bf16_t*)(wt + WT_IN), 1, smem, b0, nb); return; }
  transpose_mat(p.w_out_even, 1024, 1024, 1024, (bf16_t*)(wt + WT_OUT), 0, smem, b0, nb);
  transpose_mat(p.w_ff1, 1024, 4096, 4096, (bf16_t*)(wt + WT_FF1), 0, smem, b0, nb);
  transpose_mat(p.w_ff2, 4096, 1024, 1024, (bf16_t*)(wt + WT_FF2), 0, smem, b0, nb);
  transpose_mat(p.w_in_odd, 1024, 2816, 2816, (bf16_t*)(wt2 + WT_IN), 0, smem, b0, nb);
  transpose_mat(p.w_out_odd, 1024, 1024, 1024, (bf16_t*)(wt2 + WT_OUT), 0, smem, b0, nb);
  transpose_mat(p.w_ff1 + (size_t)1024 * 4096, 1024, 4096, 4096, (bf16_t*)(wt2 + WT_FF1), 0, smem, b0, nb);
  transpose_mat(p.w_ff2 + (size_t)1024 * 4096, 4096, 1024, 1024, (bf16_t*)(wt2 + WT_FF2), 0, smem, b0, nb);
}

DEV void mod_phase(const Params& p, unsigned char* smem) {
  float* MOD = (float*)(p.ws + OFF_MOD);
  float* sS = (float*)smem;
  float* red = sS + 3072;
  const int tid = threadIdx.x, cl = tid & 31, kg = tid >> 5;
  if ((int)blockIdx.x >= 2 * 192) return;
  __syncthreads();
  for (int i = tid; i < 3072; i += 256) { const int v = i >> 10, k = i & 1023; sS[i] = siluf_(v == 0 ? p.c[k] : (v == 1 ? p.c[1024 + k] : p.c_ctx[k])); }
  __syncthreads();
  for (int it = blockIdx.x; it < 2 * 192; it += gridDim.x) {
    const int l = it / 192, n = (it % 192) * 32 + cl;
    const float* W = p.w_mod + (size_t)l * 1024 * 6144 + n;
    float a0 = 0.f, a1 = 0.f, a2 = 0.f;
#pragma unroll 16
    for (int k = kg * 128; k < kg * 128 + 128; ++k) {
      const float wv = W[(size_t)k * 6144];
      a0 += sS[k] * wv; a1 += sS[1024 + k] * wv; a2 += sS[2048 + k] * wv;
    }
    __syncthreads();
    red[(kg * 32 + cl) * 3 + 0] = a0; red[(kg * 32 + cl) * 3 + 1] = a1; red[(kg * 32 + cl) * 3 + 2] = a2;
    __syncthreads();
    if (kg == 0) {
      const float bv = p.b_mod[l * 6144 + n];
#pragma unroll
      for (int v = 0; v < 3; ++v) {
        float sacc = 0.f;
#pragma unroll
        for (int g2 = 0; g2 < 8; ++g2) sacc += red[(g2 * 32 + cl) * 3 + v];
        MOD[(l * 3 + v) * 6144 + n] = sacc + bv;
      }
    }
  }
}
DEV void rope_phase(const Params& p) {
  float* ct = (float*)(p.ws + OFF_ROPE);
  float* st = ct + 8192 * 32;
  for (int i = blockIdx.x * 256 + threadIdx.x; i < 8192 * 32; i += gridDim.x * 256) {
    const int t = i >> 5, d = i & 31;
    const float pos = (d < 16) ? (float)(t >> 6) : (float)(t & 63);
    const float inv = powf(10000.f, -(float)(d & 15) / 16.f);
    const float ang = pos * inv;
    ct[i] = cosf(ang); st[i] = sinf(ang);
  }
}

constexpr size_t A_PART = 0x8700000;
DEV void norm_phase(const Params& p, int layer, int which, bool from_input, bool skip_ctx, int ctx_fix = 0) {
  const int lane = threadIdx.x & 63;
  const int gw = blockIdx.x * 4 + (threadIdx.x >> 6), ngw = gridDim.x * 4;
  const float* g = p.g_norm + (layer * 2 + which) * D;
  bf16_t* H = (bf16_t*)(p.ws + OFF_H);
  for (int r = gw; r < M; r += ngw) {
    const int s = r % S_;
    if (skip_ctx && s < CTX) continue;
    const bool fix = ctx_fix && s < CTX;
    const f32x4* xr = (const f32x4*)xsrc_row(p, fix ? (ctx_fix == 1) : from_input, r) + lane;
    const float* mv = mod_row(p, layer, r) + which * 3 * 1024;
    f32x4 v[4]; float ss = 0.f;
#pragma unroll
    for (int j = 0; j < 4; ++j) v[j] = xr[64 * j];
    if (fix) {
      const int rc = (r / S_) * CTX + s;
      const f32x4* pp = (const f32x4*)(p.ws + OFF_AR + A_PART) + (size_t)rc * 256 + lane;
      f32x4* xw = (f32x4*)xdst_row(p, r) + lane;
#pragma unroll
      for (int j = 0; j < 4; ++j) {
        v[j] += (pp[64 * j] + pp[(size_t)512 * 256 + 64 * j]) + (pp[(size_t)2 * 512 * 256 + 64 * j] + pp[(size_t)3 * 512 * 256 + 64 * j]);
        xw[64 * j] = v[j];
      }
    }
#pragma unroll
    for (int j = 0; j < 4; ++j) ss += v[j][0] * v[j][0] + v[j][1] * v[j][1] + v[j][2] * v[j][2] + v[j][3] * v[j][3];
    const float rstd = rsqrtf(wsum(ss) * (1.f / D) + EPS);
    uint2* o = (uint2*)(H + (size_t)r * LDH) + lane;
#pragma unroll
    for (int j = 0; j < 4; ++j) {
      const int c = 4 * lane + 256 * j;
      const f32x4 gg = *(const f32x4*)(g + c), sh = *(const f32x4*)(mv + c), sc = *(const f32x4*)(mv + 1024 + c);
      float y[4];
#pragma unroll
      for (int e = 0; e < 4; ++e) y[e] = v[j][e] * rstd * gg[e] * (1.f + sc[e]) + sh[e];
      uint2 w2; w2.x = pk2(y[0], y[1]); w2.y = pk2(y[2], y[3]);
      o[64 * j] = w2;
    }
  }
}

template <class Epi>
DEV void gemm_phase(const bf16_t* A, int lda, const bf16_t* Bt, int K, int MT, int NT, bool skip_ctx, Epi epi, unsigned char* smem) {
  const int ldb = K + 64;
  const int MTv = skip_ctx ? MT - 2 * NB : MT;
  const int nwg = MTv * NT;
  for (int t = blockIdx.x; t < nwg; t += gridDim.x) {
    int wgid = t;
    { const int q = nwg / 8, r8 = nwg % 8, xcd = wgid % 8, off = wgid / 8; wgid = (xcd < r8 ? xcd * (q + 1) : r8 * (q + 1) + (xcd - r8) * q) + off; }
    const int nig = 8 * NT, gid = wgid / nig, fm = gid * 8, gsz = (MTv - fm) < 8 ? (MTv - fm) : 8;
    int mt = fm + (wgid % nig) % gsz; const int nt = (wgid % nig) / gsz;
    if (skip_ctx) mt = (mt / (NCH - 2)) * NCH + 2 + (mt % (NCH - 2));
    f32x4 acc[2][8]; zero_acc(acc);
    const bf16_t* Ab = A + (size_t)mt * 128 * lda;
    const bf16_t* Bb = Bt + (size_t)nt * 128 * ldb;
    block_gemm_glds(acc, K / 64, Ab, (size_t)lda, Bb, (size_t)ldb, smem);
    epi(acc, mt, nt);
  }
}

template <class Epi>
DEV void gemm_phase2(const bf16_t* A, int lda, const bf16_t* Bt, int K, int MT, int NP, bool skip_ctx, Epi epi, unsigned char* smem) {
  const int ldb = K + 64;
  const int MTv = skip_ctx ? MT - 2 * NB : MT;
  for (int t = blockIdx.x; t < MTv * NP; t += gridDim.x) {
    int mt = t / NP; const int np = t % NP;
    if (skip_ctx) mt = (mt / (NCH - 2)) * NCH + 2 + (mt % (NCH - 2));
    f32x4 acc0[2][8], acc1[2][8]; zero_acc(acc0); zero_acc(acc1);
    block_gemm_glds2(acc0, acc1, K / 32, A + (size_t)mt * 128 * lda, (size_t)lda, Bt + (size_t)np * 256 * ldb, (size_t)ldb, smem);
    epi(acc0, mt, 2 * np);
    epi(acc1, mt, 2 * np + 1);
  }
}

#define PERMROW(r_) (32 * ((r_) >> 5) + 8 * (((r_) >> 2) & 3) + 4 * (((r_) >> 4) & 1) + ((r_) & 3))
#define ECOL(ni_) (32 * ((ni_) >> 1) + 8 * fq + 4 * ((ni_) & 1))
#define EPI_COORDS const int lane = threadIdx.x & 63, w = threadIdx.x >> 6, fr = lane & 15, fq = lane >> 4; (void)w; (void)fr; (void)fq;

DEV void store_bf16_row(bf16_t* base, size_t ld, int row, int col, const f32x4& v) {
  uint2 o; o.x = pk2(v[0], v[1]); o.y = pk2(v[2], v[3]);
  *(uint2*)(base + (size_t)row * ld + col) = o;
}
DEV void store_bf16_T(bf16_t* base, int col, int s, const f32x4& v) {
#pragma unroll
  for (int j = 0; j < 4; ++j) base[(size_t)(col + j) * S_ + s] = f2bf(v[j]);
}

struct GateScan { float a0, a1, b0, b1, pm0, pm1, F, amax; int pos0, pos1; };
DEV GateScan gate_scan(const float* G, const int r0, const int dir, const int h, const int lane) {
  GateScan g;
  const int j0 = 2 * lane, j1 = j0 + 1;
  g.pos0 = dir ? 127 - j0 : j0; g.pos1 = dir ? 127 - j1 : j1;
  const float i0 = G[(size_t)(r0 + g.pos0) * 24 + (dir * 2) * 6 + h], f0 = G[(size_t)(r0 + g.pos0) * 24 + (dir * 2 + 1) * 6 + h];
  const float i1 = G[(size_t)(r0 + g.pos1) * 24 + (dir * 2) * 6 + h], f1 = G[(size_t)(r0 + g.pos1) * 24 + (dir * 2 + 1) * 6 + h];
  const float lf0 = logsigf_(f0), lf1 = logsigf_(f1);
  const float s0 = lf0, s1 = lf0 + lf1;
  float tot = s1;
#pragma unroll
  for (int d = 1; d < 64; d <<= 1) { const float y = __shfl_up(tot, d); if (lane >= d) tot += y; }
  const float excl = tot - s1;
  g.b0 = s0 + excl; g.b1 = s1 + excl;
  g.F = __shfl(tot, 63);
  g.a0 = i0 - g.b0; g.a1 = i1 - g.b1;
  const float q0 = g.a0, q1 = fmaxf(g.a0, g.a1);
  float t = q1;
#pragma unroll
  for (int d = 1; d < 64; d <<= 1) { const float y = __shfl_up(t, d); if (lane >= d) t = fmaxf(t, y); }
  float ex = __shfl_up(t, 1); if (lane == 0) ex = -INFINITY;
  g.pm0 = fmaxf(q0, ex); g.pm1 = fmaxf(q1, ex);
  g.amax = __shfl(t, 63);
  return g;
}
DEV int chunk_ord(int dir, int i) { return dir == 0 ? i : (i < 2 ? 1 - i : 67 - i); }

template <int ph>
DEV void run_phase(const Params& p, unsigned char* smem) {
  const int tid = threadIdx.x, lane = tid & 63, w = tid >> 6, fr = lane & 15, fq = lane >> 4;
  unsigned char* ws = p.ws;
  bf16_t* const WT = (bf16_t*)(ws + (ph >= 11 ? OFF_WT2 : OFF_WT));
  bf16_t* const Hb = (bf16_t*)(ws + OFF_H);
  float* const Gt = (float*)(ws + OFF_G);
  float* const CS = (float*)(ws + OFF_CS);
  float* const MS = (float*)(ws + OFF_MS);
  float* const NV = (float*)(ws + OFF_NV);
  unsigned char* const AR = ws + OFF_AR;
  unsigned char* const DO = (unsigned char*)p.out;
  float* const sF = (float*)(smem + LDS_F);
  bf16_t* const sP = (bf16_t*)(smem + LDS_P);

    switch (ph) {
    case 0: {
      convert_weights(p, 0, smem, 0, gridDim.x);
      mod_phase(p, smem);
      rope_phase(p);
    } break;
    case 1: norm_phase(p, 0, 0, true, false); break;
    case 2: {
      bf16_t* QK = (bf16_t*)(AR + A0_QK); bf16_t* Vt = (bf16_t*)(AR + A0_VT); bf16_t* Ob = (bf16_t*)(AR + A0_O); bf16_t* Fb = (bf16_t*)(DO + DO_F);
      const float* bg = p.b_gate;
      auto epi = [&](f32x4 (&acc)[2][8], int mt, int nt) {
        const int b = mt / NCH;
        const int row0 = mt * 128 + 32 * w + fr, col0 = nt * 128 + 8 * fq;
        if (nt < 12 || (nt >= 18 && nt < 26)) {
          bf16_t* tb; int ld;
          if (nt < 12) { tb = QK + (size_t)row0 * 1536 + col0; ld = 1536; }
          else if (nt < 24) { tb = Ob + (size_t)row0 * 768 + (col0 - 2304); ld = 768; }
          else { tb = Fb + (size_t)row0 * 256 + (col0 - 3072); ld = 256; }
#pragma unroll
          for (int mi = 0; mi < 2; ++mi)
#pragma unroll
            for (int pq = 0; pq < 4; ++pq) {
              uint4 o; o.x = pk2(acc[mi][2 * pq][0], acc[mi][2 * pq][1]); o.y = pk2(acc[mi][2 * pq][2], acc[mi][2 * pq][3]);
              o.z = pk2(acc[mi][2 * pq + 1][0], acc[mi][2 * pq + 1][1]); o.w = pk2(acc[mi][2 * pq + 1][2], acc[mi][2 * pq + 1][3]);
              *(uint4*)(tb + (size_t)(16 * mi) * ld + 32 * pq) = o;
            }
        } else if (nt < 18) {
          bf16_t* tb = Vt + (size_t)b * 768 * S_ + (size_t)(col0 - 1536) * S_ + (row0 - b * S_);
#pragma unroll
          for (int mi = 0; mi < 2; ++mi)
#pragma unroll
            for (int ni = 0; ni < 8; ++ni)
#pragma unroll
              for (int j = 0; j < 4; ++j) tb[(size_t)(32 * (ni >> 1) + 4 * (ni & 1) + j) * S_ + 16 * mi] = f2bf(acc[mi][ni][j]);
        } else if (nt == 26) {
#pragma unroll
          for (int mi = 0; mi < 2; ++mi)
#pragma unroll
            for (int ni = 0; ni < 2; ++ni) {
              const int gc = ECOL(ni);
              if (gc < 24) { f32x4 o = acc[mi][ni]; o += *(const f32x4*)(bg + gc); *(f32x4*)(Gt + (size_t)(row0 + 16 * mi) * 24 + gc) = o; }
            }
        }
      };
      gemm_phase(Hb, LDH, (const bf16_t*)((unsigned char*)WT + WT_IN), D, M / 128, 27, false, epi, smem);
    } break;
    case 3: {
      const bf16_t* QK = (const bf16_t*)(AR + A0_QK);
      bf16_t* Qc = (bf16_t*)(AR + A0_QC); bf16_t* Kc = (bf16_t*)(AR + A0_KC); bf16_t* KcT = (bf16_t*)(DO + DO_KCT);
      bf16_t* ZT = (bf16_t*)(DO + DO_ZT); const bf16_t* Fb = (const bf16_t*)(DO + DO_F);
      for (int t = blockIdx.x; t < (M / 128) * 4; t += gridDim.x) {
        const int mt = t >> 2, g = t & 3;
        f32x4 acc[2][8]; zero_acc(acc);
        block_gemm<false>(acc, 1,
            [&](int row, int k) {
              const int cp = row & 63, im = row >> 6; float vv[8];
#pragma unroll
              for (int j = 0; j < 8; ++j) { const int mm = (cp * (k + j)) & 63; const float xx = (float)mm * (1.f / 64.f); vv[j] = im ? -__builtin_amdgcn_sinf(xx) : __builtin_amdgcn_cosf(xx); }
              uint4 o; o.x = pk2(vv[0], vv[1]); o.y = pk2(vv[2], vv[3]); o.z = pk2(vv[4], vv[5]); o.w = pk2(vv[6], vv[7]); return o;
            },
            [&](int row, int k) { return *(const uint4*)(Fb + (size_t)(mt * 128 + row) * 256 + g * 64 + k); },
            smem, nullptr, 0);
        const int b = mt / NCH;
#pragma unroll
        for (int mi = 0; mi < 2; ++mi) {
          const int n = 32 * w + 16 * mi + fr, cp = n & 63, im = n >> 6;
          bf16_t* zrow = ZT + (size_t)((b * 256 + g * 64 + cp) * 2 + im) * S_ + (mt * 128 - b * S_);
#pragma unroll
          for (int ni = 0; ni < 8; ++ni) {
            uint2 o; o.x = pk2(acc[mi][ni][0], acc[mi][ni][1]); o.y = pk2(acc[mi][ni][2], acc[mi][ni][3]);
            *(uint2*)(zrow + 16 * ni + 4 * fq) = o;
          }
        }
      }
      bf16_t* tl = (bf16_t*)smem;
      for (int t = blockIdx.x; t < (M / 64) * 12; t += gridDim.x) {
        const int rt = t / 12, ct = t % 12;
        const int r0 = rt * 64, b = r0 / S_, s0 = r0 - b * S_;
        const int lo = (s0 < CTX) ? 0 : CTX, hi = (s0 < CTX) ? CTX - 1 : S_ - 1;
        __syncthreads();
#pragma unroll
        for (int i = 0; i < 4; ++i) {
          const int id = tid + 256 * i, rr = id >> 4, cc = (id & 15) * 8;
          const int s = s0 + rr, c = ct * 128 + cc;
          const size_t base = (size_t)(r0 + rr) * 1536 + c;
          uint4 z = {0u, 0u, 0u, 0u};
          const uint4 u1 = *(const uint4*)(QK + base);
          const uint4 u0 = (s - 1 >= lo) ? *(const uint4*)(QK + base - 1536) : z;
          const uint4 u2 = (s + 1 <= hi) ? *(const uint4*)(QK + base + 1536) : z;
          const unsigned a0[4] = {u0.x, u0.y, u0.z, u0.w}, a1[4] = {u1.x, u1.y, u1.z, u1.w}, a2[4] = {u2.x, u2.y, u2.z, u2.w};
          float o[8];
          {
            const f32x4 wa0 = *(const f32x4*)(p.w_qk_conv + c), wa1 = *(const f32x4*)(p.w_qk_conv + c + 4);
            const f32x4 wb0 = *(const f32x4*)(p.w_qk_conv + 1536 + c), wb1 = *(const f32x4*)(p.w_qk_conv + 1536 + c + 4);
            const f32x4 wc0 = *(const f32x4*)(p.w_qk_conv + 3072 + c), wc1 = *(const f32x4*)(p.w_qk_conv + 3072 + c + 4);
            const float wA[8] = {wa0[0], wa0[1], wa0[2], wa0[3], wa1[0], wa1[1], wa1[2], wa1[3]};
            const float wB[8] = {wb0[0], wb0[1], wb0[2], wb0[3], wb1[0], wb1[1], wb1[2], wb1[3]};
            const float wC[8] = {wc0[0], wc0[1], wc0[2], wc0[3], wc1[0], wc1[1], wc1[2], wc1[3]};
#pragma unroll
            for (int e = 0; e < 4; ++e) {
              o[2 * e] = siluf_(wA[2 * e] * bflo(a0[e]) + wB[2 * e] * bflo(a1[e]) + wC[2 * e] * bflo(a2[e]));
              o[2 * e + 1] = siluf_(wA[2 * e + 1] * bfhi(a0[e]) + wB[2 * e + 1] * bfhi(a1[e]) + wC[2 * e + 1] * bfhi(a2[e]));
            }
          }
          if (ct < 6) {
            const float sc = 0.08838834764831845f;
            uint4 q; q.x = pk2(o[0] * sc, o[1] * sc); q.y = pk2(o[2] * sc, o[3] * sc); q.z = pk2(o[4] * sc, o[5] * sc); q.w = pk2(o[6] * sc, o[7] * sc);
            *(uint4*)(Qc + (size_t)(r0 + rr) * 768 + c) = q;
          } else {
            uint4 q; q.x = pk2(o[0], o[1]); q.y = pk2(o[2], o[3]); q.z = pk2(o[4], o[5]); q.w = pk2(o[6], o[7]);
            *(uint4*)(Kc + (size_t)(r0 + rr) * 768 + c - 768) = q;
#pragma unroll
            for (int e = 0; e < 8; ++e) tl[(cc + e) * LDT + rr] = f2bf(o[e]);
          }
        }
        __syncthreads();
        if (ct >= 6) {
#pragma unroll
          for (int i = 0; i < 4; ++i) {
            const int id = tid + 256 * i, cc = id >> 3, sc8 = (id & 7) * 8;
            const uint4 v = *(const uint4*)&tl[cc * LDT + sc8];
            *(uint4*)(KcT + (size_t)(b * 768 + (ct - 6) * 128 + cc) * S_ + s0 + sc8) = v;
          }
        }
      }
    } break;
    case 4: {
      const bf16_t* ZT = (const bf16_t*)(DO + DO_ZT);
      const int NF = 512 + 8;
      bf16_t* ApT = (bf16_t*)(DO + DO_F);
      const bf16_t* Vt = (const bf16_t*)(AR + A0_VT); const bf16_t* KcT = (const bf16_t*)(DO + DO_KCT); const bf16_t* Kc = (const bf16_t*)(AR + A0_KC);
      bf16_t* ST = (bf16_t*)(AR + A0_ST);
      for (int t = blockIdx.x; t < NF + 24 * NCH; t += gridDim.x) {
        if (t < 512) {
          const int mt = t & 1, ct = t >> 1;
          f32x4 acc[2][8]; zero_acc(acc);
          block_gemm<false>(acc, 4,
              [&](int row, int k) {
                const int p1 = mt * 64 + (row >> 1), op = row & 1, part = k >> 7, t1 = k & 127; float vv[8];
#pragma unroll
                for (int j = 0; j < 8; ++j) {
                  const float xx = (float)((p1 * (t1 + j)) & 127) * (1.f / 128.f);
                  const float cv = __builtin_amdgcn_cosf(xx), sv = __builtin_amdgcn_sinf(xx);
                  vv[j] = op == 0 ? (part == 0 ? cv : sv) : (part == 0 ? -sv : cv);
                }
                uint4 o; o.x = pk2(vv[0], vv[1]); o.y = pk2(vv[2], vv[3]); o.z = pk2(vv[4], vv[5]); o.w = pk2(vv[6], vv[7]); return o;
              },
              [&](int row, int k) {
                const int n = 2 * ct + (row >> 6), t2 = row & 63, part = k >> 7, t1 = k & 127;
                const bf16_t* src = ZT + (size_t)(n * 2 + part) * S_ + CTX + 64 * t1 + t2;
                unsigned e[8];
#pragma unroll
                for (int j = 0; j < 8; ++j) e[j] = src[64 * j];
                uint4 o; o.x = e[0] | (e[1] << 16); o.y = e[2] | (e[3] << 16); o.z = e[4] | (e[5] << 16); o.w = e[6] | (e[7] << 16); return o;
              }, smem, nullptr, 0);
#pragma unroll
          for (int mi = 0; mi < 2; ++mi) {
            const int row = 32 * w + 16 * mi + fr, p1 = mt * 64 + (row >> 1), op = row & 1;
#pragma unroll
            for (int ni = 0; ni < 8; ++ni) {
              const int col = 16 * ni + 4 * fq, n = 2 * ct + (col >> 6), t2 = col & 63;
              f32x4 v = acc[mi][ni], o;
#pragma unroll
              for (int j = 0; j < 4; ++j) {
                const float other = __shfl_xor(v[j], 1);
                const float xx = (float)((p1 * (t2 + j)) & 8191) * (1.f / 8192.f);
                const float cv = __builtin_amdgcn_cosf(xx), sv = __builtin_amdgcn_sinf(xx);
                o[j] = op == 0 ? (v[j] * cv + other * sv) : (v[j] * cv - other * sv);
              }
              store_bf16_row(ApT, 128, p1 * 512 + n, op * 64 + t2, o);
            }
          }
        } else if (t < NF) {
          const int tt = t - 512, mt = tt >> 2, nt = tt & 3;
          const int T = 256, tmask = T - 1;
          const float invT = 1.f / (float)T;
          f32x4 acc[2][8]; zero_acc(acc);
          block_gemm<false>(acc, 2 * T / 64,
              [&](int row, int k) {
                const int pp = mt * 128 + row, part = k >= T, t0 = k & tmask; float vv[8];
#pragma unroll
                for (int j = 0; j < 8; ++j) { const int mm = (pp * (t0 + j)) & tmask; const float xx = (float)mm * invT; vv[j] = part ? __builtin_amdgcn_sinf(xx) : __builtin_amdgcn_cosf(xx); }
                uint4 o; o.x = pk2(vv[0], vv[1]); o.y = pk2(vv[2], vv[3]); o.z = pk2(vv[4], vv[5]); o.w = pk2(vv[6], vv[7]); return o;
              },
              [&](int row, int k) { const int part = k >= T, t0 = k & tmask; return *(const uint4*)(ZT + (size_t)((nt * 128 + row) * 2 + part) * S_ + t0); },
              smem, nullptr, 0);
#pragma unroll
          for (int mi = 0; mi < 2; ++mi)
#pragma unroll
            for (int ni = 0; ni < 8; ++ni) {
              const int pp = mt * 128 + 32 * w + 16 * mi + fr, n = nt * 128 + 16 * ni + 4 * fq, b = n >> 8;
              f32x4 v = acc[mi][ni]; v *= (1.f / 128.f);
              store_bf16_row(Hb, LDH, b * S_ + pp, 768 + (n & 255), v);
            }
        } else {
          const int ta = t - NF, sd = ta / NCH, n = ta % NCH;
          const int dir = sd / 12, b = (sd / 6) & 1, h = sd % 6;
          const int r0 = b * S_ + n * 128;
          float* sW = sF;
          __syncthreads();
          if (w == 0) {
            const GateScan g = gate_scan(Gt, r0, dir, h, lane);
            sW[g.pos0] = __expf(g.a0 - g.amax); sW[g.pos1] = __expf(g.a1 - g.amax);
            if (lane == 0) { CS[(sd * NCH + n) * 4 + 0] = g.amax; CS[(sd * NCH + n) * 4 + 1] = g.F; }
          }
          __syncthreads();
          f32x4 acc[2][8]; zero_acc(acc);
          const bf16_t* Ab = Vt + (size_t)(b * 768 + h * 128) * S_ + n * 128;
          const bf16_t* Bb = KcT + (size_t)(b * 768 + h * 128) * S_ + n * 128;
          block_gemm<false>(acc, 2,
              [&](int row, int k) { return *(const uint4*)(Ab + (size_t)row * S_ + k); },
              [&](int row, int k) {
                const uint4 u = *(const uint4*)(Bb + (size_t)PERMROW(row) * S_ + k);
                uint4 o;
                o.x = pk2(bflo(u.x) * sW[k], bfhi(u.x) * sW[k + 1]); o.y = pk2(bflo(u.y) * sW[k + 2], bfhi(u.y) * sW[k + 3]);
                o.z = pk2(bflo(u.z) * sW[k + 4], bfhi(u.z) * sW[k + 5]); o.w = pk2(bflo(u.w) * sW[k + 6], bfhi(u.w) * sW[k + 7]);
                return o;
              }, smem, nullptr, 0);
          bf16_t* Sd = ST + (size_t)(sd * NCH + n) * 16384;
#pragma unroll
          for (int mi = 0; mi < 2; ++mi)
#pragma unroll
            for (int pq = 0; pq < 4; ++pq) {
              uint4 o; o.x = pk2(acc[mi][2 * pq][0], acc[mi][2 * pq][1]); o.y = pk2(acc[mi][2 * pq][2], acc[mi][2 * pq][3]);
              o.z = pk2(acc[mi][2 * pq + 1][0], acc[mi][2 * pq + 1][1]); o.w = pk2(acc[mi][2 * pq + 1][2], acc[mi][2 * pq + 1][3]);
              *(uint4*)(Sd + (size_t)(32 * w + 16 * mi + fr) * 128 + 8 * fq + 32 * pq) = o;
            }
          if (tid < 128) {
            int tix = tid; asm volatile("" : "+v"(tix));
            const uint4* krow = (const uint4*)(KcT + (size_t)(b * 768 + h * 128 + tix) * S_ + n * 128);
            float a = 0.f;
#pragma unroll
            for (int c = 0; c < 16; ++c) {
              const uint4 u = krow[c]; const float* ww = sW + 8 * c;
              a += bflo(u.x) * ww[0] + bfhi(u.x) * ww[1] + bflo(u.y) * ww[2] + bfhi(u.y) * ww[3] + bflo(u.z) * ww[4] + bfhi(u.z) * ww[5] + bflo(u.w) * ww[6] + bfhi(u.w) * ww[7];
            }
            NV[(size_t)(sd * NCH + n) * 128 + tix] = a;
          }
        }
      }
    } break;
    case 5: {
      {
        const bf16_t* ApT = (const bf16_t*)(DO + DO_F);
        for (int t = blockIdx.x; t < 512; t += gridDim.x) {
          const int p1 = t >> 2, n0 = (t & 3) * 128;
          f32x4 acc[2][8]; zero_acc(acc);
          block_gemm<false>(acc, 2,
              [&](int row, int k) { return *(const uint4*)(ApT + (size_t)(t * 128 + row) * 128 + k); },
              [&](int row, int k) {
                uint4 o = {0u, 0u, 0u, 0u};
                if (row < 64) {
                  const int part = k >> 6, t2 = k & 63; float vv[8];
#pragma unroll
                  for (int j = 0; j < 8; ++j) { const float xx = (float)((row * (t2 + j)) & 63) * (1.f / 64.f); vv[j] = part ? __builtin_amdgcn_sinf(xx) : __builtin_amdgcn_cosf(xx); }
                  o.x = pk2(vv[0], vv[1]); o.y = pk2(vv[2], vv[3]); o.z = pk2(vv[4], vv[5]); o.w = pk2(vv[6], vv[7]);
                }
                return o;
              }, smem, nullptr, 0);
#pragma unroll
          for (int mi = 0; mi < 2; ++mi) {
            const int n = n0 + 32 * w + 16 * mi + fr, b = n >> 8;
#pragma unroll
            for (int ni = 0; ni < 4; ++ni)
#pragma unroll
              for (int j = 0; j < 4; ++j) {
                const int p2 = 16 * ni + 4 * fq + j;
                Hb[(size_t)(b * S_ + CTX + p1 + 128 * p2) * LDH + 768 + (n & 255)] = f2bf(acc[mi][ni][j] * 0.0013810679320049757f);
              }
          }
        }
      }
      if (gridDim.x >= 400) convert_weights(p, 1, smem, 200, gridDim.x - 200); else convert_weights(p, 1, smem, 0, gridDim.x);
      bf16_t* ST = (bf16_t*)(AR + A0_ST);
      for (int e = blockIdx.x * 256 + tid; e < 24 * 2064; e += gridDim.x * 256) {
        const int sd = e / 2064, idx = e % 2064, dir = sd / 12;
        float cst[8];
#pragma unroll
        for (int j = 0; j < 8; ++j) cst[j] = 0.f;
        float m = 0.f;
        uint4 ring0[4], ring1[4]; float ra[4], rf[4];
#define SC_FETCH(i_, u_) do { const int n_ = chunk_ord(dir, (i_)); ra[u_] = CS[(sd * NCH + n_) * 4 + 0]; rf[u_] = CS[(sd * NCH + n_) * 4 + 1]; \
          if (idx < 2048) ring0[u_] = *(const uint4*)(ST + (size_t)(sd * NCH + n_) * 16384 + idx * 8); \
          else { const uint4* q_ = (const uint4*)(NV + (size_t)(sd * NCH + n_) * 128 + (idx - 2048) * 8); ring0[u_] = q_[0]; ring1[u_] = q_[1]; } } while (0)
#pragma unroll
        for (int u = 0; u < 4; ++u) { ring1[u] = uint4{0u, 0u, 0u, 0u}; SC_FETCH(u, u); }
        for (int i0 = 0; i0 < NCH; i0 += 4) {
#pragma unroll
          for (int u = 0; u < 4; ++u) {
            const int i = i0 + u;
            if (i < NCH) {
              const int n = chunk_ord(dir, i);
              const float amax = ra[u], F = rf[u];
              const uint4 c0 = ring0[u], c1 = ring1[u];
              if (i + 4 < NCH) SC_FETCH(i + 4, u);
              const float Mx = fmaxf(m, amax), dcy = __expf(m - Mx), scl = __expf(amax - Mx);
              if (idx < 2048) {
                uint4* ptr = (uint4*)(ST + (size_t)(sd * NCH + n) * 16384 + idx * 8);
                uint4 o; o.x = pk2(cst[0], cst[1]); o.y = pk2(cst[2], cst[3]); o.z = pk2(cst[4], cst[5]); o.w = pk2(cst[6], cst[7]);
                *ptr = o;
                cst[0] = dcy * cst[0] + scl * bflo(c0.x); cst[1] = dcy * cst[1] + scl * bfhi(c0.x);
                cst[2] = dcy * cst[2] + scl * bflo(c0.y); cst[3] = dcy * cst[3] + scl * bfhi(c0.y);
                cst[4] = dcy * cst[4] + scl * bflo(c0.z); cst[5] = dcy * cst[5] + scl * bfhi(c0.z);
                cst[6] = dcy * cst[6] + scl * bflo(c0.w); cst[7] = dcy * cst[7] + scl * bfhi(c0.w);
              } else {
                uint4* ptr = (uint4*)(NV + (size_t)(sd * NCH + n) * 128 + (idx - 2048) * 8);
                uint4 o0, o1;
                o0.x = __float_as_uint(cst[0]); o0.y = __float_as_uint(cst[1]); o0.z = __float_as_uint(cst[2]); o0.w = __float_as_uint(cst[3]);
                o1.x = __float_as_uint(cst[4]); o1.y = __float_as_uint(cst[5]); o1.z = __float_as_uint(cst[6]); o1.w = __float_as_uint(cst[7]);
                ptr[0] = o0; ptr[1] = o1;
                cst[0] = dcy * cst[0] + scl * __uint_as_float(c0.x); cst[1] = dcy * cst[1] + scl * __uint_as_float(c0.y);
                cst[2] = dcy * cst[2] + scl * __uint_as_float(c0.z); cst[3] = dcy * cst[3] + scl * __uint_as_float(c0.w);
                cst[4] = dcy * cst[4] + scl * __uint_as_float(c1.x); cst[5] = dcy * cst[5] + scl * __uint_as_float(c1.y);
                cst[6] = dcy * cst[6] + scl * __uint_as_float(c1.z); cst[7] = dcy * cst[7] + scl * __uint_as_float(c1.w);
              }
              if (idx == 0) MS[sd * NCH + n] = m;
              m = F + Mx;
            }
          }
        }
#undef SC_FETCH
      }
    } break;
    case 6: {
      const bf16_t* Vt = (const bf16_t*)(AR + A0_VT); const bf16_t* Qc = (const bf16_t*)(AR + A0_QC); const bf16_t* Kc = (const bf16_t*)(AR + A0_KC);
      const bf16_t* ST = (const bf16_t*)(AR + A0_ST); const bf16_t* Ob = (const bf16_t*)(AR + A0_O);
      float* aA = sF; float* aM = sF + 256; float* aI = sF + 512; float* aE = sF + 768; float* sN = sF + 1024; float* sQN = sF + 1280; float* sSC = sF + 1536;
      for (int t = blockIdx.x; t < 12 * NCH; t += gridDim.x) {
        const int bh = t / NCH, n = t % NCH, b = bh / 6, h = bh % 6;
        const int r0 = b * S_ + n * 128;
        __syncthreads();
        if (w < 2) {
          const int dir = w, sd = (dir * 2 + b) * 6 + h;
          const GateScan g = gate_scan(Gt, r0, dir, h, lane);
          const float mp = MS[sd * NCH + n];
          const float M0 = fmaxf(mp, g.pm0), M1 = fmaxf(mp, g.pm1);
          aA[dir * 128 + g.pos0] = __expf(g.a0 - g.amax); aA[dir * 128 + g.pos1] = __expf(g.a1 - g.amax);
          aM[dir * 128 + g.pos0] = __expf(g.amax - M0); aM[dir * 128 + g.pos1] = __expf(g.amax - M1);
          aI[dir * 128 + g.pos0] = __expf(mp - M0); aI[dir * 128 + g.pos1] = __expf(mp - M1);
          aE[dir * 128 + g.pos0] = __expf(-(g.b0 + M0)); aE[dir * 128 + g.pos1] = __expf(-(g.b1 + M1));
        } else {
          const int dir = w - 2, sd = (dir * 2 + b) * 6 + h;
          sN[dir * 128 + lane] = NV[(size_t)(sd * NCH + n) * 128 + lane];
          sN[dir * 128 + 64 + lane] = NV[(size_t)(sd * NCH + n) * 128 + 64 + lane];
        }
        __syncthreads();
        const bf16_t* Qb = Qc + (size_t)r0 * 768 + h * 128;
        const bf16_t* Kb = Kc + (size_t)r0 * 768 + h * 128;
        {
          const int qr = tid >> 1, k0 = (tid & 1) * 64;
          float sf = 0.f, sb = 0.f;
#pragma unroll
          for (int c8 = 0; c8 < 8; ++c8) {
            const uint4 u = *(const uint4*)(Qb + (size_t)qr * 768 + k0 + c8 * 8);
            const float* nf = sN + k0 + c8 * 8; const float* nb = sN + 128 + k0 + c8 * 8;
            sf += bflo(u.x) * nf[0] + bfhi(u.x) * nf[1] + bflo(u.y) * nf[2] + bfhi(u.y) * nf[3] + bflo(u.z) * nf[4] + bfhi(u.z) * nf[5] + bflo(u.w) * nf[6] + bfhi(u.w) * nf[7];
            sb += bflo(u.x) * nb[0] + bfhi(u.x) * nb[1] + bflo(u.y) * nb[2] + bfhi(u.y) * nb[3] + bflo(u.z) * nb[4] + bfhi(u.z) * nb[5] + bflo(u.w) * nb[6] + bfhi(u.w) * nb[7];
          }
          sf += __shfl_xor(sf, 1); sb += __shfl_xor(sb, 1);
          if ((tid & 1) == 0) { sQN[qr] = sf; sQN[128 + qr] = sb; }
        }
        f32x4 acc[2][8]; zero_acc(acc);
        block_gemm<false>(acc, 2,
            [&](int row, int k) { return *(const uint4*)(Qb + (size_t)row * 768 + k); },
            [&](int row, int k) { return *(const uint4*)(Kb + (size_t)row * 768 + k); }, smem, nullptr, 0);
        __syncthreads();
        {
          float rsf[2] = {0.f, 0.f}, rsb[2] = {0.f, 0.f};
#pragma unroll
          for (int ni = 0; ni < 8; ++ni) {
            const int s0 = 16 * ni + 4 * fq;
            const f32x4 ef = *(const f32x4*)(aA + s0), eb = *(const f32x4*)(aA + 128 + s0);
#pragma unroll
            for (int mi = 0; mi < 2; ++mi) {
              const int tr = 32 * w + 16 * mi + fr;
#pragma unroll
              for (int j = 0; j < 4; ++j) {
                const float sv = acc[mi][ni][j];
                rsf[mi] += (s0 + j <= tr) ? sv * ef[j] : 0.f;
                rsb[mi] += (s0 + j >= tr) ? sv * eb[j] : 0.f;
              }
            }
          }
          float cf[2], cb[2];
#pragma unroll
          for (int mi = 0; mi < 2; ++mi) {
            const int tr = 32 * w + 16 * mi + fr;
            float a = rsf[mi], c2 = rsb[mi];
            a += __shfl_xor(a, 16); a += __shfl_xor(a, 32); c2 += __shfl_xor(c2, 16); c2 += __shfl_xor(c2, 32);
            const float denf = a * aM[tr] + aI[tr] * sQN[tr], denb = c2 * aM[128 + tr] + aI[128 + tr] * sQN[128 + tr];
            const float ddf = 1.f / fmaxf(fabsf(denf), aE[tr]), ddb = 1.f / fmaxf(fabsf(denb), aE[128 + tr]);
            if (fq == 0) { sSC[tr] = aI[tr] * ddf; sSC[128 + tr] = aI[128 + tr] * ddb; }
            cf[mi] = aM[tr] * ddf; cb[mi] = aM[128 + tr] * ddb;
          }
#pragma unroll
          for (int ni = 0; ni < 8; ++ni) {
            const int s0 = 16 * ni + 4 * fq;
            const f32x4 ef = *(const f32x4*)(aA + s0), eb = *(const f32x4*)(aA + 128 + s0);
#pragma unroll
            for (int mi = 0; mi < 2; ++mi) {
              const int tr = 32 * w + 16 * mi + fr;
              f32x4 pv;
#pragma unroll
              for (int j = 0; j < 4; ++j) {
                const float df = (s0 + j <= tr) ? ef[j] * cf[mi] : 0.f;
                const float db = (s0 + j >= tr) ? eb[j] * cb[mi] : 0.f;
                pv[j] = acc[mi][ni][j] * (df + db);
              }
              uint2 o; o.x = pk2(pv[0], pv[1]); o.y = pk2(pv[2], pv[3]);
              *(uint2*)&sP[tr * LDP + s0] = o;
            }
          }
        }
        __syncthreads();
        zero_acc(acc);
        {
          const bf16_t* Vb = Vt + (size_t)(b * 768 + h * 128) * S_ + n * 128;
          block_gemm<true>(acc, 2, [&](int, int) { return uint4{0u, 0u, 0u, 0u}; },
              [&](int row, int k) { return *(const uint4*)(Vb + (size_t)PERMROW(row) * S_ + k); }, smem, sP, LDP);
        }
#pragma unroll
        for (int dir = 0; dir < 2; ++dir) {
          const int sd = (dir * 2 + b) * 6 + h;
          const bf16_t* Cb = ST + (size_t)(sd * NCH + n) * 16384;
          block_gemm<false>(acc, 2,
              [&](int row, int k) {
                const uint4 u = *(const uint4*)(Qb + (size_t)row * 768 + k);
                const float sc = sSC[dir * 128 + row];
                uint4 o; o.x = pk2(bflo(u.x) * sc, bfhi(u.x) * sc); o.y = pk2(bflo(u.y) * sc, bfhi(u.y) * sc);
                o.z = pk2(bflo(u.z) * sc, bfhi(u.z) * sc); o.w = pk2(bflo(u.w) * sc, bfhi(u.w) * sc); return o;
              },
              [&](int row, int k) { return *(const uint4*)(Cb + (size_t)PERMROW(row) * 128 + k); }, smem, nullptr, 0);
        }
#pragma unroll
        for (int mi = 0; mi < 2; ++mi) {
          const int tr = 32 * w + 16 * mi + fr, row = r0 + tr;
          float ss = 0.f;
#pragma unroll
          for (int ni = 0; ni < 8; ++ni)
#pragma unroll
            for (int j = 0; j < 4; ++j) ss += acc[mi][ni][j] * acc[mi][ni][j];
          ss += __shfl_xor(ss, 16); ss += __shfl_xor(ss, 32);
          const float rstd = rsqrtf(ss * (1.f / 128.f) + EPS);
#pragma unroll
          for (int pq = 0; pq < 4; ++pq) {
            const int col = h * 128 + 8 * fq + 32 * pq;
            const f32x4 g0 = *(const f32x4*)(p.g_head + col), g1 = *(const f32x4*)(p.g_head + col + 4);
            const uint4 ou = *(const uint4*)(Ob + (size_t)row * 768 + col);
            const f32x4 a0 = acc[mi][2 * pq], a1 = acc[mi][2 * pq + 1];
            uint4 o;
            o.x = pk2(a0[0] * rstd * g0[0] * sigmoidf_(bflo(ou.x)), a0[1] * rstd * g0[1] * sigmoidf_(bfhi(ou.x)));
            o.y = pk2(a0[2] * rstd * g0[2] * sigmoidf_(bflo(ou.y)), a0[3] * rstd * g0[3] * sigmoidf_(bfhi(ou.y)));
            o.z = pk2(a1[0] * rstd * g1[0] * sigmoidf_(bflo(ou.z)), a1[1] * rstd * g1[1] * sigmoidf_(bfhi(ou.z)));
            o.w = pk2(a1[2] * rstd * g1[2] * sigmoidf_(bflo(ou.w)), a1[3] * rstd * g1[3] * sigmoidf_(bfhi(ou.w)));
            *(uint4*)(Hb + (size_t)row * LDH + col) = o;
          }
        }
      }
    } break;
    case 7: case 10: case 15: case 18: {
      const bool is_ff2 = (ph == 10 || ph == 18);
      const int layer = ph >= 15 ? 1 : 0;
      const bool from_input = (ph == 7);
      const bf16_t* A = is_ff2 ? (const bf16_t*)AR : Hb;
      const int K = is_ff2 ? DFF : D;
      const bf16_t* Bt = (const bf16_t*)((unsigned char*)WT + (is_ff2 ? WT_FF2 : WT_OUT));
      const int gidx = is_ff2 ? 5 : 2;
      auto epi = [&](f32x4 (&acc)[2][8], int mt, int nt) {
#pragma unroll
        for (int mi = 0; mi < 2; ++mi) {
          const int row = mt * 128 + 32 * w + 16 * mi + fr;
          const float* xs = xsrc_row(p, from_input, row);
          float* xd = xdst_row(p, row);
          const float* gate = mod_row(p, layer, row) + gidx * 1024;
#pragma unroll
          for (int ni = 0; ni < 8; ++ni) {
            const int col = nt * 128 + ECOL(ni);
            const f32x4 xv = *(const f32x4*)(xs + col), gv = *(const f32x4*)(gate + col);
            f32x4 o = xv + gv * acc[mi][ni];
            *(f32x4*)(xd + col) = o;
          }
        }
      };
      const int lda = is_ff2 ? LDHID : LDH;
      gemm_phase(A, lda, Bt, K, M / 128, 8, true, epi, smem);
      if (layer == 0) {
        const int ldb = K + 64, kper = K / 4;
        float* PART = (float*)(AR + A_PART);
        for (int u = blockIdx.x; u < 32 * 4; u += gridDim.x) {
          const int tile = u >> 2, ks = u & 3, mc = tile >> 3, nt = tile & 7, mt = (mc >> 1) * NCH + (mc & 1);
          f32x4 acc[2][8]; zero_acc(acc);
          block_gemm_glds(acc, kper / 64, A + (size_t)mt * 128 * lda + ks * kper, (size_t)lda, Bt + (size_t)nt * 128 * ldb + ks * kper, (size_t)ldb, smem);
#pragma unroll
          for (int mi = 0; mi < 2; ++mi) {
            const int row = mt * 128 + 32 * w + 16 * mi + fr, rc = (row / S_) * CTX + (row % S_);
            const float* gate = mod_row(p, layer, row) + gidx * 1024;
            float* pd = PART + ((size_t)ks * 512 + rc) * 1024;
#pragma unroll
            for (int ni = 0; ni < 8; ++ni) {
              const int col = nt * 128 + ECOL(ni);
              const f32x4 gv = *(const f32x4*)(gate + col);
              *(f32x4*)(pd + col) = gv * acc[mi][ni];
            }
          }
        }
      }
    } break;
    case 8: norm_phase(p, 0, 1, false, false, 1); break;
    case 9: case 17: {
      bf16_t* Hid = (bf16_t*)AR;
      auto epi = [&](f32x4 (&acc)[2][8], int mt, int nt) {
#pragma unroll
        for (int mi = 0; mi < 2; ++mi) {
          bf16_t* hr = Hid + (size_t)(mt * 128 + 32 * w + 16 * mi + fr) * LDHID + nt * 128 + 8 * fq;
#pragma unroll
          for (int pq = 0; pq < 4; ++pq) {
            float r[8];
#pragma unroll
            for (int j = 0; j < 4; ++j) { const float a = fmaxf(acc[mi][2 * pq][j], 0.f), c2 = fmaxf(acc[mi][2 * pq + 1][j], 0.f); r[j] = a * a; r[4 + j] = c2 * c2; }
            uint4 o; o.x = pk2(r[0], r[1]); o.y = pk2(r[2], r[3]); o.z = pk2(r[4], r[5]); o.w = pk2(r[6], r[7]);
            *(uint4*)(hr + 32 * pq) = o;
          }
        }
      };
      gemm_phase(Hb, LDH, (const bf16_t*)((unsigned char*)WT + WT_FF1), D, M / 128, 32, ph == 17, epi, smem);
    } break;
    case 11: {
      norm_phase(p, 1, 0, false, false, 2);
    } break;
    case 12: {
      bf16_t* Qb = (bf16_t*)(AR + A1_Q); bf16_t* Kb = (bf16_t*)(AR + A1_K); bf16_t* Vt = (bf16_t*)(AR + A1_VT); bf16_t* GL = (bf16_t*)(AR + A1_GLU);
      const float* cT = (const float*)(ws + OFF_ROPE); const float* sT = cT + 8192 * 32;
      auto epi = [&](f32x4 (&acc)[2][8], int mt, int nt) {
        const int b = mt / NCH;
        if (nt < 12) {
#pragma unroll
          for (int mi = 0; mi < 2; ++mi) {
            const int row = mt * 128 + 32 * w + 16 * mi + fr, s = row - b * S_;
            if (s >= CTX) {
              const int tpos = s - CTX;
#pragma unroll
              for (int g2 = 0; g2 < 2; ++g2)
#pragma unroll
                for (int nn = 0; nn < 2; ++nn) {
                  const int ni = g2 * 4 + nn, d0 = 8 * fq + 4 * nn;
                  const f32x4 cc = *(const f32x4*)(cT + tpos * 32 + d0), sn = *(const f32x4*)(sT + tpos * 32 + d0);
                  const f32x4 x1 = acc[mi][ni], x2 = acc[mi][ni + 2];
                  acc[mi][ni] = x1 * cc - x2 * sn; acc[mi][ni + 2] = x2 * cc + x1 * sn;
                }
            }
          }
        }
#pragma unroll
        for (int mi = 0; mi < 2; ++mi)
#pragma unroll
          for (int ni = 0; ni < 8; ++ni) {
            const int row = mt * 128 + 32 * w + 16 * mi + fr, col = nt * 128 + ECOL(ni);
            f32x4 v = acc[mi][ni];
            if (nt < 6) { v *= 0.18033688011112042f; store_bf16_row(Qb, 768, row, col, v); }
            else if (nt < 12) store_bf16_row(Kb, 768, row, col - 768, v);
            else if (nt < 18) store_bf16_T(Vt + (size_t)b * 768 * S_, col - 1536, row - b * S_, v);
            else store_bf16_row(GL, 512, row, col - 2304, v);
          }
      };
      gemm_phase(Hb, LDH, (const bf16_t*)((unsigned char*)WT + WT_IN), D, M / 128, 22, false, epi, smem);
    } break;
    case 13: {
      const bf16_t* Qb = (const bf16_t*)(AR + A1_Q); const bf16_t* Kb = (const bf16_t*)(AR + A1_K); const bf16_t* Vt = (const bf16_t*)(AR + A1_VT);
      bf16_t* OA = (bf16_t*)(AR + A1_OA);
      const int r = lane & 31, hh = lane >> 5;
      constexpr int STAGE = 24576, SV_OFF = 8192, NKT = S_ / 64;
      for (int t = blockIdx.x; t < NB * 6 * 2 * 64; t += gridDim.x) {
        int item, mp;
        if ((NB * 6 * 2 * 64) % gridDim.x == 0 && (gridDim.x & 1) == 0) { const int hg = gridDim.x >> 1; item = (t % hg) + hg * (t / gridDim.x); mp = (t / hg) & 1; }
        else { item = (t & 63) | ((t >> 7) << 6); mp = (t >> 6) & 1; }
        const int qt = item & 63, bh = item >> 6, b = bh / 6, h = bh % 6;
        const int rq0 = b * S_ + CTX + qt * 128;
        const bf16_t* Qp = Qb + (size_t)rq0 * 768 + h * 128 + mp * 64;
        const bf16_t* Kp = Kb + (size_t)b * S_ * 768 + h * 128 + mp * 64;
        const bf16_t* Vp = Vt + (size_t)(b * 768 + h * 128) * S_;
        bf16x8 qf[4];
#pragma unroll
        for (int ks = 0; ks < 4; ++ks) qf[ks] = *(const bf16x8*)(Qp + (size_t)(32 * w + r) * 768 + 16 * ks + 8 * hh);
        f32x16 o[4];
#pragma unroll
        for (int db = 0; db < 4; ++db)
#pragma unroll
          for (int i = 0; i < 16; ++i) o[db][i] = 0.f;
        float mrun = 0.f, lrun = 0.f;
        f32x16 negm;
#pragma unroll
        for (int i = 0; i < 16; ++i) negm[i] = 0.f;
        LASG unsigned char* lb = (LASG unsigned char*)smem;
        const int g8 = lane >> 3, gp = lane & 7;
#define ATT_ISSUE(st_, kt_) do { \
          _Pragma("unroll") for (int i = 0; i < 2; ++i) { const int rho = 16 * w + 8 * i + g8, key_ = (rho & ~12) | ((rho & 4) << 1) | ((rho & 8) >> 1); \
            __builtin_amdgcn_global_load_lds((const unsigned*)(Kp + (size_t)((kt_) * 64 + key_) * 768 + ((gp ^ ((rho >> 1) & 7)) * 8)), (LASG unsigned*)(lb + (st_) * STAGE + (16 * w + 8 * i) * 128 + lane * 16), 16, 0, 0); } \
          _Pragma("unroll") for (int i = 0; i < 4; ++i) { const int rho = 32 * w + 8 * i + g8; \
            __builtin_amdgcn_global_load_lds((const unsigned*)(Vp + (size_t)rho * S_ + (kt_) * 64 + ((gp ^ ((rho >> 1) & 7)) * 8)), (LASG unsigned*)(lb + (st_) * STAGE + SV_OFF + (32 * w + 8 * i) * 128 + lane * 16), 16, 0, 0); } } while (0)
        const int rsw = (r >> 1) & 7;
        __syncthreads();
        ATT_ISSUE(0, 0);
        for (int kt = 0; kt < NKT; ++kt) {
          const int st = kt & 1;
          __syncthreads();
          if (kt + 1 < NKT) ATT_ISSUE(st ^ 1, kt + 1);
          const unsigned char* sK = smem + st * STAGE; const unsigned char* sV = sK + SV_OFF;
          f32x16 sx[2];
#pragma unroll
          for (int kb = 0; kb < 2; ++kb) {
            sx[kb] = negm;
#pragma unroll
            for (int ks = 0; ks < 4; ++ks) {
              const bf16x8 kf = *(const bf16x8*)(sK + (32 * kb + r) * 128 + (((2 * ks + hh) ^ rsw) * 16));
              sx[kb] = __builtin_amdgcn_mfma_f32_32x32x16_bf16(kf, qf[ks], sx[kb], 0, 0, 0);
            }
          }
          float mx = sx[0][0];
#pragma unroll
          for (int i = 0; i < 16; ++i) { mx = fmaxf(mx, sx[0][i]); mx = fmaxf(mx, sx[1][i]); }
          mx = xor32_max(mx);
          if (kt == 0 || __any(mx > 0.f)) {
            const float dlt = (kt == 0) ? mx : fmaxf(mx, 0.f);
#pragma unroll
            for (int kb = 0; kb < 2; ++kb)
#pragma unroll
              for (int i = 0; i < 16; ++i) sx[kb][i] -= dlt;
            if (kt != 0) {
              const float alpha = __builtin_amdgcn_exp2f(-dlt);
              lrun *= alpha;
#pragma unroll
              for (int db = 0; db < 4; ++db) o[db] *= alpha;
            }
            mrun += dlt;
#pragma unroll
            for (int i = 0; i < 16; ++i) negm[i] = -mrun;
          }
          f32x2 rs2 = {0.f, 0.f};
#pragma unroll
          for (int kb = 0; kb < 2; ++kb)
#pragma unroll
            for (int i = 0; i < 16; i += 2) {
              f32x2 pv; pv.x = __builtin_amdgcn_exp2f(sx[kb][i]); pv.y = __builtin_amdgcn_exp2f(sx[kb][i + 1]);
              sx[kb][i] = pv.x; sx[kb][i + 1] = pv.y; rs2 += pv;
            }
          lrun += xor32_sum(rs2.x + rs2.y);
#pragma unroll
          for (int kb = 0; kb < 2; ++kb)
#pragma unroll
            for (int s2 = 0; s2 < 2; ++s2) {
              uint4 xp;
              xp.x = pk2(sx[kb][8 * s2 + 0], sx[kb][8 * s2 + 1]); xp.y = pk2(sx[kb][8 * s2 + 2], sx[kb][8 * s2 + 3]);
              xp.z = pk2(sx[kb][8 * s2 + 4], sx[kb][8 * s2 + 5]); xp.w = pk2(sx[kb][8 * s2 + 6], sx[kb][8 * s2 + 7]);
              const bf16x8 xs = __builtin_bit_cast(bf16x8, xp);
#pragma unroll
              for (int db = 0; db < 4; ++db) {
                const bf16x8 pa = *(const bf16x8*)(sV + (32 * db + r) * 128 + (((4 * kb + 2 * s2 + hh) ^ rsw) * 16));
                o[db] = __builtin_amdgcn_mfma_f32_32x32x16_bf16(pa, xs, o[db], 0, 0, 0);
              }
            }
        }
#undef ATT_ISSUE
        bf16_t* Od = OA + (size_t)mp * M * 768 + (size_t)(rq0 + 32 * w + r) * 768 + h * 128;
        const float inv = 1.f / lrun;
#pragma unroll
        for (int db = 0; db < 4; ++db)
#pragma unroll
          for (int g = 0; g < 4; ++g) {
            uint2 ov; ov.x = pk2(o[db][4 * g] * inv, o[db][4 * g + 1] * inv); ov.y = pk2(o[db][4 * g + 2] * inv, o[db][4 * g + 3] * inv);
            *(uint2*)(Od + 32 * db + 8 * g + 4 * hh) = ov;
          }
      }
    } break;
    case 14: {
      const bf16_t* OA = (const bf16_t*)(AR + A1_OA); const bf16_t* GL = (const bf16_t*)(AR + A1_GLU);
      const float lam_init = 0.8f - 0.6f * 0.7408182206817179f;
      {
        float l1 = p.lam_p[lane] * p.lam_p[64 + lane], l2 = p.lam_p[128 + lane] * p.lam_p[192 + lane];
        l1 = wsum(l1); l2 = wsum(l2);
        const float lam = __expf(l1) - __expf(l2) + lam_init;
        const int gw = blockIdx.x * 4 + w, ngw = gridDim.x * 4;
        const int l16 = lane & 15, g4 = lane >> 4;
        const f32x4 gs0 = *(const f32x4*)(p.g_sub + 8 * l16), gs1 = *(const f32x4*)(p.g_sub + 8 * l16 + 4);
        for (int it = gw; it < NB * SEQ * 6 / 4; it += ngw) {
          const int item = it * 4 + g4, rl = item / 6, h = item - rl * 6;
          const int b = rl / SEQ, tpos = rl % SEQ, row = b * S_ + CTX + tpos;
          const uint4 u0 = *(const uint4*)(OA + (size_t)row * 768 + h * 128 + 8 * l16);
          const uint4 u1 = *(const uint4*)(OA + (size_t)M * 768 + (size_t)row * 768 + h * 128 + 8 * l16);
          float o[8];
          o[0] = bflo(u0.x) - lam * bflo(u1.x); o[1] = bfhi(u0.x) - lam * bfhi(u1.x); o[2] = bflo(u0.y) - lam * bflo(u1.y); o[3] = bfhi(u0.y) - lam * bfhi(u1.y);
          o[4] = bflo(u0.z) - lam * bflo(u1.z); o[5] = bfhi(u0.z) - lam * bfhi(u1.z); o[6] = bflo(u0.w) - lam * bflo(u1.w); o[7] = bfhi(u0.w) - lam * bfhi(u1.w);
          float ss = 0.f;
#pragma unroll
          for (int e = 0; e < 8; ++e) ss += o[e] * o[e];
          ss += __shfl_xor(ss, 1); ss += __shfl_xor(ss, 2); ss += __shfl_xor(ss, 4); ss += __shfl_xor(ss, 8);
          const float rstd = rsqrtf(ss * (1.f / 128.f) + EPS) * (1.f - lam_init);
          uint4 ov;
          ov.x = pk2(o[0] * rstd * gs0[0], o[1] * rstd * gs0[1]); ov.y = pk2(o[2] * rstd * gs0[2], o[3] * rstd * gs0[3]);
          ov.z = pk2(o[4] * rstd * gs1[0], o[5] * rstd * gs1[1]); ov.w = pk2(o[6] * rstd * gs1[2], o[7] * rstd * gs1[3]);
          *(uint4*)(Hb + (size_t)row * LDH + h * 128 + 8 * l16) = ov;
        }
      }
      {
        float* su = (float*)smem;
        for (int t = blockIdx.x; t < NB * SEQ / 32; t += gridDim.x) {
          const int b = t / (SEQ / 32), t0 = (t % (SEQ / 32)) * 32;
          __syncthreads();
          for (int i = tid; i < 62 * 64; i += 256) {
            const int rr = i >> 6, c4 = (i & 63) * 4, tp = t0 + rr - 15;
            f32x4 u = {0.f, 0.f, 0.f, 0.f};
            if (tp >= 0 && tp < SEQ) {
              const size_t ro = (size_t)(b * S_ + CTX + tp) * 512;
              const uint2 av = *(const uint2*)(GL + ro + c4), gv = *(const uint2*)(GL + ro + 256 + c4);
              u[0] = bflo(av.x) * sigmoidf_(bflo(gv.x)); u[1] = bfhi(av.x) * sigmoidf_(bfhi(gv.x));
              u[2] = bflo(av.y) * sigmoidf_(bflo(gv.y)); u[3] = bfhi(av.y) * sigmoidf_(bfhi(gv.y));
            }
            *(f32x4*)(su + rr * 256 + c4) = u;
          }
          __syncthreads();
          float z[32], wj[31];
#pragma unroll
          for (int tt = 0; tt < 32; ++tt) z[tt] = 0.f;
#pragma unroll
          for (int j = 0; j < 31; ++j) wj[j] = p.w_dw[j * 256 + tid];
#pragma unroll
          for (int rr = 0; rr < 62; ++rr) {
            const float u = su[rr * 256 + tid];
#pragma unroll
            for (int tt = 0; tt < 32; ++tt) { const int j = rr - tt; if (j >= 0 && j < 31) z[tt] += wj[j] * u; }
          }
          __syncthreads();
#pragma unroll
          for (int tt = 0; tt < 32; ++tt) su[tt * 256 + tid] = z[tt];
          __syncthreads();
          for (int tt = w; tt < 32; tt += 4) {
            f32x4 v = *(const f32x4*)(su + tt * 256 + 4 * lane);
            const float mu = wsum(v[0] + v[1] + v[2] + v[3]) * (1.f / 256.f);
            v -= mu;
            const float rstd = rsqrtf(wsum(v[0] * v[0] + v[1] * v[1] + v[2] * v[2] + v[3] * v[3]) * (1.f / 256.f) + EPS);
            const f32x4 gl = *(const f32x4*)(p.g_cln + 4 * lane), bl = *(const f32x4*)(p.b_cln + 4 * lane);
            float y[4];
#pragma unroll
            for (int e = 0; e < 4; ++e) y[e] = siluf_(v[e] * rstd * gl[e] + bl[e]);
            uint2 o; o.x = pk2(y[0], y[1]); o.y = pk2(y[2], y[3]);
            *(uint2*)(Hb + (size_t)(b * S_ + CTX + t0 + tt) * LDH + 768 + 4 * lane) = o;
          }
        }
      }
    } break;
    case 16: norm_phase(p, 1, 1, false, true); break;
    case 19: {
      const int gw = blockIdx.x * 4 + w, ngw = gridDim.x * 4;
      for (int r = gw; r < NB * SEQ; r += ngw) {
        f32x4* xr = (f32x4*)(p.out + (size_t)r * D) + lane;
        f32x4 v[4]; float ss = 0.f;
#pragma unroll
        for (int j = 0; j < 4; ++j) { v[j] = xr[64 * j]; ss += v[j][0] * v[j][0] + v[j][1] * v[j][1] + v[j][2] * v[j][2] + v[j][3] * v[j][3]; }
        const float rstd = rsqrtf(wsum(ss) * (1.f / D) + EPS);
#pragma unroll
        for (int j = 0; j < 4; ++j) { const f32x4 gg = *(const f32x4*)(p.g_final + 4 * lane + 256 * j); xr[64 * j] = v[j] * rstd * gg; }
      }
    } break;
    default: break;
    }
}

__global__ void __launch_bounds__(256, LB2) mega(Params p) {
  extern __shared__ __attribute__((aligned(16))) unsigned char smem[];
  {
    volatile LAS unsigned* st = (volatile LAS unsigned*)(smem + LDS_BYTES - 16);
    if (threadIdx.x == 0) { st[0] = 0u; st[1] = 0u; }
    __syncthreads();
  }
  if (p.ph_hi == 7777) cg::this_grid().sync();
  const XcdBarrier xb = xcd_barrier_post((unsigned*)(p.ws + OFF_BAR), (volatile LAS unsigned*)(smem + LDS_BYTES - 16));
#ifndef REP_PH
#define REP_PH -1
#endif
#define RUN(k) if (p.ph_lo <= k && k < p.ph_hi) { if (k > p.ph_lo) { xcd_barrier(xb); } run_phase<k>(p, smem); \
    if (k == REP_PH) { xcd_barrier(xb); run_phase<k>(p, smem); } }
  RUN(0) RUN(1) RUN(2) RUN(3) RUN(4) RUN(5) RUN(6) RUN(7) RUN(8) RUN(9) RUN(10) RUN(11) RUN(12) RUN(13) RUN(14) RUN(15) RUN(16) RUN(17) RUN(18) RUN(19)
#undef RUN
  if (p.ph_lo == 20) {
    const bf16_t* src = (const bf16_t*)(p.ws + DUMP_OFF);
    for (size_t i = (size_t)blockIdx.x * 256 + threadIdx.x; i < (size_t)NB * SEQ * D; i += (size_t)gridDim.x * 256) p.out[i] = bf2f(src[i]) + bf2f(((const bf16_t*)(p.ws + OFF_H))[i]);
  }
}

extern "C" void kernel_launch(void* const* d_in, const int* in_sizes, int n_in, void* d_out, int out_size, void* d_ws, size_t ws_size, hipStream_t stream) {
  static int grid_blocks = 0;
  if (!grid_blocks) {
    if (ws_size < WS_NEED) { fprintf(stderr, "kernel_launch: workspace too small: %zu < %zu\n", ws_size, (size_t)WS_NEED); grid_blocks = -1; return; }
    int dev = 0, cus = 0, per_cu = 0;
    hipGetDevice(&dev);
    hipDeviceGetAttribute(&cus, hipDeviceAttributeMultiprocessorCount, dev);
    hipFuncSetAttribute((const void*)mega, hipFuncAttributeMaxDynamicSharedMemorySize, LDS_BYTES);
    hipOccupancyMaxActiveBlocksPerMultiprocessor(&per_cu, (const void*)mega, 256, LDS_BYTES);
    if (per_cu < 1) per_cu = 1;
    if (per_cu > 2) per_cu = 2;
    grid_blocks = cus * per_cu;
    fprintf(stderr, "kernel_launch: cus %d per_cu %d grid %d ws %zu\n", cus, per_cu, grid_blocks, ws_size);
  }
  if (grid_blocks < 0) return;
  Params p{};
  const float** pp = (const float**)&p;
  for (int i = 0; i < 22; ++i) pp[i] = (const float*)d_in[i];
  p.out = (float*)d_out; p.ws = (unsigned char*)d_ws;
#if MULTI_LAUNCH
  for (int ph = 0; ph < NPH_RUN; ++ph) {
    p.ph_lo = ph; p.ph_hi = ph + 1;
    hipLaunchKernelGGL(mega, dim3(grid_blocks), dim3(256), LDS_BYTES, stream, p);
  }
#if NPH_RUN < 20
  p.ph_lo = 20; p.ph_hi = 21;
  hipLaunchKernelGGL(mega, dim3(grid_blocks), dim3(256), LDS_BYTES, stream, p);
#endif
#else
  hipMemsetAsync((unsigned char*)d_ws + OFF_BAR, 0, XCD_BAR_WORDS * 4, stream);
  p.ph_lo = 0; p.ph_hi = NPH;
  void* args[] = {&p};
  hipError_t e = hipLaunchCooperativeKernel((void*)mega, dim3(grid_blocks), dim3(256), args, LDS_BYTES, stream);
  if (e != hipSuccess) fprintf(stderr, "cooperative launch failed: %s (grid %d)\n", hipGetErrorString(e), grid_blocks);
#endif
}
```
